# Optimizing an MI355X kernel written in HIP

```python
import jax, jax.numpy as jnp
from jax import lax
import numpy as np

D_MODEL = 2048
BATCH = 8
SEQ = 2048
DEPTH = 1

EPS = 1e-6
MLA_HEADS = 16
MLA_Q_RANK = 512
MLA_KV_RANK = 512
MLA_NOPE = 128
MLA_ROPE = 64
MLA_V = D_MODEL // MLA_HEADS
ROPE_THETA = 10000.0
Q_BLOCK = 128
GLA_HEADS = 4
GLA_DK = D_MODEL // 2 // GLA_HEADS
GLA_DV = D_MODEL // GLA_HEADS
GLA_GATE_RANK = 16
GLA_TAU = 16.0
GLA_CHUNK = 64
PEER_HEADS = 8
PEER_NKEYS = 128
PEER_N = PEER_NKEYS * PEER_NKEYS
PEER_DQ = 256
PEER_HALF = PEER_DQ // 2
PEER_TOPK = 16
PEER_TOKEN_BLOCK = 128
IN_SPLITS = (MLA_Q_RANK, MLA_KV_RANK, MLA_ROPE,
             GLA_HEADS * GLA_DK, GLA_HEADS * GLA_DK, GLA_HEADS * GLA_DV,
             GLA_GATE_RANK, GLA_HEADS * GLA_DV, D_MODEL, D_MODEL)
D_IN = 11344

kernel_name = 'hybrid_mla_gla_peer_block'


def _rmsnorm(x, g):
    x32 = x.astype(jnp.float32)
    y = x32 * lax.rsqrt(jnp.mean(x32 * x32, axis=-1, keepdims=True) + EPS)
    return (y * g.astype(jnp.float32)).astype(x.dtype)


def _rope_tables(positions, dtype):
    inv_freq = ROPE_THETA ** (-jnp.arange(0, MLA_ROPE, 2, dtype=jnp.float32) / MLA_ROPE)
    ang = positions.astype(jnp.float32)[..., None] * inv_freq
    return jnp.cos(ang).astype(dtype), jnp.sin(ang).astype(dtype)


def _apply_rope(x, cos, sin):
    x1, x2 = jnp.split(x, 2, axis=-1)
    return jnp.concatenate([x1 * cos - x2 * sin, x2 * cos + x1 * sin], axis=-1)


def _mla(c_q, c_kv, k_pe, cos, sin, g_cq, w_uq, g_ckv, w_ukv, g_qn, g_qr, g_kn, g_kr):
    B, S, _ = c_q.shape
    H = MLA_HEADS
    q = (_rmsnorm(c_q, g_cq) @ w_uq).reshape(B, S, H, MLA_NOPE + MLA_ROPE)
    kv = (_rmsnorm(c_kv, g_ckv) @ w_ukv).reshape(B, S, H, MLA_NOPE + MLA_V)
    q_nope, q_pe = q[..., :MLA_NOPE], q[..., MLA_NOPE:]
    k_nope, v = kv[..., :MLA_NOPE], kv[..., MLA_NOPE:]
    q_nope = _rmsnorm(q_nope, g_qn)
    q_pe = _apply_rope(_rmsnorm(q_pe, g_qr), cos[:, :, None, :], sin[:, :, None, :])
    k_nope = _rmsnorm(k_nope, g_kn)
    k_pe = _apply_rope(_rmsnorm(k_pe, g_kr), cos, sin)
    scale = (MLA_NOPE + MLA_ROPE) ** -0.5
    nb = S // Q_BLOCK
    qn_b = q_nope.reshape(B, nb, Q_BLOCK, H, MLA_NOPE).transpose(1, 0, 2, 3, 4)
    qr_b = q_pe.reshape(B, nb, Q_BLOCK, H, MLA_ROPE).transpose(1, 0, 2, 3, 4)
    key_pos = jnp.arange(S)

    def attend(args):
        qn, qr, blk = args
        s = (jnp.einsum('bqhd,bkhd->bhqk', qn, k_nope).astype(jnp.float32)
             + jnp.einsum('bqhr,bkr->bhqk', qr, k_pe).astype(jnp.float32)) * scale
        q_pos = blk * Q_BLOCK + jnp.arange(Q_BLOCK)
        mask = key_pos[None, :] <= q_pos[:, None]
        s = jnp.where(mask[None, None], s, -jnp.inf)
        prob = jax.nn.softmax(s, axis=-1).astype(v.dtype)
        return jnp.einsum('bhqk,bkhd->bqhd', prob, v)

    o = lax.map(attend, (qn_b, qr_b, jnp.arange(nb)))
    return o.transpose(1, 0, 2, 3, 4).reshape(B, S, H * MLA_V)


def _gla(q, k, v, a_lr, og, w_a2, b_a, g_on):
    B, S, _ = q.shape
    H, DK, DV, C = GLA_HEADS, GLA_DK, GLA_DV, GLA_CHUNK
    nc = S // C
    log_a = jax.nn.log_sigmoid((a_lr @ w_a2 + b_a).astype(jnp.float32)) / GLA_TAU

    def to_chunks(t, d):
        return t.reshape(B, nc, C, H, d).transpose(1, 0, 3, 2, 4)

    qc = to_chunks(q * (DK ** -0.5), DK)
    kc = to_chunks(k, DK)
    vc = to_chunks(v, DV)
    bc = jnp.cumsum(to_chunks(log_a, DK), axis=-2)
    causal = jnp.tril(jnp.ones((C, C), dtype=bool))

    def step(state, inp):
        qi, ki, vi, bi = inp
        inter = jnp.einsum('bhcd,bhde->bhce', qi * jnp.exp(bi), state)
        diff = bi[:, :, :, None, :] - bi[:, :, None, :, :]
        decay = jnp.exp(jnp.where(causal[None, None, :, :, None], diff, -jnp.inf))
        att = jnp.einsum('bhid,bhjd,bhijd->bhij', qi, ki, decay)
        intra = jnp.einsum('bhij,bhje->bhie', att, vi)
        b_last = bi[:, :, -1:, :]
        new_state = (jnp.exp(b_last[:, :, 0, :])[..., None] * state
                     + jnp.einsum('bhjd,bhje->bhde', ki * jnp.exp(b_last - bi), vi))
        return new_state, inter + intra

    state0 = jnp.zeros((B, H, DK, DV), jnp.float32)
    _, o = lax.scan(step, state0, (qc, kc, vc, bc))
    o = o.transpose(1, 0, 3, 2, 4).reshape(B, S, H, DV)
    o = _rmsnorm(o, g_on) * jax.nn.silu(og.reshape(B, S, H, DV)).astype(jnp.float32)
    return o.reshape(B, S, H * DV).astype(q.dtype)


def _peer(h, w_pq, sub_keys, u_emb, v_emb):
    B, S, D = h.shape
    TB, K = PEER_TOKEN_BLOCK, PEER_TOPK
    hf = h.reshape((B * S) // TB, TB, D)

    def block(hb):
        q = (hb @ w_pq).reshape(TB, PEER_HEADS, 2, PEER_HALF)
        s = jnp.einsum('thpd,hpnd->thpn', q, sub_keys).astype(jnp.float32)
        top_s, top_i = lax.top_k(s, K)
        cand_s = (top_s[:, :, 0, :, None] + top_s[:, :, 1, None, :]).reshape(TB, PEER_HEADS, K * K)
        cand_id = (top_i[:, :, 0, :, None] * PEER_NKEYS + top_i[:, :, 1, None, :]).reshape(TB, PEER_HEADS, K * K)
        best_s, best_j = lax.top_k(cand_s, K)
        ids = jnp.take_along_axis(cand_id, best_j, axis=-1)
        gate = jax.nn.softmax(best_s, axis=-1)
        u_sel = jnp.take(u_emb, ids, axis=0)
        v_sel = jnp.take(v_emb, ids, axis=0)
        act = jax.nn.gelu(jnp.einsum('td,thkd->thk', hb, u_sel), approximate=False)
        return jnp.einsum('thk,thkd->td', (gate * act).astype(hb.dtype), v_sel)

    return lax.map(block, hf).reshape(B, S, D)


def setup_inputs(seed: int = 0) -> dict:
    key = jax.random.key(seed)
    ks = jax.random.split(key, 24)
    f32 = jnp.float32
    L, D = DEPTH, D_MODEL

    def nrm(k, shape, scale):
        return jax.random.normal(k, shape, f32) * scale

    def gain(k, shape):
        return 1.0 + 0.01 * jax.random.normal(k, shape, f32)

    x = jax.random.normal(ks[0], (BATCH, SEQ, D), f32)
    offset = jax.random.randint(ks[1], (BATCH, 1), 0, 4096, dtype=jnp.int32)
    positions = offset + jnp.arange(SEQ, dtype=jnp.int32)[None, :]
    return {
        'x': x,
        'positions': positions,
        'g_norm_mix': gain(ks[2], (L, D)),
        'w_in': nrm(ks[3], (L, D, D_IN), D ** -0.5),
        'b_gate': nrm(ks[4], (L, 2, D), 0.1),
        'g_cq': gain(ks[5], (L, MLA_Q_RANK)),
        'w_uq': nrm(ks[6], (L, MLA_Q_RANK, MLA_HEADS * (MLA_NOPE + MLA_ROPE)), MLA_Q_RANK ** -0.5),
        'g_ckv': gain(ks[7], (L, MLA_KV_RANK)),
        'w_ukv': nrm(ks[8], (L, MLA_KV_RANK, MLA_HEADS * (MLA_NOPE + MLA_V)), MLA_KV_RANK ** -0.5),
        'g_qn': gain(ks[9], (L, MLA_NOPE)),
        'g_qr': gain(ks[10], (L, MLA_ROPE)),
        'g_kn': gain(ks[11], (L, MLA_NOPE)),
        'g_kr': gain(ks[12], (L, MLA_ROPE)),
        'w_a2': nrm(ks[13], (L, GLA_GATE_RANK, GLA_HEADS * GLA_DK), GLA_GATE_RANK ** -0.5),
        'b_a': nrm(ks[14], (L, GLA_HEADS * GLA_DK), 0.1),
        'g_gla_out': gain(ks[15], (L, GLA_DV)),
        'w_out': nrm(ks[16], (L, D, D), D ** -0.5),
        'g_norm_ffn': gain(ks[17], (L, D)),
        'w_pq': nrm(ks[18], (L, D, PEER_HEADS * PEER_DQ), D ** -0.5),
        'sub_keys': nrm(ks[19], (L, PEER_HEADS, 2, PEER_NKEYS, PEER_HALF), PEER_HALF ** -0.5),
        'u_emb': nrm(ks[20], (L, PEER_N, D), D ** -0.5),
        'v_emb': nrm(ks[21], (L, PEER_N, D), 0.5),
    }


def reference(x, positions, g_norm_mix, w_in, b_gate, g_cq, w_uq, g_ckv, w_ukv, g_qn, g_qr, g_kn, g_kr,
              w_a2, b_a, g_gla_out, w_out, g_norm_ffn, w_pq, sub_keys, u_emb, v_emb):
    cos, sin = _rope_tables(positions, x.dtype)
    offsets = [int(o) for o in np.cumsum(IN_SPLITS)[:-1]]
    for l in range(DEPTH):
        h = _rmsnorm(x, g_norm_mix[l])
        p = h @ w_in[l]
        c_q, c_kv, k_pe, q_g, k_g, v_g, a_lr, og, gate_a, gate_b = jnp.split(p, offsets, axis=-1)
        o_mla = _mla(c_q, c_kv, k_pe, cos, sin, g_cq[l], w_uq[l], g_ckv[l], w_ukv[l],
                     g_qn[l], g_qr[l], g_kn[l], g_kr[l])
        o_gla = _gla(q_g, k_g, v_g, a_lr, og, w_a2[l], b_a[l], g_gla_out[l])
        merged = (jax.nn.sigmoid(gate_a + b_gate[l, 0]) * o_mla
                  + jax.nn.sigmoid(gate_b + b_gate[l, 1]) * o_gla)
        x = x + merged @ w_out[l]
        x = x + _peer(_rmsnorm(x, g_norm_ffn[l]), w_pq[l], sub_keys[l], u_emb[l], v_emb[l])
    return x
```

```cpp
#include <hip/hip_runtime.h>
#include <hip/hip_cooperative_groups.h>
#include <cstdio>
#include <cstdint>
namespace cg = cooperative_groups;

#ifndef MK_N_LAUNCHES
#define MK_N_LAUNCHES 1
#endif

#define LAS __attribute__((address_space(3)))
typedef unsigned short bf16_t;
typedef short bf16x8 __attribute__((ext_vector_type(8)));
typedef short s16x4 __attribute__((ext_vector_type(4)));
typedef float f32x4 __attribute__((ext_vector_type(4)));
typedef int i32x4 __attribute__((ext_vector_type(4)));
typedef float f32x16 __attribute__((ext_vector_type(16)));
typedef unsigned u32x4 __attribute__((ext_vector_type(4)));
typedef unsigned u32x2 __attribute__((ext_vector_type(2)));
typedef float f32x2_t __attribute__((ext_vector_type(2)));
typedef __bf16 bf16x2_t __attribute__((ext_vector_type(2)));
typedef short v4i16_t __attribute__((ext_vector_type(4)));

constexpr int T = 16384, DM = 2048, NB = 8, SEQ = 2048;
constexpr float EPS = 1e-6f;
constexpr int N1 = 11520;
constexpr float QSCALE = 0.07216878364870322f * 1.4426950408889634f;

constexpr size_t MiB = 1u << 20;
constexpr size_t WS_WUQ = 1 * MiB, WS_WUKV = 4 * MiB, WS_WOUT = 8 * MiB, WS_WPQ = 16 * MiB, WS_KEYS = 24 * MiB, WS_ROPE = 25 * MiB;
constexpr size_t WS_RSQ0 = 29 * MiB, WS_RSQ1 = 30 * MiB, WS_DEC = 32 * MiB, WS_SSQ = 33 * MiB, WS_KPE = 35 * MiB;
constexpr size_t WS_WIN = 40 * MiB, WS_H = 85 * MiB;
constexpr size_t WS_QH = 40 * MiB;
constexpr size_t WS_X1B = 40 * MiB;
constexpr size_t WS_CQKV = 149 * MiB, WS_QG = 181 * MiB, WS_KG = 213 * MiB, WS_VG = 245 * MiB, WS_OG = 309 * MiB, WS_GA = 373 * MiB, WS_GB = 437 * MiB, WS_MISC = 501 * MiB;
constexpr size_t WS_UB = WS_QG, WS_VB = WS_VG, WS_QP = WS_OG;
constexpr size_t WS_ABUF = 138 * MiB;
constexpr size_t WS_WG8 = 40 * MiB;
constexpr size_t WS_PMAX = 37 * MiB, WS_SWG = 39 * MiB;
constexpr size_t WS_SM = 39 * MiB + 512 * 1024, WS_SWO = 39 * MiB + 768 * 1024, WS_PMAXO = 38 * MiB + 512 * 1024;
constexpr size_t WS_M8 = WS_OG;
constexpr size_t WS_END = 509 * MiB;
constexpr size_t WS_SELT = WS_CQKV, WS_GATE = WS_CQKV + 4 * MiB, WS_R1G = WS_CQKV + 20 * MiB, WS_ACTP = WS_GA;
constexpr size_t WS_SX = WS_CQKV + 21 * MiB, WS_SU = WS_CQKV + 22 * MiB, WS_SV = WS_CQKV + 23 * MiB, WS_SW = WS_CQKV + 24 * MiB, WS_W8 = WS_CQKV + 25 * MiB;
constexpr size_t WS_X8 = WS_KG;
constexpr int NPH = 8;

constexpr int LDS_BYTES = 163840;
constexpr int XCH_OFF = 132096;

__device__ __forceinline__ unsigned pkbf(float lo, float hi) { f32x2_t v = {lo, hi}; bf16x2_t b = __builtin_convertvector(v, bf16x2_t); return __builtin_bit_cast(unsigned, b); }
__device__ __forceinline__ float bf_lo(unsigned u) { return __uint_as_float(u << 16); }
__device__ __forceinline__ float bf_hi(unsigned u) { return __uint_as_float(u & 0xffff0000u); }
__device__ __forceinline__ float bf1(bf16_t u) { return __uint_as_float(((unsigned)u) << 16); }
__device__ __forceinline__ bf16_t f2bf(float f) { return (bf16_t)(pkbf(f, 0.f) & 0xffffu); }
__device__ __forceinline__ float wave_sum(float v) {
#pragma unroll
    for (int o = 1; o < 64; o <<= 1) v += __shfl_xor(v, o);
    return v;
}
__device__ __forceinline__ float wave_max(float v) {
#pragma unroll
    for (int o = 1; o < 64; o <<= 1) v = fmaxf(v, __shfl_xor(v, o));
    return v;
}
__device__ __forceinline__ unsigned q8pack(float a, float b, float c, float d, float inv) {
    const int ia = (int)__builtin_rintf(a * inv), ib = (int)__builtin_rintf(b * inv), ic = (int)__builtin_rintf(c * inv), id = (int)__builtin_rintf(d * inv);
    return ((unsigned)ia & 0xffu) | (((unsigned)ib & 0xffu) << 8) | (((unsigned)ic & 0xffu) << 16) | ((unsigned)id << 24);
}
__device__ __forceinline__ float fast_sigmoid(float v) { return __builtin_amdgcn_rcpf(1.f + __builtin_amdgcn_exp2f(-1.4426950408889634f * v)); }

namespace pg8 {
constexpr int BM = 256, BK = 64, HALF = 128, HTB = HALF * BK * 2, STAGE_BYTES = 8 * HTB, NXCD = 8, WGM = 8;
__host__ __device__ __forceinline__ int lds_byte(int r, int c) { const int st = (r >> 4) * 2 + (c >> 5), rr = r & 15, cc = c & 31, ob = rr * 64 + cc * 2; return st * 1024 + (ob ^ (((ob >> 9) & 1) << 5)); }
__host__ __device__ __forceinline__ void stage_rc(int b, int& R, int& C) { const int st = b / 1024, sb = b % 1024, swz = sb ^ (((sb >> 9) & 1) << 5); R = (st >> 1) * 16 + swz / 64; C = (st & 1) * 32 + (swz % 64) / 2; }
__host__ __device__ __forceinline__ int perm32(int rho) { const int n = rho >> 4, i = rho & 15; return 8 * (i >> 2) + 4 * n + (i & 3); }
struct Unit { int pm, pn; };
struct Gemm { const bf16_t* A; const bf16_t* Bt; int M, N, K, lda, ldb; };
struct StaticOrder {
    int nM, nN, nwg, G, c;
    __device__ void init(int M, int N, int G_, int c_) { nM = M / BM; nN = N / BM; nwg = nM * nN; G = G_; c = c_; }
    __device__ bool next(int i, Unit& u) const {
        const long L = (long)i * G + c; if (L >= nwg) return false;
        int wgid = (int)L; { const int q = nwg / NXCD, r = nwg % NXCD, xcd = wgid % NXCD, off = wgid / NXCD; wgid = (xcd < r ? xcd * (q + 1) : r * (q + 1) + (xcd - r) * q) + off; }
        const int nig = WGM * nN, gid = wgid / nig, fm = gid * WGM, gsz = (nM - fm) < WGM ? (nM - fm) : WGM;
        u.pm = fm + ((wgid % nig) % gsz); u.pn = (wgid % nig) / gsz; return true;
    }
};
__device__ __forceinline__ f32x4 mma16(bf16x8 a, bf16x8 b, f32x4 c) { return __builtin_amdgcn_mfma_f32_16x16x32_bf16(a, b, c, 0, 0, 0); }
__device__ __forceinline__ i32x4 mma16(bf16x8 a, bf16x8 b, i32x4 c) { return __builtin_amdgcn_mfma_i32_16x16x64_i8(__builtin_bit_cast(i32x4, a), __builtin_bit_cast(i32x4, b), c, 0, 0, 0); }
template <class Epi, bool ALIGN_EPI>
__device__ __forceinline__ void gemm_phase(LAS unsigned char* lds, const Gemm g, const StaticOrder& S, const Epi& E) {
    const int tid = threadIdx.x, wid = __builtin_amdgcn_readfirstlane(tid >> 6), lane = tid & 63, wr = wid >> 2, wc = wid & 3, fr = lane & 15, fq = lane >> 4;
    const int K = g.K, nt = K / BK;
    unsigned voffA[2], voffB[2];
#pragma unroll
    for (int i = 0; i < 2; ++i) { int R, C; stage_rc(tid * 16 + i * 8192, R, C); const int Rb = Epi::PERM ? ((R & ~31) + perm32(R & 31)) : R;
        voffA[i] = (unsigned)(R * g.lda + C) * 2u; voffB[i] = (unsigned)(Rb * g.ldb + C) * 2u; }
    const size_t kstep = (size_t)(BK * 2);
    const size_t hstepA = (size_t)HALF * g.lda * 2, hstepB = (size_t)HALF * g.ldb * 2;
    const size_t tstepA = 2 * hstepA, tstepB = 2 * hstepB;
    const unsigned ldsw = (unsigned)wid * 1024u;
    const int aoff = lds_byte(wr * 64 + fr, fq * 8), boff = lds_byte(wc * 32 + fr, fq * 8);
#define PG8_SA(b, h) (((b) * 2 + (h)) * HTB)
#define PG8_SB(b, h) ((4 + (b) * 2 + (h)) * HTB)
#define PG8_STAGE(bufoff, gbase, voff) do { _Pragma("unroll") for (int _i = 0; _i < 2; ++_i) \
        __builtin_amdgcn_global_load_lds((const unsigned*)((const char*)(gbase) + (voff)[_i]), (LAS unsigned*)(lds + (bufoff) + ldsw + _i * 8192), 16, 0, 0); } while (0)
#define PG8_LDA(dst, b, h) do { _Pragma("unroll") for (int m = 0; m < 4; ++m) _Pragma("unroll") for (int k = 0; k < 2; ++k) dst[m][k] = *(const LAS bf16x8*)(lds + PG8_SA(b, h) + aoff + m * 2048 + k * 1024); } while (0)
#define PG8_LDB(dst, b, h) do { _Pragma("unroll") for (int n = 0; n < 2; ++n) _Pragma("unroll") for (int k = 0; k < 2; ++k) dst[n][k] = *(const LAS bf16x8*)(lds + PG8_SB(b, h) + boff + n * 2048 + k * 1024); } while (0)
#define PG8_MMA(ai, bj, At, Bt) do { __builtin_amdgcn_s_setprio(1); _Pragma("unroll") for (int m = 0; m < 4; ++m) _Pragma("unroll") for (int n = 0; n < 2; ++n) _Pragma("unroll") for (int k = 0; k < 2; ++k) \
        acc[ai][bj][m][n] = mma16(Bt[n][k], At[m][k], acc[ai][bj][m][n]); __builtin_amdgcn_s_setprio(0); } while (0)
#define PG8_WAIT_V(n) asm volatile("s_waitcnt vmcnt(" #n ")" ::: "memory")
#define PG8_WAIT_L(n) asm volatile("s_waitcnt lgkmcnt(" #n ")" ::: "memory")
#define PG8_BAR __builtin_amdgcn_s_barrier()
#define PG8_SCHED __builtin_amdgcn_sched_barrier(0)
    Unit cur, nxt; int ui = 0;
    if (!S.next(0, cur)) return;
    typename Epi::acc_t acc[2][2][4][2];
    E.init(acc, cur, wr, wc, fr, fq);
    bf16x8 At[4][2], B0[2][2], B1[2][2];
    const char* cA = (const char*)g.A + (size_t)cur.pm * tstepA; const char* cB = (const char*)g.Bt + (size_t)cur.pn * tstepB;
    PG8_STAGE(PG8_SB(0, 0), cB, voffB); PG8_STAGE(PG8_SB(0, 1), cB + hstepB, voffB); PG8_STAGE(PG8_SA(0, 0), cA, voffA); PG8_STAGE(PG8_SA(0, 1), cA + hstepA, voffA);
    if (wr == 1) PG8_BAR;
    PG8_WAIT_V(2); PG8_BAR;
    PG8_STAGE(PG8_SB(1, 0), cB + kstep, voffB); PG8_STAGE(PG8_SA(1, 0), cA + kstep, voffA); PG8_STAGE(PG8_SB(1, 1), cB + hstepB + kstep, voffB);
    PG8_WAIT_V(6); PG8_BAR;
    for (;;) {
        const bool has_next = S.next(ui + 1, nxt);
        const char* nA = has_next ? (const char*)g.A + (size_t)nxt.pm * tstepA : cA; const char* nB = has_next ? (const char*)g.Bt + (size_t)nxt.pn * tstepB : cB;
        for (int t = 0; t < nt; t += 2) {
            const bool last = (t == nt - 2);
            const char* a1 = cA + (size_t)(t + 1) * kstep;
            const char* a2 = last ? nA : cA + (size_t)(t + 2) * kstep; const char* b2 = last ? nB : cB + (size_t)(t + 2) * kstep;
            const char* a3 = a2 + kstep; const char* b3 = b2 + kstep;
            PG8_LDB(B0, 0, 0); PG8_LDB(B1, 0, 1); PG8_SCHED; PG8_LDA(At, 0, 0); PG8_STAGE(PG8_SA(1, 1), a1 + hstepA, voffA);
            PG8_WAIT_V(8); PG8_WAIT_L(0); PG8_BAR; PG8_MMA(0, 0, At, B0); PG8_MMA(0, 1, At, B1); PG8_BAR; PG8_SCHED;
            PG8_LDA(At, 0, 1); PG8_STAGE(PG8_SB(0, 0), b2, voffB); PG8_STAGE(PG8_SB(0, 1), b2 + hstepB, voffB); PG8_STAGE(PG8_SA(0, 0), a2, voffA);
            PG8_WAIT_V(8); PG8_WAIT_L(0); PG8_BAR; PG8_MMA(1, 0, At, B0); PG8_MMA(1, 1, At, B1); PG8_BAR; PG8_SCHED;
            PG8_LDB(B0, 1, 0); PG8_LDB(B1, 1, 1); PG8_SCHED; PG8_LDA(At, 1, 0); PG8_STAGE(PG8_SA(0, 1), a2 + hstepA, voffA);
            PG8_WAIT_V(8); PG8_WAIT_L(0); PG8_BAR; PG8_MMA(0, 0, At, B0); PG8_MMA(0, 1, At, B1); PG8_BAR; PG8_SCHED;
            PG8_LDA(At, 1, 1); PG8_STAGE(PG8_SB(1, 0), b3, voffB); PG8_STAGE(PG8_SB(1, 1), b3 + hstepB, voffB); PG8_STAGE(PG8_SA(1, 0), a3, voffA);
            PG8_WAIT_V(8); PG8_WAIT_L(0); PG8_BAR; PG8_MMA(1, 0, At, B0); PG8_MMA(1, 1, At, B1); PG8_BAR; PG8_SCHED;
        }
        if constexpr (ALIGN_EPI) { if (wr == 0) PG8_BAR; }
        E(acc, cur, wr, wc, fr, fq);
        if (!has_next) break;
        E.init(acc, nxt, wr, wc, fr, fq);
        cur = nxt; cA = nA; cB = nB; ++ui;
        if constexpr (ALIGN_EPI) { if (wr == 1) PG8_BAR; }
    }
    PG8_WAIT_V(0);
    if constexpr (!ALIGN_EPI) { if (wr == 0) PG8_BAR; }
    PG8_BAR;
#undef PG8_SA
#undef PG8_SB
#undef PG8_STAGE
#undef PG8_LDA
#undef PG8_LDB
#undef PG8_MMA
#undef PG8_WAIT_V
#undef PG8_WAIT_L
#undef PG8_BAR
#undef PG8_SCHED
}
}
using pg8::Unit;

#define RAW_BAR() asm volatile("s_waitcnt lgkmcnt(0)\n\ts_barrier" ::: "memory")

struct EpiG1 {
    static constexpr bool PERM = true;
    typedef f32x4 acc_t;
    __device__ __forceinline__ void init(f32x4 (&acc)[2][2][4][2], const Unit&, int, int, int, int) const {
#pragma unroll
        for (int a = 0; a < 2; ++a)
#pragma unroll
            for (int b = 0; b < 2; ++b)
#pragma unroll
                for (int m = 0; m < 4; ++m)
#pragma unroll
                    for (int n = 0; n < 2; ++n) acc[a][b][m][n] = (f32x4){0.f, 0.f, 0.f, 0.f};
    }
    unsigned char* ws; const float* bgate; float* rsq0;
    __device__ __forceinline__ void operator()(const f32x4 (&acc)[2][2][4][2], const Unit& u, int wr, int wc, int fr, int fq) const {
        asm volatile("" : "+v"(fr), "+v"(fq));
        const int pn = u.pn; bf16_t* base; int ld, ct, act = 0; const float* bias = nullptr;
        if (pn < 4)       { base = (bf16_t*)(ws + WS_CQKV); ld = 1024; ct = pn; }
        else if (pn < 8)  { base = (bf16_t*)(ws + WS_QG);   ld = 1024; ct = pn - 4; }
        else if (pn < 12) { base = (bf16_t*)(ws + WS_KG);   ld = 1024; ct = pn - 8; }
        else if (pn < 20) { base = (bf16_t*)(ws + WS_VG);   ld = 2048; ct = pn - 12; }
        else              { base = (bf16_t*)(ws + WS_MISC); ld = 256;  ct = 0; }
        const int col0 = ct * 256 + wc * 32 + 8 * fq;
        f32x4 bv[2][2];
#pragma unroll
        for (int bj = 0; bj < 2; ++bj)
#pragma unroll
            for (int n = 0; n < 2; ++n) bv[bj][n] = bias ? *(const f32x4*)(bias + col0 + bj * 128 + 4 * n) : (f32x4){0.f, 0.f, 0.f, 0.f};
#pragma unroll
        for (int ai = 0; ai < 2; ++ai)
#pragma unroll
            for (int m = 0; m < 4; ++m) {
                const int row = u.pm * 256 + ai * 128 + wr * 64 + m * 16 + fr;
                bf16_t* rowp = base + (size_t)row * ld + col0;
                float ss = 0.f;
#pragma unroll
                for (int bj = 0; bj < 2; ++bj) {
                    f32x4 v0 = acc[ai][bj][m][0] + bv[bj][0], v1 = acc[ai][bj][m][1] + bv[bj][1];
                    if (act == 1) {
#pragma unroll
                        for (int j = 0; j < 4; ++j) { v0[j] = v0[j] * fast_sigmoid(v0[j]); v1[j] = v1[j] * fast_sigmoid(v1[j]); }
                    } else if (act == 2) {
#pragma unroll
                        for (int j = 0; j < 4; ++j) { v0[j] = fast_sigmoid(v0[j]); v1[j] = fast_sigmoid(v1[j]); }
                    }
#pragma unroll
                    for (int j = 0; j < 4; ++j) ss += v0[j] * v0[j] + v1[j] * v1[j];
                    u32x4 w; w.x = pkbf(v0[0], v0[1]); w.y = pkbf(v0[2], v0[3]); w.z = pkbf(v1[0], v1[1]); w.w = pkbf(v1[2], v1[3]);
                    *(u32x4*)(rowp + bj * 128) = w;
                }
                if (pn < 4) {
                    ss += __shfl_xor(ss, 16); ss += __shfl_xor(ss, 32);
                    if (fq == 0) rsq0[((size_t)row * 4 + pn) * 4 + wc] = ss;
                }
            }
    }
};

struct EpiG1i {
    static constexpr bool PERM = true;
    typedef i32x4 acc_t;
    __device__ __forceinline__ void init(i32x4 (&acc)[2][2][4][2], const Unit&, int, int, int, int) const {
#pragma unroll
        for (int a = 0; a < 2; ++a)
#pragma unroll
            for (int b = 0; b < 2; ++b)
#pragma unroll
                for (int m = 0; m < 4; ++m)
#pragma unroll
                    for (int n = 0; n < 2; ++n) acc[a][b][m][n] = (i32x4){0, 0, 0, 0};
    }
    unsigned char* ws; const float* bgate; const float* sh; const float* swg; float* rsq0;
    __device__ __forceinline__ void operator()(const i32x4 (&acc)[2][2][4][2], const Unit& u, int wr, int wc, int fr, int fq) const {
        asm volatile("" : "+v"(fr), "+v"(fq));
        const int pn = u.pn; bf16_t* base; int ld, ct, act = 0; const float* bias = nullptr;
        if (pn < 4)       { base = (bf16_t*)(ws + WS_CQKV); ld = 1024; ct = pn; }
        else if (pn < 8)  { base = (bf16_t*)(ws + WS_QG);   ld = 1024; ct = pn - 4; }
        else if (pn < 12) { base = (bf16_t*)(ws + WS_KG);   ld = 1024; ct = pn - 8; }
        else if (pn < 20) { base = (bf16_t*)(ws + WS_VG);   ld = 2048; ct = pn - 12; }
        else if (pn < 28) { base = (bf16_t*)(ws + WS_OG);   ld = 2048; ct = pn - 20; act = 1; }
        else if (pn < 36) { base = (bf16_t*)(ws + WS_GA);   ld = 2048; ct = pn - 28; act = 2; bias = bgate; }
        else if (pn < 44) { base = (bf16_t*)(ws + WS_GB);   ld = 2048; ct = pn - 36; act = 2; bias = bgate + 2048; }
        else              { base = (bf16_t*)(ws + WS_MISC); ld = 256;  ct = 0; }
        const int col0 = ct * 256 + wc * 32 + 8 * fq, colg = pn * 256 + wc * 32 + 8 * fq;
        f32x4 bv[2][2], sw[2][2];
#pragma unroll
        for (int bj = 0; bj < 2; ++bj)
#pragma unroll
            for (int n = 0; n < 2; ++n) { bv[bj][n] = bias ? *(const f32x4*)(bias + col0 + bj * 128 + 4 * n) : (f32x4){0.f, 0.f, 0.f, 0.f}; sw[bj][n] = *(const f32x4*)(swg + colg + bj * 128 + 4 * n); }
#pragma unroll
        for (int ai = 0; ai < 2; ++ai)
#pragma unroll
            for (int m = 0; m < 4; ++m) {
                const int row = u.pm * 256 + ai * 128 + wr * 64 + m * 16 + fr;
                const float shr = sh[row];
                bf16_t* rowp = base + (size_t)row * ld + col0;
                float ss = 0.f;
#pragma unroll
                for (int bj = 0; bj < 2; ++bj) {
                    f32x4 v0, v1;
#pragma unroll
                    for (int j = 0; j < 4; ++j) { v0[j] = (float)acc[ai][bj][m][0][j] * shr * sw[bj][0][j] + bv[bj][0][j]; v1[j] = (float)acc[ai][bj][m][1][j] * shr * sw[bj][1][j] + bv[bj][1][j]; }
                    if (act == 1) {
#pragma unroll
                        for (int j = 0; j < 4; ++j) { v0[j] = v0[j] * fast_sigmoid(v0[j]); v1[j] = v1[j] * fast_sigmoid(v1[j]); }
                    } else if (act == 2) {
#pragma unroll
                        for (int j = 0; j < 4; ++j) { v0[j] = fast_sigmoid(v0[j]); v1[j] = fast_sigmoid(v1[j]); }
                    }
#pragma unroll
                    for (int j = 0; j < 4; ++j) ss += v0[j] * v0[j] + v1[j] * v1[j];
                    u32x4 w; w.x = pkbf(v0[0], v0[1]); w.y = pkbf(v0[2], v0[3]); w.z = pkbf(v1[0], v1[1]); w.w = pkbf(v1[2], v1[3]);
                    *(u32x4*)(rowp + bj * 128) = w;
                }
                if (pn < 4) {
                    ss += __shfl_xor(ss, 16); ss += __shfl_xor(ss, 32);
                    if (fq == 0) rsq0[((size_t)row * 4 + pn) * 4 + wc] = ss;
                }
            }
    }
};

template <int MODE> struct EpiUp {
    static constexpr bool PERM = true;
    typedef f32x4 acc_t;
    __device__ __forceinline__ void init(f32x4 (&acc)[2][2][4][2], const Unit&, int, int, int, int) const {
#pragma unroll
        for (int a = 0; a < 2; ++a)
#pragma unroll
            for (int b = 0; b < 2; ++b)
#pragma unroll
                for (int m = 0; m < 4; ++m)
#pragma unroll
                    for (int n = 0; n < 2; ++n) acc[a][b][m][n] = (f32x4){0.f, 0.f, 0.f, 0.f};
    }
    LAS unsigned char* lds; const float* rsq0; int rsq_off; const float* gn; const float* gr; const float* rope; bf16_t* out0; bf16_t* out1;
    __device__ __forceinline__ void operator()(const f32x4 (&acc)[2][2][4][2], const Unit& u, int wr, int wc, int fr, int fq) const {
        asm volatile("" : "+v"(fr), "+v"(fq));
        auto rcf = [&](int ai, int m) -> float {
            const int row = u.pm * 256 + ai * 128 + wr * 64 + m * 16 + fr;
            const f32x4 a = *(const f32x4*)(rsq0 + (size_t)row * 16 + rsq_off), b = *(const f32x4*)(rsq0 + (size_t)row * 16 + rsq_off + 4);
            const float s = (a[0] + a[1]) + (a[2] + a[3]) + (b[0] + b[1]) + (b[2] + b[3]);
            return __builtin_amdgcn_rsqf(s * (1.f / 512.f) + EPS);
        };
        const int pn = u.pn;
        if (pn < 8) {
            LAS float* X = (LAS float*)(lds + XCH_OFF);
#pragma unroll
            for (int ai = 0; ai < 2; ++ai)
#pragma unroll
                for (int m = 0; m < 4; ++m) {
                    const float rcv = rcf(ai, m);
#pragma unroll
                    for (int bj = 0; bj < 2; ++bj) {
                        float s = 0.f;
#pragma unroll
                        for (int n = 0; n < 2; ++n)
#pragma unroll
                            for (int j = 0; j < 4; ++j) { const float v = acc[ai][bj][m][n][j] * rcv; s += v * v; }
                        s += __shfl_xor(s, 16); s += __shfl_xor(s, 32);
                        if (fq == 0) X[((ai * 128 + wr * 64 + m * 16 + fr) * 2 + bj) * 4 + wc] = s;
                    }
                    asm volatile("" ::: "memory");
                }
            RAW_BAR();
            const int d0 = wc * 32 + 8 * fq;
            const f32x4 g0 = *(const f32x4*)(gn + d0), g1 = *(const f32x4*)(gn + d0 + 4);
#pragma unroll
            for (int ai = 0; ai < 2; ++ai)
#pragma unroll
                for (int m = 0; m < 4; ++m) {
                    const int rl = ai * 128 + wr * 64 + m * 16 + fr; const size_t row = (size_t)u.pm * 256 + rl;
                    const float rcv = rcf(ai, m);
#pragma unroll
                    for (int bj = 0; bj < 2; ++bj) {
                        const f32x4 t = *(const LAS f32x4*)(X + (rl * 2 + bj) * 4);
                        const float tot = (t[0] + t[1]) + (t[2] + t[3]);
                        float rs = __builtin_amdgcn_rsqf(tot * (1.f / 128.f) + EPS) * rcv;
                        if (MODE == 0) rs *= QSCALE;
                        const f32x4 v0 = acc[ai][bj][m][0] * rs * g0, v1 = acc[ai][bj][m][1] * rs * g1;
                        u32x4 w; w.x = pkbf(v0[0], v0[1]); w.y = pkbf(v0[2], v0[3]); w.z = pkbf(v1[0], v1[1]); w.w = pkbf(v1[2], v1[3]);
                        const int head = 2 * pn + bj;
                        if (MODE == 0) *(u32x4*)(out0 + row * 3072 + head * 192 + d0) = w;
                        else           *(u32x4*)(out0 + row * 2048 + head * 128 + d0) = w;
                    }
                    asm volatile("" ::: "memory");
                }
        } else if (MODE == 1) {
            const int d0 = wc * 32 + 8 * fq;
#pragma unroll
            for (int ai = 0; ai < 2; ++ai)
#pragma unroll
                for (int m = 0; m < 4; ++m) {
                    const size_t row = (size_t)u.pm * 256 + ai * 128 + wr * 64 + m * 16 + fr;
                    const float rcv = rcf(ai, m);
#pragma unroll
                    for (int bj = 0; bj < 2; ++bj) {
                        const f32x4 v0 = acc[ai][bj][m][0] * rcv, v1 = acc[ai][bj][m][1] * rcv;
                        u32x4 w; w.x = pkbf(v0[0], v0[1]); w.y = pkbf(v0[2], v0[3]); w.z = pkbf(v1[0], v1[1]); w.w = pkbf(v1[2], v1[3]);
                        const int head = 2 * (pn - 8) + bj;
                        *(u32x4*)(out1 + row * 2048 + head * 128 + d0) = w;
                    }
                    asm volatile("" ::: "memory");
                }
        } else {
            const int head = 4 * (pn - 8) + wc;
#pragma unroll
            for (int ai = 0; ai < 2; ++ai)
#pragma unroll
                for (int m = 0; m < 4; ++m) {
                    const size_t row = (size_t)u.pm * 256 + ai * 128 + wr * 64 + m * 16 + fr;
                    const float rcv = rcf(ai, m);
                    float s = 0.f;
#pragma unroll
                    for (int bj = 0; bj < 2; ++bj)
#pragma unroll
                        for (int n = 0; n < 2; ++n)
#pragma unroll
                            for (int j = 0; j < 4; ++j) { const float v = acc[ai][bj][m][n][j] * rcv; s += v * v; }
                    s += __shfl_xor(s, 16); s += __shfl_xor(s, 32);
                    const float rs = __builtin_amdgcn_rsqf(s * (1.f / 64.f) + EPS) * rcv;
#pragma unroll
                    for (int bj = 0; bj < 2; ++bj) {
                        unsigned wv[4];
#pragma unroll
                        for (int n = 0; n < 2; ++n) {
                            const int i0 = 16 * bj + 4 * fq + 2 * n;
                            const f32x2_t cs = *(const f32x2_t*)(rope + row * 64 + i0), sn = *(const f32x2_t*)(rope + row * 64 + 32 + i0);
                            const f32x2_t ga = *(const f32x2_t*)(gr + i0), gb = *(const f32x2_t*)(gr + 32 + i0);
                            const f32x4 a = acc[ai][bj][m][n];
                            const float x1a = a[0] * rs * ga[0], x2a = a[1] * rs * gb[0], x1b = a[2] * rs * ga[1], x2b = a[3] * rs * gb[1];
                            const float o0 = (x1a * cs[0] - x2a * sn[0]) * QSCALE, o1 = (x2a * cs[0] + x1a * sn[0]) * QSCALE;
                            const float o2 = (x1b * cs[1] - x2b * sn[1]) * QSCALE, o3 = (x2b * cs[1] + x1b * sn[1]) * QSCALE;
                            wv[2 * n] = pkbf(o0, o1); wv[2 * n + 1] = pkbf(o2, o3);
                        }
                        u32x4 w; w.x = wv[0]; w.y = wv[1]; w.z = wv[2]; w.w = wv[3];
                        *(u32x4*)(out0 + row * 3072 + head * 192 + 128 + 32 * bj + 8 * fq) = w;
                    }
                    asm volatile("" ::: "memory");
                }
        }
    }
};

struct EpiOut {
    static constexpr bool PERM = false;
    typedef f32x4 acc_t;
    const float* x; float* out; bf16_t* x1b; float* rsq1;
    __device__ __forceinline__ void init(f32x4 (&acc)[2][2][4][2], const Unit& u, int wr, int wc, int fr, int fq) const {
        asm volatile("" : "+v"(fr), "+v"(fq));
        const int col0 = u.pn * 256 + wc * 32 + 4 * fq;
#pragma unroll
        for (int ai = 0; ai < 2; ++ai)
#pragma unroll
            for (int m = 0; m < 4; ++m) { const size_t off = ((size_t)u.pm * 256 + ai * 128 + wr * 64 + m * 16 + fr) * 2048 + col0;
#pragma unroll
                for (int bj = 0; bj < 2; ++bj)
#pragma unroll
                    for (int n = 0; n < 2; ++n) acc[ai][bj][m][n] = *(const f32x4*)(x + off + bj * 128 + n * 16); }
    }
    __device__ __forceinline__ void operator()(const f32x4 (&acc)[2][2][4][2], const Unit& u, int wr, int wc, int fr, int fq) const {
        asm volatile("" : "+v"(fr), "+v"(fq));
        const int col0 = u.pn * 256 + wc * 32 + 4 * fq;
#pragma unroll
        for (int ai = 0; ai < 2; ++ai)
#pragma unroll
            for (int m = 0; m < 4; ++m) {
                const size_t row = (size_t)u.pm * 256 + ai * 128 + wr * 64 + m * 16 + fr; const size_t off = row * 2048 + col0;
                float ss = 0.f;
#pragma unroll
                for (int bj = 0; bj < 2; ++bj)
#pragma unroll
                    for (int n = 0; n < 2; ++n) {
                        const f32x4 v = acc[ai][bj][m][n];
                        *(f32x4*)(out + off + bj * 128 + n * 16) = v;
                        u32x2 w; w.x = pkbf(v[0], v[1]); w.y = pkbf(v[2], v[3]);
                        *(u32x2*)(x1b + off + bj * 128 + n * 16) = w;
                        ss += (v[0] * v[0] + v[1] * v[1]) + (v[2] * v[2] + v[3] * v[3]);
                    }
                ss += __shfl_xor(ss, 16); ss += __shfl_xor(ss, 32);
                if (fq == 0) rsq1[row * 32 + u.pn * 4 + wc] = ss;
            }
    }
};
struct EpiOutI {
    static constexpr bool PERM = false;
    typedef i32x4 acc_t;
    __device__ __forceinline__ void init(i32x4 (&acc)[2][2][4][2], const Unit&, int, int, int, int) const {
#pragma unroll
        for (int a = 0; a < 2; ++a)
#pragma unroll
            for (int b = 0; b < 2; ++b)
#pragma unroll
                for (int m = 0; m < 4; ++m)
#pragma unroll
                    for (int n = 0; n < 2; ++n) acc[a][b][m][n] = (i32x4){0, 0, 0, 0};
    }
    const float* x; float* out; bf16_t* x1b; float* rsq1; const float* sm; const float* swo;
    __device__ __forceinline__ void operator()(const i32x4 (&acc)[2][2][4][2], const Unit& u, int wr, int wc, int fr, int fq) const {
        asm volatile("" : "+v"(fr), "+v"(fq));
        const int col0 = u.pn * 256 + wc * 32 + 4 * fq;
        f32x4 sw[2][2];
#pragma unroll
        for (int bj = 0; bj < 2; ++bj)
#pragma unroll
            for (int n = 0; n < 2; ++n) sw[bj][n] = *(const f32x4*)(swo + col0 + bj * 128 + n * 16);
#pragma unroll
        for (int ai = 0; ai < 2; ++ai)
#pragma unroll
            for (int m = 0; m < 4; ++m) {
                const size_t row = (size_t)u.pm * 256 + ai * 128 + wr * 64 + m * 16 + fr; const size_t off = row * 2048 + col0;
                const float smr = sm[row];
                f32x4 xv[2][2];
#pragma unroll
                for (int bj = 0; bj < 2; ++bj)
#pragma unroll
                    for (int n = 0; n < 2; ++n) xv[bj][n] = *(const f32x4*)(x + off + bj * 128 + n * 16);
                float ss = 0.f;
#pragma unroll
                for (int bj = 0; bj < 2; ++bj)
#pragma unroll
                    for (int n = 0; n < 2; ++n) {
                        f32x4 v;
#pragma unroll
                        for (int j = 0; j < 4; ++j) v[j] = xv[bj][n][j] + (float)acc[ai][bj][m][n][j] * smr * sw[bj][n][j];
                        *(f32x4*)(out + off + bj * 128 + n * 16) = v;
                        u32x2 w; w.x = pkbf(v[0], v[1]); w.y = pkbf(v[2], v[3]);
                        *(u32x2*)(x1b + off + bj * 128 + n * 16) = w;
                        ss += (v[0] * v[0] + v[1] * v[1]) + (v[2] * v[2] + v[3] * v[3]);
                    }
                ss += __shfl_xor(ss, 16); ss += __shfl_xor(ss, 32);
                if (fq == 0) rsq1[row * 32 + u.pn * 4 + wc] = ss;
                if (m & 1) asm volatile("" ::: "memory");
            }
    }
};
struct EpiQP {
    static constexpr bool PERM = true;
    typedef f32x4 acc_t;
    __device__ __forceinline__ void init(f32x4 (&acc)[2][2][4][2], const Unit&, int, int, int, int) const {
#pragma unroll
        for (int a = 0; a < 2; ++a)
#pragma unroll
            for (int b = 0; b < 2; ++b)
#pragma unroll
                for (int m = 0; m < 4; ++m)
#pragma unroll
                    for (int n = 0; n < 2; ++n) acc[a][b][m][n] = (f32x4){0.f, 0.f, 0.f, 0.f};
    }
    bf16_t* qp;
    __device__ __forceinline__ void operator()(const f32x4 (&acc)[2][2][4][2], const Unit& u, int wr, int wc, int fr, int fq) const {
        asm volatile("" : "+v"(fr), "+v"(fq));
        const int col0 = u.pn * 256 + wc * 32 + 8 * fq;
#pragma unroll
        for (int ai = 0; ai < 2; ++ai)
#pragma unroll
            for (int m = 0; m < 4; ++m) {
                const size_t row = (size_t)u.pm * 256 + ai * 128 + wr * 64 + m * 16 + fr;
#pragma unroll
                for (int bj = 0; bj < 2; ++bj) {
                    const f32x4 v0 = acc[ai][bj][m][0], v1 = acc[ai][bj][m][1];
                    u32x4 w; w.x = pkbf(v0[0], v0[1]); w.y = pkbf(v0[2], v0[3]); w.z = pkbf(v1[0], v1[1]); w.w = pkbf(v1[2], v1[3]);
                    *(u32x4*)(qp + row * 2048 + col0 + bj * 128) = w;
                }
            }
    }
};

template <class CM>
__device__ __forceinline__ void p0_transpose_item(const float* W, int ldw, int K, int nblk, bf16_t* WT, LAS float* scr, int item, int lane, const CM& colmap, const float* kscale) {
    const int kb = item / nblk, nb = item % nblk, k0 = 64 * kb, n0 = 32 * nb;
    const int src = colmap(n0 + (lane & 31));
    float vv[32];
#pragma unroll
    for (int i = 0; i < 32; ++i) { const int kk = 2 * i + (lane >> 5); vv[i] = (src >= 0) ? W[(size_t)(k0 + kk) * ldw + src] : 0.f; }
    if (kscale) {
#pragma unroll
        for (int i = 0; i < 32; ++i) vv[i] *= kscale[k0 + 2 * i + (lane >> 5)];
    }
#pragma unroll
    for (int i = 0; i < 32; ++i) scr[(2 * i + (lane >> 5)) * 33 + (lane & 31)] = vv[i];
    asm volatile("s_waitcnt lgkmcnt(0)" ::: "memory");
    const int c = lane & 7;
#pragma unroll
    for (int j = 0; j < 4; ++j) { const int n = (lane >> 3) + 8 * j; const LAS float* s = scr + (8 * c) * 33 + n;
        u32x4 o; o.x = pkbf(s[0 * 33], s[1 * 33]); o.y = pkbf(s[2 * 33], s[3 * 33]); o.z = pkbf(s[4 * 33], s[5 * 33]); o.w = pkbf(s[6 * 33], s[7 * 33]);
        *(u32x4*)(WT + (size_t)(n0 + n) * K + k0 + 8 * c) = o; }
    asm volatile("s_waitcnt lgkmcnt(0)" ::: "memory");
}
template <class CM>
__device__ __forceinline__ void p0_transpose_item64(const float* W, int ldw, int K, int nblk, bf16_t* WT, LAS float* scr, int item, int lane, const CM& colmap, const float* kscale) {
    const int kb = item / nblk, nb = item % nblk, k0 = 64 * kb, n0 = 64 * nb;
    const int c4 = lane & 15, rr = lane >> 4;
    const int src = colmap(n0 + 4 * c4);
    f32x4 vv[16];
#pragma unroll
    for (int i = 0; i < 16; ++i) { const int kk = 4 * i + rr; vv[i] = (src >= 0) ? *(const f32x4*)(W + (size_t)(k0 + kk) * ldw + src) : (f32x4){0.f, 0.f, 0.f, 0.f}; }
    if (kscale) {
#pragma unroll
        for (int i = 0; i < 16; ++i) vv[i] = vv[i] * kscale[k0 + 4 * i + rr];
    }
#pragma unroll
    for (int i = 0; i < 16; ++i) { LAS float* d = scr + (4 * i + rr) * 65 + 4 * c4; d[0] = vv[i][0]; d[1] = vv[i][1]; d[2] = vv[i][2]; d[3] = vv[i][3]; }
    asm volatile("s_waitcnt lgkmcnt(0)" ::: "memory");
    const int c = lane & 7;
#pragma unroll
    for (int j = 0; j < 8; ++j) { const int n = (lane >> 3) + 8 * j; const LAS float* sp = scr + (8 * c) * 65 + n;
        u32x4 o; o.x = pkbf(sp[0 * 65], sp[1 * 65]); o.y = pkbf(sp[2 * 65], sp[3 * 65]); o.z = pkbf(sp[4 * 65], sp[5 * 65]); o.w = pkbf(sp[6 * 65], sp[7 * 65]);
        *(u32x4*)(WT + (size_t)(n0 + n) * K + k0 + 8 * c) = o; }
    asm volatile("s_waitcnt lgkmcnt(0)" ::: "memory");
}
__device__ __forceinline__ int cm_win(int n) { if (n < 1024) return n; if (n < 5120) return n + 64; if (n < 11264) return n + 80; if (n < 11328) return 1024 + (n - 11264); if (n < 11344) return 5184 + (n - 11328); return -1; }
template <bool WIN> __device__ __forceinline__ void p0_gate_colmax_item(const float* W, int ldw, int nblk, float* PMAX, int item, int lane) {
    const int kb = item / nblk, nb = item % nblk, k0 = 64 * kb, n0 = 64 * nb, c4 = lane & 15, rr = lane >> 4, ncol = 64 * nblk;
    const int src = WIN ? cm_win(n0 + 4 * c4) : n0 + 4 * c4;
    f32x4 mx = (f32x4){0.f, 0.f, 0.f, 0.f};
#pragma unroll
    for (int i = 0; i < 16; ++i) { const f32x4 v = (src >= 0) ? *(const f32x4*)(W + (size_t)(k0 + 4 * i + rr) * ldw + src) : (f32x4){0.f, 0.f, 0.f, 0.f};
        mx[0] = fmaxf(mx[0], fabsf(v[0])); mx[1] = fmaxf(mx[1], fabsf(v[1])); mx[2] = fmaxf(mx[2], fabsf(v[2])); mx[3] = fmaxf(mx[3], fabsf(v[3])); }
#pragma unroll
    for (int j = 0; j < 4; ++j) { mx[j] = fmaxf(mx[j], __shfl_xor(mx[j], 16)); mx[j] = fmaxf(mx[j], __shfl_xor(mx[j], 32)); }
    if (rr == 0) *(f32x4*)(PMAX + (size_t)kb * ncol + n0 + 4 * c4) = mx;
}
template <bool WIN> __device__ __forceinline__ void p0_gate_quant_item(const float* W, int ldw, int nblk, const float* PMAX, unsigned char* WG8, float* SWG, LAS float* scr, int item, int lane) {
    const int kb = item / nblk, nb = item % nblk, k0 = 64 * kb, n0 = 64 * nb, c4 = lane & 15, rr = lane >> 4, ncol = 64 * nblk;
    const int src = WIN ? cm_win(n0 + 4 * c4) : n0 + 4 * c4;
    float cm = 0.f;
#pragma unroll 8
    for (int b = 0; b < 32; ++b) cm = fmaxf(cm, PMAX[(size_t)b * ncol + n0 + lane]);
    cm = fmaxf(cm, 1e-30f);
    if (kb == 0) SWG[n0 + lane] = cm * (1.f / 127.f);
    f32x4 vv[16];
#pragma unroll
    for (int i = 0; i < 16; ++i) vv[i] = (src >= 0) ? *(const f32x4*)(W + (size_t)(k0 + 4 * i + rr) * ldw + src) : (f32x4){0.f, 0.f, 0.f, 0.f};
#pragma unroll
    for (int i = 0; i < 16; ++i) { LAS float* d = scr + (4 * i + rr) * 65 + 4 * c4; d[0] = vv[i][0]; d[1] = vv[i][1]; d[2] = vv[i][2]; d[3] = vv[i][3]; }
    asm volatile("s_waitcnt lgkmcnt(0)" ::: "memory");
    const int c = lane & 3;
#pragma unroll
    for (int j = 0; j < 4; ++j) { const int n = (lane >> 2) + 16 * j; const LAS float* sp = scr + (16 * c) * 65 + n;
        const float inv = 127.f / __shfl(cm, n);
        u32x4 o;
        o.x = q8pack(sp[0 * 65], sp[1 * 65], sp[2 * 65], sp[3 * 65], inv); o.y = q8pack(sp[4 * 65], sp[5 * 65], sp[6 * 65], sp[7 * 65], inv);
        o.z = q8pack(sp[8 * 65], sp[9 * 65], sp[10 * 65], sp[11 * 65], inv); o.w = q8pack(sp[12 * 65], sp[13 * 65], sp[14 * 65], sp[15 * 65], inv);
        *(u32x4*)(WG8 + (size_t)(n0 + n) * 2048 + k0 + 16 * c) = o; }
    asm volatile("s_waitcnt lgkmcnt(0)" ::: "memory");
}
struct CmWin { __device__ int operator()(int n) const { if (n < 1024) return n; if (n < 5120) return n + 64; if (n < 11264) return n + 80; if (n < 11328) return 1024 + (n - 11264); if (n < 11344) return 5184 + (n - 11328); return -1; } };
struct CmWuq { __device__ int operator()(int n) const { if (n < 2048) return (n >> 7) * 192 + (n & 127);
    const int m = n - 2048, tile = m >> 8, cl = m & 255, hl = (cl >> 5) & 3, pos = 32 * (cl >> 7) + (cl & 31), head = 4 * tile + hl; return head * 192 + 128 + (pos >> 1) + 32 * (pos & 1); } };
struct CmWukv { __device__ int operator()(int n) const { if (n < 2048) return (n >> 7) * 256 + (n & 127); const int m = n - 2048; return (m >> 7) * 256 + 128 + (m & 127); } };
struct CmId { __device__ int operator()(int n) const { return n; } };

struct Args { const void* in[22]; float* out; unsigned char* ws; int ph_lo, ph_hi; };

__device__ __forceinline__ s16x4 tr_read(const LAS unsigned char* p) { return __builtin_bit_cast(s16x4, __builtin_amdgcn_ds_read_tr16_b64_v4i16((LAS v4i16_t*)p)); }
__device__ __forceinline__ bf16x8 cat8(s16x4 lo, s16x4 hi) { return (bf16x8){lo[0], lo[1], lo[2], lo[3], hi[0], hi[1], hi[2], hi[3]}; }
__device__ __forceinline__ int crow(int r, int hi) { return (r & 3) + 8 * (r >> 2) + 4 * hi; }
__device__ __forceinline__ unsigned f2key(float f) { const unsigned u = __float_as_uint(f); return (u & 0x80000000u) ? ~u : (u | 0x80000000u); }
__device__ __forceinline__ float key2f(unsigned k) { const unsigned u = (k & 0x80000000u) ? (k & 0x7fffffffu) : ~k; return __uint_as_float(u); }
__device__ __forceinline__ unsigned umed3(unsigned a, unsigned b, unsigned c) { const unsigned mx = a > b ? a : b, mn = a > b ? b : a; const unsigned t = mx < c ? mx : c; return mn > t ? mn : t; }

constexpr int GL_QS = 0, GL_KS = 33792, GL_VS = 67584, GL_ST = 76800, GL_AB = 110592, GL_OB = 119808, GL_DEC = 137216;
__device__ __forceinline__ void gla_scan_unit(LAS unsigned char* lds, unsigned char* ws, const float* g_on, int b, int hh, int sl, bool dummy) {
    int tid_ = threadIdx.x; asm volatile("" : "+v"(tid_));
    const int tid = tid_, lane = tid & 63, wid = __builtin_amdgcn_readfirstlane(tid >> 6), l15 = lane & 15, g = lane >> 4;
    const bf16_t* QG = (const bf16_t*)(ws + WS_QG); const bf16_t* KG = (const bf16_t*)(ws + WS_KG); const bf16_t* VG = (const bf16_t*)(ws + WS_VG);
    const bf16_t* OG = (const bf16_t*)(ws + WS_OG); bf16_t* GB = (bf16_t*)(ws + WS_GB); const float* DECG = (const float*)(ws + WS_DEC); float* SSQ = (float*)(ws + WS_SSQ);
    const bf16_t* ABUF = (const bf16_t*)(ws + WS_ABUF);
    bf16_t* GBo = dummy ? (bf16_t*)(ws + WS_CQKV) : GB; float* SSQo = dummy ? (float*)(ws + WS_WIN + 100 * MiB) : SSQ; const size_t omask = dummy ? (size_t)0xffffff : ~(size_t)0;
    f32x4 S[2][4];
#pragma unroll
    for (int a = 0; a < 2; ++a)
#pragma unroll
        for (int v = 0; v < 4; ++v) S[a][v] = (f32x4){0.f, 0.f, 0.f, 0.f};
    u32x4 pq[4], pk[4], pv, pab, pgb, pog; f32x4 pd = (f32x4){0.f, 0.f, 0.f, 0.f};
    const size_t tb = (size_t)b * SEQ;
    const int oi = tid >> 3, opart = tid & 7, oe0 = sl * 64 + 8 * opart;
    const f32x4 gn0 = *(const f32x4*)(g_on + oe0), gn1 = *(const f32x4*)(g_on + oe0 + 4);
    auto issue = [&](int c) {
        const size_t t0 = tb + (size_t)c * 64;
#pragma unroll
        for (int q = 0; q < 4; ++q) { const int ci = tid + 512 * q, row = ci >> 5, cc = ci & 31;
            pq[q] = *(const u32x4*)(QG + (t0 + row) * 1024 + hh * 256 + cc * 8); pk[q] = *(const u32x4*)(KG + (t0 + row) * 1024 + hh * 256 + cc * 8); }
        { const int row = tid >> 3, cc = tid & 7; pv = *(const u32x4*)(VG + (t0 + row) * 2048 + hh * 512 + sl * 64 + cc * 8);
          pab = *(const u32x4*)(ABUF + ((size_t)((b * 4 + hh) * 32 + c)) * 4096 + row * 64 + cc * 8); }
        if (tid < 64) pd = *(const f32x4*)(DECG + ((size_t)((b * 4 + hh) * 32 + c)) * 256 + 4 * tid);
        { const size_t off = (t0 + oi) * 2048 + hh * 512 + oe0; pgb = *(const u32x4*)(GB + off); pog = *(const u32x4*)(OG + off); }
    };
    issue(0);
    for (int c = 0; c < 32; ++c) {
#ifdef REP_GA
        for (int rep_ = 0; rep_ < 2; ++rep_) {
#else
        {
#endif
#pragma unroll
        for (int q = 0; q < 4; ++q) { const int ci = tid + 512 * q, row = ci >> 5, cc = ci & 31;
            *(LAS u32x4*)(lds + GL_QS + row * 528 + cc * 16) = pq[q]; *(LAS u32x4*)(lds + GL_KS + row * 528 + cc * 16) = pk[q]; }
        { const int row = tid >> 3, cc = tid & 7; *(LAS u32x4*)(lds + GL_VS + row * 144 + cc * 16) = pv; *(LAS u32x4*)(lds + GL_AB + row * 144 + cc * 16) = pab; }
        if (tid < 64) *(LAS f32x4*)(lds + GL_DEC + 16 * tid) = pd;
#pragma unroll
        for (int a = 0; a < 2; ++a)
#pragma unroll
            for (int vt = 0; vt < 4; ++vt) { const int dt = 2 * wid + a; u32x2 w; w.x = pkbf(S[a][vt][0], S[a][vt][1]); w.y = pkbf(S[a][vt][2], S[a][vt][3]);
                *(LAS u32x2*)(lds + GL_ST + (16 * vt + l15) * 528 + (16 * dt + 4 * g) * 2) = w; }
        RAW_BAR();
        }
        const u32x4 cgb = pgb, cog = pog;
        if (c + 1 < 32) issue(c + 1);
#ifdef REP_GF1
        for (int rep_ = 0; rep_ < 2; ++rep_)
#endif
        {
            const int it = wid >> 1;
#pragma unroll
            for (int vv = 0; vv < 2; ++vv) {
                const int vt = 2 * (wid & 1) + vv;
                f32x4 o = (f32x4){0.f, 0.f, 0.f, 0.f};
#pragma unroll
                for (int ks = 0; ks < 8; ++ks) {
                    const bf16x8 fa = *(const LAS bf16x8*)(lds + GL_QS + (16 * it + l15) * 528 + (32 * ks + 8 * g) * 2);
                    const bf16x8 fb = *(const LAS bf16x8*)(lds + GL_ST + (16 * vt + l15) * 528 + (32 * ks + 8 * g) * 2);
                    o = __builtin_amdgcn_mfma_f32_16x16x32_bf16(fa, fb, o, 0, 0, 0);
                }
#pragma unroll
                for (int ks = 0; ks < 2; ++ks) {
                    const bf16x8 fa = *(const LAS bf16x8*)(lds + GL_AB + (16 * it + l15) * 144 + (32 * ks + 8 * g) * 2);
                    const LAS unsigned char* vp = lds + GL_VS + (32 * ks + 8 * g + (l15 >> 2)) * 144 + (16 * vt + 4 * (l15 & 3)) * 2;
                    const bf16x8 fb = cat8(tr_read(vp), tr_read(vp + 4 * 144));
                    o = __builtin_amdgcn_mfma_f32_16x16x32_bf16(fa, fb, o, 0, 0, 0);
                }
#pragma unroll
                for (int r = 0; r < 4; ++r) *(LAS float*)(lds + GL_OB + ((16 * it + 4 * g + r) * 68 + 16 * vt + l15) * 4) = o[r];
            }
        }
        {
            bf16x8 fv[4][2];
#pragma unroll
            for (int vt = 0; vt < 4; ++vt)
#pragma unroll
                for (int ks = 0; ks < 2; ++ks) { const LAS unsigned char* vp = lds + GL_VS + (32 * ks + 8 * g + (l15 >> 2)) * 144 + (16 * vt + 4 * (l15 & 3)) * 2;
                    fv[vt][ks] = cat8(tr_read(vp), tr_read(vp + 4 * 144)); }
#pragma unroll
            for (int a = 0; a < 2; ++a) {
                const int dt = 2 * wid + a;
#pragma unroll
                for (int ks = 0; ks < 2; ++ks) {
                    const LAS unsigned char* kp = lds + GL_KS + (32 * ks + 8 * g + (l15 >> 2)) * 528 + (16 * dt + 4 * (l15 & 3)) * 2;
                    const bf16x8 fk = cat8(tr_read(kp), tr_read(kp + 4 * 528));
#pragma unroll
                    for (int vt = 0; vt < 4; ++vt) S[a][vt] = __builtin_amdgcn_mfma_f32_16x16x32_bf16(fk, fv[vt][ks], S[a][vt], 0, 0, 0);
                }
                const f32x4 dc = *(const LAS f32x4*)(lds + GL_DEC + (16 * dt + 4 * g) * 4);
#pragma unroll
                for (int vt = 0; vt < 4; ++vt) S[a][vt] = S[a][vt] * dc;
            }
        }
        RAW_BAR();
        {
            const int i = oi, part = opart; const size_t t = tb + (size_t)c * 64 + i;
            const f32x4 o0 = *(const LAS f32x4*)(lds + GL_OB + (i * 68 + 8 * part) * 4), o1 = *(const LAS f32x4*)(lds + GL_OB + (i * 68 + 8 * part + 4) * 4);
            float ss = (o0[0] * o0[0] + o0[1] * o0[1]) + (o0[2] * o0[2] + o0[3] * o0[3]) + (o1[0] * o1[0] + o1[1] * o1[1]) + (o1[2] * o1[2] + o1[3] * o1[3]);
            ss += __shfl_xor(ss, 1); ss += __shfl_xor(ss, 2); ss += __shfl_xor(ss, 4);
            if (part == 0) SSQo[(t * 4 + hh) * 8 + sl] = ss;
            const size_t off = t * 2048 + hh * 512 + oe0;
            const u32x4 gb = cgb, og = cog;
            u32x4 w;
            w.x = pkbf(o0[0] * bf_lo(gb.x) * bf_lo(og.x) * gn0[0], o0[1] * bf_hi(gb.x) * bf_hi(og.x) * gn0[1]);
            w.y = pkbf(o0[2] * bf_lo(gb.y) * bf_lo(og.y) * gn0[2], o0[3] * bf_hi(gb.y) * bf_hi(og.y) * gn0[3]);
            w.z = pkbf(o1[0] * bf_lo(gb.z) * bf_lo(og.z) * gn1[0], o1[1] * bf_hi(gb.z) * bf_hi(og.z) * gn1[1]);
            w.w = pkbf(o1[2] * bf_lo(gb.w) * bf_lo(og.w) * gn1[2], o1[3] * bf_hi(gb.w) * bf_hi(og.w) * gn1[3]);
            *(u32x4*)(GBo + (off & omask)) = w;
        }
    }
    __syncthreads();
}

constexpr int AT_KSTR = 400, AT_VSTR = 320, AT_VOFF = 64 * AT_KSTR, AT_BUF = 64 * AT_KSTR + 64 * AT_VSTR;
__device__ __forceinline__ void attn_unit(LAS unsigned char* lds, const bf16_t* Qh, const bf16_t* Kh, const bf16_t* Vh, const bf16_t* KPE, const bf16_t* GAin, bf16_t* GAout, size_t omask, int b, int hh, int qb) {
    int tid_ = threadIdx.x; asm volatile("" : "+v"(tid_));
    const int tid = tid_, lane = tid & 63, wid = __builtin_amdgcn_readfirstlane(tid >> 6), r32 = lane & 31, hi = lane >> 5;
    const size_t tb = (size_t)b * SEQ; const int q0 = qb * 256;
    const int NT = (q0 + 256) / 64;
    u32x4 sk[2], sr, sv[2];
    auto issue = [&](int jt) {
        const size_t t0 = tb + (size_t)jt * 64;
#pragma unroll
        for (int q = 0; q < 2; ++q) { const int ci = tid + 512 * q, row = ci >> 4, cc = ci & 15;
            sk[q] = *(const u32x4*)(Kh + (t0 + row) * 2048 + hh * 128 + cc * 8); sv[q] = *(const u32x4*)(Vh + (t0 + row) * 2048 + hh * 128 + cc * 8); }
        { const int row = tid >> 3, cc = tid & 7; sr = *(const u32x4*)(KPE + (t0 + row) * 64 + cc * 8); }
    };
    auto stash = [&](int buf) {
        LAS unsigned char* kb = lds + buf * AT_BUF; LAS unsigned char* vb = kb + AT_VOFF;
#pragma unroll
        for (int q = 0; q < 2; ++q) { const int ci = tid + 512 * q, row = ci >> 4, cc = ci & 15;
            *(LAS u32x4*)(kb + row * AT_KSTR + cc * 16) = sk[q]; *(LAS u32x4*)(vb + row * AT_VSTR + cc * 16) = sv[q]; }
        { const int row = tid >> 3, cc = tid & 7; *(LAS u32x4*)(kb + row * AT_KSTR + 256 + cc * 16) = sr; }
    };
    issue(0);
    bf16x8 qf[12];
    { const bf16_t* qp = Qh + (tb + q0 + wid * 32 + r32) * 3072 + hh * 192 + hi * 8;
#pragma unroll
      for (int d0 = 0; d0 < 12; ++d0) qf[d0] = *(const bf16x8*)(qp + d0 * 16); }
    f32x16 o[4];
#pragma unroll
    for (int d = 0; d < 4; ++d)
#pragma unroll
        for (int r = 0; r < 16; ++r) o[d][r] = 0.f;
    float mrun = -1e30f, lrun = 0.f;
    stash(0);
    if (NT > 1) issue(1);
    RAW_BAR();
    const int qidx = q0 + wid * 32 + r32;
    for (int jt = 0; jt < NT; ++jt) {
        const int buf = jt & 1;
        const LAS unsigned char* kb = lds + buf * AT_BUF; const LAS unsigned char* vb = kb + AT_VOFF;
        f32x16 p0, p1;
#pragma unroll
        for (int r = 0; r < 16; ++r) { p0[r] = 0.f; p1[r] = 0.f; }
        __builtin_amdgcn_s_setprio(1);
#pragma unroll
        for (int d0 = 0; d0 < 12; ++d0) {
            const bf16x8 k0 = *(const LAS bf16x8*)(kb + r32 * AT_KSTR + (16 * d0 + 8 * hi) * 2);
            const bf16x8 k1 = *(const LAS bf16x8*)(kb + (32 + r32) * AT_KSTR + (16 * d0 + 8 * hi) * 2);
            p0 = __builtin_amdgcn_mfma_f32_32x32x16_bf16(k0, qf[d0], p0, 0, 0, 0);
            p1 = __builtin_amdgcn_mfma_f32_32x32x16_bf16(k1, qf[d0], p1, 0, 0, 0);
        }
        __builtin_amdgcn_s_setprio(0);
        if (jt >= NT - 4) {
            const int kbase = jt * 64 + 4 * hi;
#pragma unroll
            for (int r = 0; r < 16; ++r) { const int kv = kbase + (r & 3) + 8 * (r >> 2); if (kv > qidx) p0[r] = -1e30f; if (kv + 32 > qidx) p1[r] = -1e30f; }
        }
        float mxa = fmaxf(fmaxf(p0[0], p0[1]), p0[2]), mxb = fmaxf(fmaxf(p1[0], p1[1]), p1[2]);
#pragma unroll
        for (int r = 3; r < 15; r += 2) { mxa = fmaxf(fmaxf(mxa, p0[r]), p0[r + 1]); mxb = fmaxf(fmaxf(mxb, p1[r]), p1[r + 1]); }
        float mx = fmaxf(fmaxf(mxa, p0[15]), fmaxf(mxb, p1[15]));
        mx = fmaxf(mx, __shfl_xor(mx, 32));
        const bool grow = mx > mrun + 6.0f;
        if (__builtin_amdgcn_ballot_w64(grow) != 0ull) {
            const float mnew = fmaxf(mrun, mx);
            const float alpha = __builtin_amdgcn_exp2f(mrun - mnew);
            mrun = mnew; lrun *= alpha;
#pragma unroll
            for (int d = 0; d < 4; ++d)
#pragma unroll
                for (int r = 0; r < 16; ++r) o[d][r] *= alpha;
        }
        float ls = 0.f;
#pragma unroll
        for (int r = 0; r < 16; ++r) { p0[r] = __builtin_amdgcn_exp2f(p0[r] - mrun); p1[r] = __builtin_amdgcn_exp2f(p1[r] - mrun); ls += p0[r] + p1[r]; }
        lrun += ls;
        bf16x8 pf[4];
        { u32x4 w;
          w.x = pkbf(p0[0], p0[1]); w.y = pkbf(p0[2], p0[3]); w.z = pkbf(p0[4], p0[5]); w.w = pkbf(p0[6], p0[7]); pf[0] = __builtin_bit_cast(bf16x8, w);
          w.x = pkbf(p0[8], p0[9]); w.y = pkbf(p0[10], p0[11]); w.z = pkbf(p0[12], p0[13]); w.w = pkbf(p0[14], p0[15]); pf[1] = __builtin_bit_cast(bf16x8, w);
          w.x = pkbf(p1[0], p1[1]); w.y = pkbf(p1[2], p1[3]); w.z = pkbf(p1[4], p1[5]); w.w = pkbf(p1[6], p1[7]); pf[2] = __builtin_bit_cast(bf16x8, w);
          w.x = pkbf(p1[8], p1[9]); w.y = pkbf(p1[10], p1[11]); w.z = pkbf(p1[12], p1[13]); w.w = pkbf(p1[14], p1[15]); pf[3] = __builtin_bit_cast(bf16x8, w); }
        const int i16 = lane & 15;
        const LAS unsigned char* vbase = vb + ((4 * hi) + (i16 >> 2)) * AT_VSTR + (16 * ((lane >> 4) & 1) + 4 * (i16 & 3)) * 2;
        __builtin_amdgcn_s_setprio(1);
#pragma unroll
        for (int ks = 0; ks < 4; ++ks) {
#pragma unroll
            for (int d = 0; d < 4; ++d) {
                const LAS unsigned char* vp = vbase + (16 * ks) * AT_VSTR + (32 * d) * 2;
                const bf16x8 fv = cat8(tr_read(vp), tr_read(vp + 8 * AT_VSTR));
                o[d] = __builtin_amdgcn_mfma_f32_32x32x16_bf16(fv, pf[ks], o[d], 0, 0, 0);
            }
        }
        __builtin_amdgcn_s_setprio(0);
        if (jt + 1 < NT) stash(buf ^ 1);
        if (jt + 2 < NT) issue(jt + 2);
        RAW_BAR();
    }
    lrun += __shfl_xor(lrun, 32);
    const float inv = __builtin_amdgcn_rcpf(lrun);
    bf16_t* op = GAout + (((tb + qidx) * 2048 + hh * 128) & omask); const bf16_t* ip = GAin + (tb + qidx) * 2048 + hh * 128;
#pragma unroll
    for (int d = 0; d < 4; ++d)
#pragma unroll
        for (int g4 = 0; g4 < 4; ++g4) {
            const int dv = 32 * d + 8 * g4 + 4 * hi;
            const u32x2 ga = *(const u32x2*)(ip + dv);
            u32x2 w;
            w.x = pkbf(o[d][4 * g4 + 0] * inv * bf_lo(ga.x), o[d][4 * g4 + 1] * inv * bf_hi(ga.x));
            w.y = pkbf(o[d][4 * g4 + 2] * inv * bf_lo(ga.y), o[d][4 * g4 + 3] * inv * bf_hi(ga.y));
            *(u32x2*)(op + dv) = w;
        }
}

constexpr int PE_SELID = 0, PE_SELG = 32768, PE_R1 = 65536;
__device__ __forceinline__ void sort16_insert(unsigned (&L)[16], unsigned x) {
#pragma unroll
    for (int i = 15; i >= 1; --i) L[i] = umed3(L[i - 1], L[i], x);
    L[0] = L[0] > x ? L[0] : x;
}
__device__ __forceinline__ void cex(unsigned& a, unsigned& b) { const unsigned hi = a > b ? a : b, lo = a > b ? b : a; a = hi; b = lo; }
__device__ __forceinline__ unsigned sel4(unsigned p0, unsigned p1, unsigned p2, unsigned p3, int i) {
    const unsigned w = (i & 8) ? ((i & 4) ? p3 : p2) : ((i & 4) ? p1 : p0);
    return (w >> (8 * (i & 3))) & 0xffu;
}
__device__ __forceinline__ void peer_unit(LAS unsigned char* lds, unsigned char* ws, float* out, int unit) {
    unsigned short* SELT = (unsigned short*)(ws + WS_SELT); float* GATE = (float*)(ws + WS_GATE); float* R1G = (float*)(ws + WS_R1G);
    int tid_ = threadIdx.x; asm volatile("" : "+v"(tid_));
    const int tid = tid_, lane = tid & 63, wid = __builtin_amdgcn_readfirstlane(tid >> 6), r32 = lane & 31, hi = lane >> 5;
    const bf16_t* QP = (const bf16_t*)(ws + WS_QP); const bf16_t* KEYS = (const bf16_t*)(ws + WS_KEYS); const bf16_t* X1B = (const bf16_t*)(ws + WS_X1B);
    const unsigned char* U8 = ws + WS_UB; const unsigned char* V8 = ws + WS_VB; const float* RSQ1 = (const float*)(ws + WS_RSQ1);
    LAS unsigned* SELID = (LAS unsigned*)(lds + PE_SELID); LAS float* SELG = (LAS float*)(lds + PE_SELG); LAS float* R1 = (LAS float*)(lds + PE_R1);
    const size_t t0 = (size_t)unit * 64;
    if (tid < 64) { const float* p = RSQ1 + (t0 + tid) * 32; float s = 0.f;
#pragma unroll
        for (int i = 0; i < 8; ++i) { const f32x4 v = *(const f32x4*)(p + 4 * i); s += (v[0] + v[1]) + (v[2] + v[3]); }
        const float r1v = __builtin_amdgcn_rsqf(s * (1.f / 2048.f) + EPS); R1[tid] = r1v; R1G[t0 + tid] = r1v; }
    {
        unsigned char* X8 = ws + WS_X8; float* SX = (float*)(ws + WS_SX);
#pragma unroll 1
        for (int it = 0; it < 8; ++it) { const size_t t = t0 + wid + 8 * it;
            u32x4 xv[4]; float ax = 0.f;
#pragma unroll
            for (int q = 0; q < 2; ++q)
#pragma unroll
                for (int hf = 0; hf < 2; ++hf) xv[2 * q + hf] = *(const u32x4*)(X1B + t * 2048 + (size_t)(lane + 64 * q) * 16 + 8 * hf);
#pragma unroll
            for (int k = 0; k < 4; ++k)
#pragma unroll
                for (int d = 0; d < 4; ++d) ax = fmaxf(ax, fmaxf(fabsf(bf_lo(xv[k][d])), fabsf(bf_hi(xv[k][d]))));
            ax = fmaxf(wave_max(ax), 1e-30f); const float ix = 127.f / ax;
#pragma unroll
            for (int q = 0; q < 2; ++q) { u32x4 w;
                w.x = q8pack(bf_lo(xv[2 * q].x), bf_hi(xv[2 * q].x), bf_lo(xv[2 * q].y), bf_hi(xv[2 * q].y), ix); w.y = q8pack(bf_lo(xv[2 * q].z), bf_hi(xv[2 * q].z), bf_lo(xv[2 * q].w), bf_hi(xv[2 * q].w), ix);
                w.z = q8pack(bf_lo(xv[2 * q + 1].x), bf_hi(xv[2 * q + 1].x), bf_lo(xv[2 * q + 1].y), bf_hi(xv[2 * q + 1].y), ix); w.w = q8pack(bf_lo(xv[2 * q + 1].z), bf_hi(xv[2 * q + 1].z), bf_lo(xv[2 * q + 1].w), bf_hi(xv[2 * q + 1].w), ix);
                *(u32x4*)(X8 + t * 2048 + (size_t)(lane + 64 * q) * 16) = w; }
            if (lane == 0) SX[t] = ax * (1.f / 127.f); }
    }
    __syncthreads();
#ifndef NO_PEER1
    {
        const int tg = wid & 1; const int tl = 32 * tg + r32; const size_t t = t0 + tl;
        const float rstd = R1[tl];
#pragma unroll 1
        for (int hx = 0; hx < 2; ++hx) {
            const int h = (wid >> 1) + 4 * hx;
            unsigned LA[16], LB[16];
#pragma unroll 1
            for (int p = 0; p < 2; ++p) {
                f32x16 acc[4];
#pragma unroll
                for (int kb = 0; kb < 4; ++kb)
#pragma unroll
                    for (int r = 0; r < 16; ++r) acc[kb][r] = 0.f;
                const bf16_t* qp = QP + t * 2048 + h * 256 + p * 128 + 8 * hi;
                const bf16_t* kp = KEYS + ((size_t)((h * 2 + p) * 128 + r32)) * 128 + 8 * hi;
#pragma unroll 2
                for (int d0 = 0; d0 < 8; ++d0) {
                    const bf16x8 qf = *(const bf16x8*)(qp + 16 * d0);
#pragma unroll
                    for (int kb = 0; kb < 4; ++kb) { const bf16x8 kf = *(const bf16x8*)(kp + (size_t)kb * 32 * 128 + 16 * d0);
                        acc[kb] = __builtin_amdgcn_mfma_f32_32x32x16_bf16(kf, qf, acc[kb], 0, 0, 0); }
                }
                unsigned L[16];
#pragma unroll
                for (int i = 0; i < 16; ++i) L[i] = 0u;
#pragma unroll
                for (int kb = 0; kb < 4; ++kb)
#pragma unroll
                    for (int r = 0; r < 16; ++r) { const int key = 32 * kb + (r & 3) + 8 * (r >> 2);
                        const unsigned x = (f2key(acc[kb][r]) & ~127u) | (unsigned)(127 - key - 4 * hi); sort16_insert(L, x); }
                unsigned M[16];
#pragma unroll
                for (int i = 0; i < 16; ++i) { const unsigned o = (unsigned)__shfl_xor((int)L[15 - i], 32); M[i] = L[i] > o ? L[i] : o; }
#pragma unroll
                for (int dd = 8; dd >= 1; dd >>= 1)
#pragma unroll
                    for (int i = 0; i < 16; ++i) if ((i & dd) == 0) cex(M[i], M[i + dd]);
                if (p == 0) {
#pragma unroll
                    for (int i = 0; i < 16; ++i) LA[i] = M[i];
                } else {
#pragma unroll
                    for (int i = 0; i < 16; ++i) LB[i] = M[i];
                }
            }
            float fa[16], fb[16]; unsigned ia0 = 0u, ia1 = 0u, ia2 = 0u, ia3 = 0u, ib0 = 0u, ib1 = 0u, ib2 = 0u, ib3 = 0u;
#pragma unroll
            for (int i = 0; i < 16; ++i) { fa[i] = key2f(LA[i] & ~127u); fb[i] = key2f(LB[i] & ~127u);
                const unsigned va = (127u - (LA[i] & 127u)) << (8 * (i & 3)), vb = (127u - (LB[i] & 127u)) << (8 * (i & 3));
                if ((i >> 2) == 0) { ia0 |= va; ib0 |= vb; } else if ((i >> 2) == 1) { ia1 |= va; ib1 |= vb; } else if ((i >> 2) == 2) { ia2 |= va; ib2 |= vb; } else { ia3 |= va; ib3 |= vb; } }
            unsigned C[16];
#pragma unroll
            for (int i = 0; i < 16; ++i) C[i] = 0u;
#pragma unroll
            for (int i = 0; i < 16; ++i)
#pragma unroll
                for (int j = 0; j < 16; ++j) if ((i + 1) * (j + 1) <= 16) { const unsigned x = (f2key(fa[i] + fb[j]) & ~255u) | (unsigned)(i * 16 + j); sort16_insert(C, x); }
            const float smax = key2f(C[0] & ~255u);
            float e[16], den = 0.f;
#pragma unroll
            for (int k = 0; k < 16; ++k) { e[k] = __builtin_amdgcn_exp2f((key2f(C[k] & ~255u) - smax) * rstd * 1.4426950408889634f); den += e[k]; }
            const float rden = 1.f / den;
            if (hi == 0) {
#pragma unroll
                for (int k = 0; k < 16; ++k) { const int ij = (int)(C[k] & 255u); const unsigned id = sel4(ia0, ia1, ia2, ia3, ij >> 4) * 128u + sel4(ib0, ib1, ib2, ib3, ij & 15);
                    const int pos = (k & 7) * 16 + 2 * h + (k >> 3);
                    SELT[t * 128 + pos] = (unsigned short)id; GATE[t * 128 + pos] = e[k] * rden; }
            }
        }
    }
#endif
    __syncthreads();
    __syncthreads();
}


#define PEER_IDS(dst0, dst1, tt) do { dst0 = __builtin_nontemporal_load((const u32x4*)(SELT + (tt) * 128 + es * 16)); dst1 = __builtin_nontemporal_load((const u32x4*)(SELT + (tt) * 128 + es * 16 + 8)); } while (0)
#define PEER_ROWS(rowv, i0v, i1v) do { _Pragma("unroll") for (int q = 0; q < 16; ++q) { const unsigned w_ = (q < 8) ? i0v[q >> 1] : i1v[(q - 8) >> 1]; const unsigned id_ = (q & 1) ? (w_ >> 16) : (w_ & 0xffffu); \
        rowv[q] = *(const u32x4*)(tab + (size_t)id_ * 128); } } while (0)
#define PERMB(s0, s1, sel) __builtin_amdgcn_perm((s0), (s1), (sel))
__device__ __forceinline__ void peer_v_token(const u32x4 (&row)[16], const u32x4 wq, float sw, float* op, int lane) {
    const f32x2_t xo = __builtin_nontemporal_load((const f32x2_t*)op);
    int a[16];
#pragma unroll
    for (int k = 0; k < 16; ++k) a[k] = 0;
#pragma unroll
    for (int g4 = 0; g4 < 4; ++g4) {
        const int wd = (int)wq[g4];
#pragma unroll
        for (int dw = 0; dw < 4; ++dw) {
            const unsigned A = row[4 * g4][dw], B = row[4 * g4 + 1][dw], C = row[4 * g4 + 2][dw], D = row[4 * g4 + 3][dw];
            const unsigned ablo = PERMB(B, A, 0x05010400u), abhi = PERMB(B, A, 0x07030602u), cdlo = PERMB(D, C, 0x05010400u), cdhi = PERMB(D, C, 0x07030602u);
            a[4 * dw + 0] = __builtin_amdgcn_sdot4((int)PERMB(cdlo, ablo, 0x05040100u), wd, a[4 * dw + 0], false);
            a[4 * dw + 1] = __builtin_amdgcn_sdot4((int)PERMB(cdlo, ablo, 0x07060302u), wd, a[4 * dw + 1], false);
            a[4 * dw + 2] = __builtin_amdgcn_sdot4((int)PERMB(cdhi, abhi, 0x05040100u), wd, a[4 * dw + 2], false);
            a[4 * dw + 3] = __builtin_amdgcn_sdot4((int)PERMB(cdhi, abhi, 0x07060302u), wd, a[4 * dw + 3], false);
        }
    }
    int r4a[4], r4b[4], r2a[2], r2b[2], r1a, r1b;
#pragma unroll
    for (int j = 0; j < 4; ++j) { const bool up = (lane & 8) != 0;
        const int ka = up ? a[4 * j + 2] : a[4 * j], kb = up ? a[4 * j + 3] : a[4 * j + 1], sa = up ? a[4 * j] : a[4 * j + 2], sb = up ? a[4 * j + 1] : a[4 * j + 3];
        r4a[j] = ka + __shfl_xor(sa, 8); r4b[j] = kb + __shfl_xor(sb, 8); }
#pragma unroll
    for (int j = 0; j < 2; ++j) { const bool up = (lane & 16) != 0;
        const int ka = up ? r4a[2 * j + 1] : r4a[2 * j], kb = up ? r4b[2 * j + 1] : r4b[2 * j], sa = up ? r4a[2 * j] : r4a[2 * j + 1], sb = up ? r4b[2 * j] : r4b[2 * j + 1];
        r2a[j] = ka + __shfl_xor(sa, 16); r2b[j] = kb + __shfl_xor(sb, 16); }
    { const bool up = (lane & 32) != 0;
        const int ka = up ? r2a[1] : r2a[0], kb = up ? r2b[1] : r2b[0], sa = up ? r2a[0] : r2a[1], sb = up ? r2b[0] : r2b[1];
        r1a = ka + __shfl_xor(sa, 32); r1b = kb + __shfl_xor(sb, 32); }
    __builtin_nontemporal_store((f32x2_t){xo[0] + sw * (float)r1a, xo[1] + sw * (float)r1b}, (f32x2_t*)op);
}

__device__ __forceinline__ void peer_u_sum(const u32x4 (&row)[16], const u32x4 xq, int lane, int& s0, int& s1) {
    int part[16];
#pragma unroll
    for (int q = 0; q < 16; ++q) { int a = 0;
#pragma unroll
        for (int dw = 0; dw < 4; ++dw) a = __builtin_amdgcn_sdot4((int)xq[dw], (int)row[q][dw], a, false);
        part[q] = a; }
    int r8[8], r4[4];
#pragma unroll
    for (int j = 0; j < 8; ++j) { const int keep = (lane & 1) ? part[2 * j + 1] : part[2 * j], send = (lane & 1) ? part[2 * j] : part[2 * j + 1]; r8[j] = keep + __shfl_xor(send, 1); }
#pragma unroll
    for (int j = 0; j < 4; ++j) { const int keep = (lane & 2) ? r8[2 * j + 1] : r8[2 * j], send = (lane & 2) ? r8[2 * j] : r8[2 * j + 1]; r4[j] = keep + __shfl_xor(send, 2); }
    { const int keep = (lane & 4) ? r4[1] : r4[0], send = (lane & 4) ? r4[0] : r4[1]; s0 += keep + __shfl_xor(send, 4); }
    { const int keep = (lane & 4) ? r4[3] : r4[2], send = (lane & 4) ? r4[2] : r4[3]; s1 += keep + __shfl_xor(send, 4); }
}
__device__ __forceinline__ void peer_fused_rounds(LAS unsigned char* lds, unsigned char* ws, float* out, int unit) {
    int tid_ = threadIdx.x; asm volatile("" : "+v"(tid_));
    const int tid = tid_, lane = tid & 63, wid = __builtin_amdgcn_readfirstlane(tid >> 6), es = lane >> 3, cb = lane & 7;
    const unsigned short* SELT = (const unsigned short*)(ws + WS_SELT); const unsigned char* X8 = ws + WS_X8; const float* GATE = (const float*)(ws + WS_GATE);
    const float* R1G = (const float*)(ws + WS_R1G); const float* SX = (const float*)(ws + WS_SX); const float* SU = (const float*)(ws + WS_SU); const float* SV = (const float*)(ws + WS_SV);
    LAS unsigned char* W8L = lds + 70000 + wid * 1024;
    const size_t tw = (size_t)unit * 64 + (size_t)wid * 8;
    u32x4 idr[8][2];
#pragma unroll
    for (int i = 0; i < 8; ++i) { idr[i][0] = *(const u32x4*)(SELT + (tw + i) * 128 + es * 16); idr[i][1] = *(const u32x4*)(SELT + (tw + i) * 128 + es * 16 + 8); }
    int acc[8][2];
#pragma unroll
    for (int i = 0; i < 8; ++i) { acc[i][0] = 0; acc[i][1] = 0; }
#pragma unroll 1
    for (int sidx = 0; sidx < 16; ++sidx) {
        const unsigned char* tab = ws + WS_UB + (size_t)sidx * (2 * MiB) + cb * 16;
        u32x4 xq[8];
#pragma unroll
        for (int i = 0; i < 8; ++i) xq[i] = *(const u32x4*)(X8 + (tw + i) * 2048 + sidx * 128 + cb * 16);
#pragma unroll
        for (int i = 0; i < 8; ++i) { u32x4 row[16]; u32x4 ia = idr[i][0], ib = idr[i][1]; asm volatile("" : "+v"(ia), "+v"(ib));
            PEER_ROWS(row, ia, ib); peer_u_sum(row, xq[i], lane, acc[i][0], acc[i][1]); asm volatile("" ::: "memory"); }
    }
    float swv[8];
#pragma unroll
    for (int i = 0; i < 8; ++i) { const size_t t = tw + i; const float tsc = SX[t] * R1G[t]; float wv[2];
#pragma unroll
        for (int hf = 0; hf < 2; ++hf) { const size_t idx = t * 128 + es * 16 + 8 * hf + cb; const unsigned id = SELT[idx];
            const float act = (float)acc[i][hf] * tsc * SU[id];
            wv[hf] = GATE[idx] * 0.5f * act * (1.f + erff(act * 0.70710678118654752f)) * SV[id]; }
        const float aw = fmaxf(wave_max(fmaxf(fabsf(wv[0]), fabsf(wv[1]))), 1e-30f); const float iw = 127.f / aw;
        W8L[i * 128 + es * 16 + cb] = (unsigned char)((int)__builtin_rintf(wv[0] * iw) & 0xff); W8L[i * 128 + es * 16 + 8 + cb] = (unsigned char)((int)__builtin_rintf(wv[1] * iw) & 0xff);
        swv[i] = aw * (1.f / 127.f); }
    asm volatile("s_waitcnt lgkmcnt(0)" ::: "memory");
    u32x4 wq[8];
#pragma unroll
    for (int i = 0; i < 8; ++i) wq[i] = *(const LAS u32x4*)(W8L + i * 128 + es * 16);
#pragma unroll 1
    for (int sidx = 0; sidx < 16; ++sidx) {
        const unsigned char* tab = ws + WS_VB + (size_t)sidx * (2 * MiB) + cb * 16;
        float* ob = out + sidx * 128 + cb * 16 + 2 * es;
#pragma unroll
        for (int i = 0; i < 8; ++i) { u32x4 row[16]; u32x4 ia = idr[i][0], ib = idr[i][1]; asm volatile("" : "+v"(ia), "+v"(ib));
            PEER_ROWS(row, ia, ib); peer_v_token(row, wq[i], swv[i], ob + (tw + i) * 2048, lane); asm volatile("" ::: "memory"); }
    }
}

#define XB_TMO      128
#define XB_XCNT(j)  (256  + 64 * (j))
#define XB_XSUB(j)  (1280 + 64 * (j))
#define XB_XGEN(j)  (2304 + 64 * (j))
#define XB_TOP      3328
#define XB_TOPGEN   3392
#define XB_SPIN_CAP (1u << 22)
__device__ __forceinline__ unsigned xb_ld(unsigned* p)              { return __hip_atomic_load(p, __ATOMIC_RELAXED, __HIP_MEMORY_SCOPE_AGENT); }
__device__ __forceinline__ unsigned xb_add(unsigned* p, unsigned v) { return __hip_atomic_fetch_add(p, v, __ATOMIC_RELAXED, __HIP_MEMORY_SCOPE_AGENT); }
__device__ __forceinline__ unsigned xb_xcc_id() { return (unsigned)__builtin_amdgcn_s_getreg((3 << 11) | 20) & 0xFu; }
#define XB_SPIN(cond, bar) do { unsigned _sp = 0; while (cond) { __builtin_amdgcn_s_sleep(1); \
    if ((++_sp & 255u) == 0u) { if (xb_ld(&(bar)[XB_TMO])) break; if (_sp > XB_SPIN_CAP) { atomicAdd(&(bar)[XB_TMO], 1u); break; } } } } while (0)
struct XcdBarrier { unsigned* bar; unsigned x; volatile LAS unsigned* st; };
__device__ __forceinline__ XcdBarrier xcd_barrier_post(unsigned* bar, volatile LAS unsigned* st) {
    XcdBarrier b; b.bar = bar; b.x = xb_xcc_id(); b.st = st;
    if (threadIdx.x == 0) (void)xb_add(&bar[XB_XCNT(b.x)], 1u);
    return b;
}
__device__ __forceinline__ void xcd_barrier_complete(unsigned* bar, unsigned x, unsigned& nloc, unsigned& nx) {
    const unsigned G = gridDim.x * gridDim.y * gridDim.z;
    unsigned sum, cnt, mine, sp = 0u;
    for (;;) {
        sum = 0u; cnt = 0u; mine = 0u;
#pragma unroll
        for (unsigned j = 0; j < 16; ++j) { const unsigned c = xb_ld(&bar[XB_XCNT(j)]); sum += c; cnt += (c > 0u) ? 1u : 0u; mine = (j == x) ? c : mine; }
        if (sum == G) break;
        __builtin_amdgcn_s_sleep(1);
        if ((++sp & 255u) == 0u) { if (xb_ld(&bar[XB_TMO])) break; if (sp > XB_SPIN_CAP) { atomicAdd(&bar[XB_TMO], 1u); break; } }
    }
    nloc = mine > 0u ? mine : 1u; nx = cnt > 0u ? cnt : 1u;
}
__device__ __forceinline__ void xcd_barrier(const XcdBarrier& b) {
    asm volatile("s_waitcnt vmcnt(0)" ::: "memory");
    __syncthreads();
    if (threadIdx.x == 0) {
        unsigned* bar = b.bar;
        __builtin_amdgcn_s_waitcnt(0);
        unsigned nloc = b.st[0], nx = b.st[1];
        if (nloc == 0u) { xcd_barrier_complete(bar, b.x, nloc, nx); b.st[0] = nloc; b.st[1] = nx; }
        const unsigned old = xb_add(&bar[XB_XSUB(b.x)], 1u);
        const unsigned gen = old / nloc;
        if (old + 1u == (gen + 1u) * nloc) {
            __builtin_amdgcn_fence(__ATOMIC_RELEASE, "agent");
            asm volatile("s_waitcnt vmcnt(0)" ::: "memory");
            const unsigned og = xb_add(&bar[XB_TOP], 1u);
            const unsigned tg = og / nx;
            if (og + 1u == (tg + 1u) * nx) xb_add(&bar[XB_TOPGEN], 1u);
            else XB_SPIN(xb_ld(&bar[XB_TOPGEN]) == tg, bar);
            __builtin_amdgcn_fence(__ATOMIC_ACQUIRE, "agent");
            xb_add(&bar[XB_XGEN(b.x)], 1u);
            asm volatile("s_waitcnt vmcnt(0)" ::: "memory");
        } else {
            XB_SPIN(xb_ld(&bar[XB_XGEN(b.x)]) == gen, bar);
            __builtin_amdgcn_fence(__ATOMIC_ACQUIRE, "agent");
            asm volatile("s_waitcnt vmcnt(0)" ::: "memory");
        }
    }
    __syncthreads();
}

__global__ void __launch_bounds__(512, 2) mk_fwd(Args args) {
    extern __shared__ __attribute__((aligned(16))) unsigned char lds_raw[];
    LAS unsigned char* lds = (LAS unsigned char*)lds_raw;
    const int tid = threadIdx.x, lane = tid & 63, wave = __builtin_amdgcn_readfirstlane(tid >> 6);
    const int G = gridDim.x, bx = blockIdx.x;
    const int vcu = (G % 8 == 0) ? (bx % 8) * (G / 8) + bx / 8 : bx;
    unsigned char* ws = args.ws;
    const float* x = (const float*)args.in[0]; const int* positions = (const int*)args.in[1];
    const float* g_norm_mix = (const float*)args.in[2]; const float* w_in = (const float*)args.in[3]; const float* b_gate = (const float*)args.in[4];
    const float* g_cq = (const float*)args.in[5]; const float* w_uq = (const float*)args.in[6]; const float* g_ckv = (const float*)args.in[7]; const float* w_ukv = (const float*)args.in[8];
    const float* g_qn = (const float*)args.in[9]; const float* g_qr = (const float*)args.in[10]; const float* g_kn = (const float*)args.in[11]; const float* g_kr = (const float*)args.in[12];
    const float* w_a2 = (const float*)args.in[13]; const float* b_a = (const float*)args.in[14]; const float* g_on = (const float*)args.in[15];
    const float* w_out = (const float*)args.in[16]; const float* g_ffn = (const float*)args.in[17]; const float* w_pq = (const float*)args.in[18]; const float* sub_keys = (const float*)args.in[19];
    const float* u_emb = (const float*)args.in[20]; const float* v_emb = (const float*)args.in[21];
    float* out = args.out;
    const int lo = args.ph_lo, hi_ph = args.ph_hi;
#ifndef PH_MASK
#define PH_MASK 0xff
#endif
#define IN(k) (((PH_MASK >> (k)) & 1) && lo <= (k) && (k) < hi_ph)
#define SEAM(k) do { if (IN(k) && IN((k) + 1)) { if (args.ph_lo < 0) cg::this_grid().sync(); else xcd_barrier(xbar); } } while (0)
    volatile LAS unsigned* xst = (volatile LAS unsigned*)(lds + (LDS_BYTES - 64));
    if (tid < 2) xst[tid] = 0u;
    __syncthreads();
    XcdBarrier xbar = xcd_barrier_post((unsigned*)ws, xst);
    const int gw = vcu * 8 + wave, NGW = G * 8;

    if (IN(0)) {
#ifdef REP_P0
      for (int rep_ = 0; rep_ < 2; ++rep_) {
#else
      {
#endif
        LAS float* scr = (LAS float*)(lds + wave * 16896);
        constexpr int I_UQ = 8 * 96, I_UKV = 8 * 64, I_OUT = 32 * 32, I_PQ = 32 * 32, I_GM = 32 * 180;
        constexpr int NITEMS = I_UQ + I_UKV + I_OUT + I_PQ + I_GM;
        for (int it = gw; it < NITEMS; it += NGW) {
            int r = it;
            if (r < I_GM) { p0_gate_colmax_item<true>(w_in, 11344, 180, (float*)(ws + WS_PMAX), r, lane); continue; } r -= I_GM;
            if (r < I_UQ) { p0_transpose_item(w_uq, 3072, 512, 96, (bf16_t*)(ws + WS_WUQ), scr, r, lane, CmWuq(), g_cq); continue; } r -= I_UQ;
            if (r < I_UKV) { p0_transpose_item64(w_ukv, 4096, 512, 64, (bf16_t*)(ws + WS_WUKV), scr, r, lane, CmWukv(), g_ckv); continue; } r -= I_UKV;
            if (r < I_OUT) { p0_gate_colmax_item<false>(w_out, 2048, 32, (float*)(ws + WS_PMAXO), r, lane); continue; } r -= I_OUT;
            p0_transpose_item64(w_pq, 2048, 2048, 32, (bf16_t*)(ws + WS_WPQ), scr, r, lane, CmId(), g_ffn);
        }
        for (int m = gw; m < T; m += 2 * NGW) {
            const int m2 = m + NGW;
            const f32x4* xr = (const f32x4*)(x + (size_t)m * 2048) + lane; const f32x4* xr2 = (const f32x4*)(x + (size_t)(m2 < T ? m2 : m) * 2048) + lane;
            f32x4 v[8], v2[8]; float s = 0.f, s2 = 0.f;
#pragma unroll
            for (int j = 0; j < 8; ++j) { v[j] = xr[64 * j]; v2[j] = xr2[64 * j]; }
#pragma unroll
            for (int j = 0; j < 8; ++j) { s += (v[j][0] * v[j][0] + v[j][1] * v[j][1]) + (v[j][2] * v[j][2] + v[j][3] * v[j][3]); s2 += (v2[j][0] * v2[j][0] + v2[j][1] * v2[j][1]) + (v2[j][2] * v2[j][2] + v2[j][3] * v2[j][3]); }
            const float rstd = 1.f / sqrtf(wave_sum(s) * (1.f / 2048.f) + EPS), rstd2 = 1.f / sqrtf(wave_sum(s2) * (1.f / 2048.f) + EPS);
            float am = 0.f, am2 = 0.f;
#pragma unroll
            for (int j = 0; j < 8; ++j) { const f32x4 gg = *((const f32x4*)g_norm_mix + lane + 64 * j);
                v[j] = v[j] * rstd * gg; v2[j] = v2[j] * rstd2 * gg;
                am = fmaxf(am, fmaxf(fmaxf(fabsf(v[j][0]), fabsf(v[j][1])), fmaxf(fabsf(v[j][2]), fabsf(v[j][3])))); am2 = fmaxf(am2, fmaxf(fmaxf(fabsf(v2[j][0]), fabsf(v2[j][1])), fmaxf(fabsf(v2[j][2]), fabsf(v2[j][3]))));
                }
            am = fmaxf(wave_max(am), 1e-30f); am2 = fmaxf(wave_max(am2), 1e-30f);
            const float ih = 127.f / am, ih2 = 127.f / am2;
            unsigned* h8 = (unsigned*)((unsigned char*)out + (size_t)m * 2048) + lane; unsigned* h82 = (unsigned*)((unsigned char*)out + (size_t)m2 * 2048) + lane;
#pragma unroll
            for (int j = 0; j < 8; ++j) { h8[64 * j] = q8pack(v[j][0], v[j][1], v[j][2], v[j][3], ih); if (m2 < T) h82[64 * j] = q8pack(v2[j][0], v2[j][1], v2[j][2], v2[j][3], ih2); }
            if (lane == 0) { float* SH = (float*)((unsigned char*)out + 32 * MiB); SH[m] = am * (1.f / 127.f); if (m2 < T) SH[m2] = am2 * (1.f / 127.f); }
        }
        { float* ROPE = (float*)(ws + WS_ROPE);
          for (int i = bx * 512 + tid; i < T * 32; i += G * 512) { const int t = i >> 5, f = i & 31; const float inv = powf(10000.f, -(float)(2 * f) / 64.f); const float ang = (float)positions[t] * inv;
              ROPE[(size_t)t * 64 + f] = cosf(ang); ROPE[(size_t)t * 64 + 32 + f] = sinf(ang); } }
        { bf16_t* KEYS = (bf16_t*)(ws + WS_KEYS);
          for (int i = bx * 512 + tid; i < 8 * 2 * 128 * 128 / 2; i += G * 512) { const f32x2_t v = *(const f32x2_t*)(sub_keys + 2 * (size_t)i); *(unsigned*)(KEYS + 2 * (size_t)i) = pkbf(v[0], v[1]); } }
      }
    }
    SEAM(0);
    if (IN(1)) {
        {   LAS float* scr = (LAS float*)(lds + wave * 16896);
            for (int it = gw; it < 32 * 180 + 32 * 32; it += NGW) {
                if (it < 32 * 180) p0_gate_quant_item<true>(w_in, 11344, 180, (const float*)(ws + WS_PMAX), ws + WS_WG8, (float*)(ws + WS_SWG), scr, it, lane);
                else p0_gate_quant_item<false>(w_out, 2048, 32, (const float*)(ws + WS_PMAXO), ws + WS_WOUT, (float*)(ws + WS_SWO), scr, it - 32 * 180, lane); }
            __syncthreads(); }
        if (lo == 0 && hi_ph == NPH) xcd_barrier(xbar);
        {
            pg8::Gemm g{(const bf16_t*)out, (const bf16_t*)(ws + WS_WG8), T, N1, 1024, 1024, 1024}; pg8::StaticOrder S; S.init(T, N1, G, bx);
            EpiG1i E{ws, b_gate, (const float*)((const unsigned char*)out + 32 * MiB), (const float*)(ws + WS_SWG), (float*)(ws + WS_RSQ0)};
            pg8::gemm_phase<EpiG1i, true>(lds, g, S, E); }
    }
    SEAM(1);
    if (IN(2)) {
        {
            const bf16_t* MISC = (const bf16_t*)(ws + WS_MISC); const float* ROPE = (const float*)(ws + WS_ROPE); bf16_t* KPE = (bf16_t*)(ws + WS_KPE);
            for (int t = gw; t < T; t += NGW) {
                const float v = bf1(MISC[(size_t)t * 256 + lane]);
                const float ss = wave_sum(v * v);
                const float xn = v * __builtin_amdgcn_rsqf(ss * (1.f / 64.f) + EPS) * g_kr[lane];
                const float other = __shfl_xor(xn, 32);
                const int f = lane & 31; const float c = ROPE[(size_t)t * 64 + f], s = ROPE[(size_t)t * 64 + 32 + f];
                const float o = (lane < 32) ? (xn * c - other * s) : (xn * c + other * s);
                KPE[(size_t)t * 64 + 2 * f + (lane >> 5)] = f2bf(o);
            }
        }
#ifndef NO_PREP
        {
            bf16_t* QG = (bf16_t*)(ws + WS_QG); bf16_t* KG = (bf16_t*)(ws + WS_KG); const bf16_t* MISC = (const bf16_t*)(ws + WS_MISC); float* DECG = (float*)(ws + WS_DEC);
            LAS float* alr = (LAS float*)lds; LAS float* tot = (LAS float*)(lds + 4096);
            const int d = tid & 255, half = tid >> 8;
            for (int un = vcu; un < 1024; un += G) {
                const int c = un & 31, hh = (un >> 5) & 3, b = un >> 7; const size_t t0 = (size_t)b * SEQ + (size_t)c * 64;
                for (int i = tid; i < 1024; i += 512) alr[i] = bf1(MISC[(t0 + (i >> 4)) * 256 + 64 + (i & 15)]);
                float w[16];
#pragma unroll
                for (int r = 0; r < 16; ++r) w[r] = w_a2[r * 1024 + hh * 256 + d];
                const float ba = b_a[hh * 256 + d];
                __syncthreads();
                float la[32]; float sum = 0.f;
#pragma unroll
                for (int jj = 0; jj < 32; ++jj) { const int j = 32 * half + jj; float z = ba;
#pragma unroll
                    for (int r4 = 0; r4 < 4; ++r4) { const f32x4 a = *(const LAS f32x4*)(alr + j * 16 + 4 * r4); z += a[0] * w[4 * r4] + a[1] * w[4 * r4 + 1] + a[2] * w[4 * r4 + 2] + a[3] * w[4 * r4 + 3]; }
                    const float ls = fminf(z, 0.f) - __logf(1.f + __expf(-fabsf(z)));
                    la[jj] = ls * (1.f / 16.f); sum += la[jj]; }
                if (half == 0) tot[d] = sum;
                __syncthreads();
                float cum = half ? tot[d] : 0.f;
#pragma unroll
                for (int jj = 0; jj < 32; ++jj) { cum += la[jj]; const size_t off = (t0 + 32 * half + jj) * 1024 + hh * 256 + d;
                    const float eq = __expf(cum); const float q = bf1(QG[off]), k = bf1(KG[off]);
                    QG[off] = f2bf(q * eq * 0.0625f); KG[off] = f2bf(k * __builtin_amdgcn_rcpf(eq)); }
                if (half == 1) DECG[((size_t)((b * 4 + hh) * 32 + c)) * 256 + d] = __expf(cum);
                __syncthreads();
                {
                    bf16_t* ABUF = (bf16_t*)(ws + WS_ABUF) + ((size_t)((b * 4 + hh) * 32 + c)) * 4096;
                    const int l15 = lane & 15, g = lane >> 4, it = wave >> 1;
#pragma unroll
                    for (int jj = 0; jj < 2; ++jj) {
                        const int jt = 2 * (wave & 1) + jj;
                        f32x4 a = (f32x4){0.f, 0.f, 0.f, 0.f};
                        if (jt <= it) {
#pragma unroll
                            for (int ks = 0; ks < 8; ++ks) {
                                const bf16x8 fa = *(const bf16x8*)(QG + (t0 + 16 * it + l15) * 1024 + hh * 256 + 32 * ks + 8 * g);
                                const bf16x8 fb = *(const bf16x8*)(KG + (t0 + 16 * jt + l15) * 1024 + hh * 256 + 32 * ks + 8 * g);
                                a = __builtin_amdgcn_mfma_f32_16x16x32_bf16(fa, fb, a, 0, 0, 0);
                            }
                        }
#pragma unroll
                        for (int r = 0; r < 4; ++r) { const int i = 16 * it + 4 * g + r, j = 16 * jt + l15; ABUF[i * 64 + j] = f2bf((j <= i) ? a[r] : 0.f); }
                    }
                }
                __syncthreads();
            }
        }
#endif
#ifndef NO_G2
        {
            pg8::Gemm g{(const bf16_t*)(ws + WS_CQKV), (const bf16_t*)(ws + WS_WUQ), T, 3072, 512, 1024, 512}; pg8::StaticOrder S; S.init(T, 3072, G, bx);
            EpiUp<0> E{lds, (const float*)(ws + WS_RSQ0), 0, g_qn, g_qr, (const float*)(ws + WS_ROPE), (bf16_t*)(ws + WS_QH), nullptr};
            pg8::gemm_phase<EpiUp<0>, true>(lds, g, S, E);
#ifdef REP_G2
            pg8::gemm_phase<EpiUp<0>, true>(lds, g, S, E);
#endif
        }
#endif
#ifndef NO_G3
        {
            pg8::Gemm g{(const bf16_t*)(ws + WS_CQKV) + 512, (const bf16_t*)(ws + WS_WUKV), T, 4096, 512, 1024, 512}; pg8::StaticOrder S; S.init(T, 4096, G, bx);
            EpiUp<1> E{lds, (const float*)(ws + WS_RSQ0), 8, g_kn, nullptr, nullptr, (bf16_t*)out, (bf16_t*)out + (size_t)T * 2048};
            pg8::gemm_phase<EpiUp<1>, true>(lds, g, S, E);
#ifdef REP_G2
            pg8::gemm_phase<EpiUp<1>, true>(lds, g, S, E);
#endif
        }
#endif
    }
    SEAM(2);
    if (IN(3)) {
#ifndef NO_GLA
        for (int un = vcu; un < 256; un += G) gla_scan_unit(lds, ws, g_on, un >> 5, (un >> 3) & 3, un & 7, false);
#endif
#ifdef REP_GLA
        for (int un = vcu; un < 256; un += G) gla_scan_unit(lds, ws, g_on, un >> 5, (un >> 3) & 3, un & 7, true);
#endif
        const bf16_t* Qh = (const bf16_t*)(ws + WS_QH); const bf16_t* Kh = (const bf16_t*)out; const bf16_t* Vh = (const bf16_t*)out + (size_t)T * 2048;
        const bf16_t* KPE = (const bf16_t*)(ws + WS_KPE); bf16_t* GA = (bf16_t*)(ws + WS_GA);
#ifndef NO_ATTN
        for (int pr = vcu; pr < 512; pr += G) {
            const int bh = pr >> 2, s = pr & 3;
            attn_unit(lds, Qh, Kh, Vh, KPE, GA, GA, ~(size_t)0, bh >> 4, bh & 15, 7 - s);
            attn_unit(lds, Qh, Kh, Vh, KPE, GA, GA, ~(size_t)0, bh >> 4, bh & 15, s);
        }
#endif
#ifdef REP_ATTN
        for (int pr = vcu; pr < 512; pr += G) { const int bh = pr >> 2, s = pr & 3;
            attn_unit(lds, Qh, Kh, Vh, KPE, GA, (bf16_t*)(ws + WS_CQKV), (size_t)0xffffff, bh >> 4, bh & 15, 7 - s);
            attn_unit(lds, Qh, Kh, Vh, KPE, GA, (bf16_t*)(ws + WS_CQKV), (size_t)0xffffff, bh >> 4, bh & 15, s); }
#endif
    }
    SEAM(3);
    if (IN(4)) {
        const bf16_t* GA = (const bf16_t*)(ws + WS_GA); const bf16_t* GB = (const bf16_t*)(ws + WS_GB); const float* SSQ = (const float*)(ws + WS_SSQ);
        unsigned char* M8 = ws + WS_M8; float* SM = (float*)(ws + WS_SM);
        for (int t = gw; t < T; t += NGW) {
            float mv[4][8]; float am = 0.f;
#pragma unroll
            for (int q = 0; q < 4; ++q) {
                const f32x4 s0 = *(const f32x4*)(SSQ + ((size_t)t * 4 + q) * 8), s1 = *(const f32x4*)(SSQ + ((size_t)t * 4 + q) * 8 + 4);
                const float rs = __builtin_amdgcn_rsqf(((s0[0] + s0[1]) + (s0[2] + s0[3]) + (s1[0] + s1[1]) + (s1[2] + s1[3])) * (1.f / 512.f) + EPS);
                const size_t off = (size_t)t * 2048 + (size_t)(lane + 64 * q) * 8;
                const u32x4 a = *(const u32x4*)(GA + off), bb = *(const u32x4*)(GB + off);
                mv[q][0] = bf_lo(a.x) + rs * bf_lo(bb.x); mv[q][1] = bf_hi(a.x) + rs * bf_hi(bb.x); mv[q][2] = bf_lo(a.y) + rs * bf_lo(bb.y); mv[q][3] = bf_hi(a.y) + rs * bf_hi(bb.y);
                mv[q][4] = bf_lo(a.z) + rs * bf_lo(bb.z); mv[q][5] = bf_hi(a.z) + rs * bf_hi(bb.z); mv[q][6] = bf_lo(a.w) + rs * bf_lo(bb.w); mv[q][7] = bf_hi(a.w) + rs * bf_hi(bb.w);
#pragma unroll
                for (int e = 0; e < 8; ++e) am = fmaxf(am, fabsf(mv[q][e]));
            }
            am = fmaxf(wave_max(am), 1e-30f); const float im = 127.f / am;
#pragma unroll
            for (int q = 0; q < 4; ++q) { u32x2 w; w.x = q8pack(mv[q][0], mv[q][1], mv[q][2], mv[q][3], im); w.y = q8pack(mv[q][4], mv[q][5], mv[q][6], mv[q][7], im);
                *(u32x2*)(M8 + (size_t)t * 2048 + (size_t)(lane + 64 * q) * 8) = w; }
            if (lane == 0) SM[t] = am * (1.f / 127.f);
        }
        unsigned char* U8 = ws + WS_UB; unsigned char* V8 = ws + WS_VB;
        float* SU = (float*)(ws + WS_SU); float* SV = (float*)(ws + WS_SV);
#ifdef REP_P4C
      for (int rep_ = 0; rep_ < 2; ++rep_)
#endif
        for (int e = gw; e < 16384; e += NGW) {
            f32x4 uv[8], vv[8]; float au = 0.f, av = 0.f;
#pragma unroll
            for (int q = 0; q < 2; ++q)
#pragma unroll
                for (int h4 = 0; h4 < 4; ++h4) { const int col = 16 * (lane + 64 * q) + 4 * h4;
                    uv[4 * q + h4] = *(const f32x4*)(u_emb + (size_t)e * 2048 + col) * *(const f32x4*)(g_ffn + col); vv[4 * q + h4] = *(const f32x4*)(v_emb + (size_t)e * 2048 + col); }
#pragma unroll
            for (int k = 0; k < 8; ++k) { au = fmaxf(au, fmaxf(fmaxf(fabsf(uv[k][0]), fabsf(uv[k][1])), fmaxf(fabsf(uv[k][2]), fabsf(uv[k][3]))));
                av = fmaxf(av, fmaxf(fmaxf(fabsf(vv[k][0]), fabsf(vv[k][1])), fmaxf(fabsf(vv[k][2]), fabsf(vv[k][3])))); }
            au = fmaxf(wave_max(au), 1e-30f); av = fmaxf(wave_max(av), 1e-30f);
            const float iu = 127.f / au, iv = 127.f / av;
#pragma unroll
            for (int q = 0; q < 2; ++q) { const int cc = lane + 64 * q; const size_t dst = (size_t)(cc >> 3) * (2 * MiB) + (size_t)e * 128 + (size_t)(cc & 7) * 16;
                u32x4 wu, wv;
#pragma unroll
                for (int h4 = 0; h4 < 4; ++h4) { wu[h4] = q8pack(uv[4 * q + h4][0], uv[4 * q + h4][1], uv[4 * q + h4][2], uv[4 * q + h4][3], iu); wv[h4] = q8pack(vv[4 * q + h4][0], vv[4 * q + h4][1], vv[4 * q + h4][2], vv[4 * q + h4][3], iv); }
                *(u32x4*)(U8 + dst) = wu; *(u32x4*)(V8 + dst) = wv; }
            if (lane == 0) { SU[e] = au * (1.f / 127.f); SV[e] = av * (1.f / 127.f); }
        }
    }
    SEAM(4);
    if (IN(5)) {
        pg8::Gemm g{(const bf16_t*)(ws + WS_M8), (const bf16_t*)(ws + WS_WOUT), T, 2048, 1024, 1024, 1024}; pg8::StaticOrder S; S.init(T, 2048, G, bx);
        EpiOutI E{x, out, (bf16_t*)(ws + WS_X1B), (float*)(ws + WS_RSQ1), (const float*)(ws + WS_SM), (const float*)(ws + WS_SWO)};
        pg8::gemm_phase<EpiOutI, true>(lds, g, S, E);
    }
    SEAM(5);
    if (IN(6)) {
        pg8::Gemm g{(const bf16_t*)(ws + WS_X1B), (const bf16_t*)(ws + WS_WPQ), T, 2048, 2048, 2048, 2048}; pg8::StaticOrder S; S.init(T, 2048, G, bx);
        EpiQP E{(bf16_t*)(ws + WS_QP)};
        pg8::gemm_phase<EpiQP, true>(lds, g, S, E);
#ifdef REP_P6
        pg8::gemm_phase<EpiQP, true>(lds, g, S, E);
#endif
    }
    SEAM(6);
    if (IN(7)) {
        for (int un = vcu; un < 256; un += G) { peer_unit(lds, ws, out, un); peer_fused_rounds(lds, ws, out, un); __syncthreads(); }
    }
#undef IN
#undef SEAM
}

extern "C" void kernel_launch(void* const* d_in, const int* in_sizes, int n_in, void* d_out, int out_size, void* d_ws, size_t ws_size, hipStream_t stream) {
    static int grid = 0;
    if (grid == 0) {
        if (n_in != 22 || out_size != T * DM || ws_size < WS_END) { fprintf(stderr, "kernel_launch: unexpected problem (n_in %d out %d ws %zu)\n", n_in, out_size, ws_size); grid = -1; return; }
        int dev = 0, cus = 0, per_cu = 0;
        (void)hipGetDevice(&dev); (void)hipDeviceGetAttribute(&cus, hipDeviceAttributeMultiprocessorCount, dev);
        if (hipFuncSetAttribute((const void*)mk_fwd, hipFuncAttributeMaxDynamicSharedMemorySize, LDS_BYTES) != hipSuccess) { fprintf(stderr, "kernel_launch: hipFuncSetAttribute failed\n"); grid = -1; return; }
        if (hipOccupancyMaxActiveBlocksPerMultiprocessor(&per_cu, (const void*)mk_fwd, 512, LDS_BYTES) != hipSuccess || per_cu < 1) { fprintf(stderr, "kernel_launch: occupancy query says %d\n", per_cu); (void)hipGetLastError(); grid = -1; return; }
        grid = cus;
        fprintf(stderr, "kernel_launch: grid %d (per_cu %d)\n", grid, per_cu);
    }
    if (grid < 0) return;
    if (hipMemsetAsync(d_ws, 0, 16384, stream) != hipSuccess) { fprintf(stderr, "kernel_launch: memset failed\n"); return; }
    Args a{};
    for (int i = 0; i < 22; ++i) a.in[i] = d_in[i];
    a.out = (float*)d_out; a.ws = (unsigned char*)d_ws;
#if MK_N_LAUNCHES == 1
    a.ph_lo = 0; a.ph_hi = NPH;
    void* kargs[] = {&a};
    hipError_t e = hipLaunchCooperativeKernel((const void*)mk_fwd, dim3(grid), dim3(512), kargs, LDS_BYTES, stream);
    if (e != hipSuccess) fprintf(stderr, "kernel_launch: cooperative launch failed: %s\n", hipGetErrorString(e));
#else
    for (int p = 0; p < NPH; ++p) { a.ph_lo = p; a.ph_hi = p + 1; hipLaunchKernelGGL(mk_fwd, dim3(grid), dim3(512), LDS_BYTES, stream, a); }
#endif
}
```

```cpp
#include <hip/hip_runtime.h>
#include <hip/hip_cooperative_groups.h>
#include <cstdio>
#include <cstdint>
namespace cg = cooperative_groups;

#ifndef MK_N_LAUNCHES
#define MK_N_LAUNCHES 1
#endif

#define LAS __attribute__((address_space(3)))
typedef unsigned short bf16_t;
typedef short bf16x8 __attribute__((ext_vector_type(8)));
typedef short s16x4 __attribute__((ext_vector_type(4)));
typedef float f32x4 __attribute__((ext_vector_type(4)));
typedef int i32x4 __attribute__((ext_vector_type(4)));
typedef float f32x16 __attribute__((ext_vector_type(16)));
typedef unsigned u32x4 __attribute__((ext_vector_type(4)));
typedef unsigned u32x2 __attribute__((ext_vector_type(2)));
typedef float f32x2_t __attribute__((ext_vector_type(2)));
typedef __bf16 bf16x2_t __attribute__((ext_vector_type(2)));
typedef short v4i16_t __attribute__((ext_vector_type(4)));

constexpr int T = 16384, DM = 2048, NB = 8, SEQ = 2048;
constexpr float EPS = 1e-6f;
constexpr int N1 = 11520;
constexpr float QSCALE = 0.07216878364870322f * 1.4426950408889634f;

constexpr size_t MiB = 1u << 20;
constexpr size_t WS_WUQ = 1 * MiB, WS_WUKV = 4 * MiB, WS_WOUT = 8 * MiB, WS_WPQ = 16 * MiB, WS_KEYS = 24 * MiB, WS_ROPE = 25 * MiB;
constexpr size_t WS_RSQ0 = 29 * MiB, WS_RSQ1 = 30 * MiB, WS_DEC = 32 * MiB, WS_SSQ = 33 * MiB, WS_KPE = 35 * MiB;
constexpr size_t WS_WIN = 40 * MiB, WS_H = 85 * MiB;
constexpr size_t WS_QH = 40 * MiB;
constexpr size_t WS_X1B = 40 * MiB;
constexpr size_t WS_CQKV = 149 * MiB, WS_QG = 181 * MiB, WS_KG = 213 * MiB, WS_VG = 245 * MiB, WS_OG = 309 * MiB, WS_GA = 373 * MiB, WS_GB = 437 * MiB, WS_MISC = 501 * MiB;
constexpr size_t WS_UB = WS_QG, WS_VB = WS_VG, WS_QP = WS_OG;
constexpr size_t WS_ABUF = 138 * MiB;
constexpr size_t WS_WG8 = 40 * MiB;
constexpr size_t WS_PMAX = 37 * MiB, WS_SWG = 39 * MiB;
constexpr size_t WS_SM = 39 * MiB + 512 * 1024, WS_SWO = 39 * MiB + 768 * 1024, WS_PMAXO = 38 * MiB + 512 * 1024;
constexpr size_t WS_PMAXP = 38 * MiB + 768 * 1024, WS_SWP = 39 * MiB + 832 * 1024;
constexpr size_t WS_M8 = WS_OG;
constexpr size_t WS_END = 509 * MiB;
constexpr size_t WS_SELT = WS_CQKV, WS_GATE = WS_CQKV + 4 * MiB, WS_R1G = WS_CQKV + 20 * MiB, WS_ACTP = WS_GA;
constexpr size_t WS_SX = WS_CQKV + 21 * MiB, WS_SU = WS_CQKV + 22 * MiB, WS_SV = WS_CQKV + 23 * MiB, WS_SW = WS_CQKV + 24 * MiB, WS_W8 = WS_CQKV + 25 * MiB;
constexpr size_t WS_X8 = WS_KG;
constexpr int NPH = 8;

constexpr int LDS_BYTES = 163840;
constexpr int XCH_OFF = 132096;

__device__ __forceinline__ unsigned pkbf(float lo, float hi) { f32x2_t v = {lo, hi}; bf16x2_t b = __builtin_convertvector(v, bf16x2_t); return __builtin_bit_cast(unsigned, b); }
__device__ __forceinline__ float bf_lo(unsigned u) { return __uint_as_float(u << 16); }
__device__ __forceinline__ float bf_hi(unsigned u) { return __uint_as_float(u & 0xffff0000u); }
__device__ __forceinline__ float bf1(bf16_t u) { return __uint_as_float(((unsigned)u) << 16); }
__device__ __forceinline__ bf16_t f2bf(float f) { return (bf16_t)(pkbf(f, 0.f) & 0xffffu); }
__device__ __forceinline__ float wave_sum(float v) {
#pragma unroll
    for (int o = 1; o < 64; o <<= 1) v += __shfl_xor(v, o);
    return v;
}
__device__ __forceinline__ float wave_max(float v) {
#pragma unroll
    for (int o = 1; o < 64; o <<= 1) v = fmaxf(v, __shfl_xor(v, o));
    return v;
}
__device__ __forceinline__ unsigned q8pack(float a, float b, float c, float d, float inv) {
    const int ia = (int)__builtin_rintf(a * inv), ib = (int)__builtin_rintf(b * inv), ic = (int)__builtin_rintf(c * inv), id = (int)__builtin_rintf(d * inv);
    return ((unsigned)ia & 0xffu) | (((unsigned)ib & 0xffu) << 8) | (((unsigned)ic & 0xffu) << 16) | ((unsigned)id << 24);
}
__device__ __forceinline__ float fast_sigmoid(float v) { return __builtin_amdgcn_rcpf(1.f + __builtin_amdgcn_exp2f(-1.4426950408889634f * v)); }

namespace pg8 {
constexpr int BM = 256, BK = 64, HALF = 128, HTB = HALF * BK * 2, STAGE_BYTES = 8 * HTB, NXCD = 8, WGM = 8;
__host__ __device__ __forceinline__ int lds_byte(int r, int c) { const int st = (r >> 4) * 2 + (c >> 5), rr = r & 15, cc = c & 31, ob = rr * 64 + cc * 2; return st * 1024 + (ob ^ (((ob >> 9) & 1) << 5)); }
__host__ __device__ __forceinline__ void stage_rc(int b, int& R, int& C) { const int st = b / 1024, sb = b % 1024, swz = sb ^ (((sb >> 9) & 1) << 5); R = (st >> 1) * 16 + swz / 64; C = (st & 1) * 32 + (swz % 64) / 2; }
__host__ __device__ __forceinline__ int perm32(int rho) { const int n = rho >> 4, i = rho & 15; return 8 * (i >> 2) + 4 * n + (i & 3); }
struct Unit { int pm, pn; };
struct Gemm { const bf16_t* A; const bf16_t* Bt; int M, N, K, lda, ldb; };
struct StaticOrder {
    int nM, nN, nwg, G, c;
    __device__ void init(int M, int N, int G_, int c_) { nM = M / BM; nN = N / BM; nwg = nM * nN; G = G_; c = c_; }
    __device__ bool next(int i, Unit& u) const {
        const long L = (long)i * G + c; if (L >= nwg) return false;
        int wgid = (int)L; { const int q = nwg / NXCD, r = nwg % NXCD, xcd = wgid % NXCD, off = wgid / NXCD; wgid = (xcd < r ? xcd * (q + 1) : r * (q + 1) + (xcd - r) * q) + off; }
        const int nig = WGM * nN, gid = wgid / nig, fm = gid * WGM, gsz = (nM - fm) < WGM ? (nM - fm) : WGM;
        u.pm = fm + ((wgid % nig) % gsz); u.pn = (wgid % nig) / gsz; return true;
    }
};
__device__ __forceinline__ f32x4 mma16(bf16x8 a, bf16x8 b, f32x4 c) { return __builtin_amdgcn_mfma_f32_16x16x32_bf16(a, b, c, 0, 0, 0); }
__device__ __forceinline__ i32x4 mma16(bf16x8 a, bf16x8 b, i32x4 c) { return __builtin_amdgcn_mfma_i32_16x16x64_i8(__builtin_bit_cast(i32x4, a), __builtin_bit_cast(i32x4, b), c, 0, 0, 0); }
template <class Epi, bool ALIGN_EPI>
__device__ __forceinline__ void gemm_phase(LAS unsigned char* lds, const Gemm g, const StaticOrder& S, const Epi& E) {
    const int tid = threadIdx.x, wid = __builtin_amdgcn_readfirstlane(tid >> 6), lane = tid & 63, wr = wid >> 2, wc = wid & 3, fr = lane & 15, fq = lane >> 4;
    const int K = g.K, nt = K / BK;
    unsigned voffA[2], voffB[2];
#pragma unroll
    for (int i = 0; i < 2; ++i) { int R, C; stage_rc(tid * 16 + i * 8192, R, C); const int Rb = Epi::PERM ? ((R & ~31) + perm32(R & 31)) : R;
        voffA[i] = (unsigned)(R * g.lda + C) * 2u; voffB[i] = (unsigned)(Rb * g.ldb + C) * 2u; }
    const size_t kstep = (size_t)(BK * 2);
    const size_t hstepA = (size_t)HALF * g.lda * 2, hstepB = (size_t)HALF * g.ldb * 2;
    const size_t tstepA = 2 * hstepA, tstepB = 2 * hstepB;
    const unsigned ldsw = (unsigned)wid * 1024u;
    const int aoff = lds_byte(wr * 64 + fr, fq * 8), boff = lds_byte(wc * 32 + fr, fq * 8);
#define PG8_SA(b, h) (((b) * 2 + (h)) * HTB)
#define PG8_SB(b, h) ((4 + (b) * 2 + (h)) * HTB)
#define PG8_STAGE(bufoff, gbase, voff) do { _Pragma("unroll") for (int _i = 0; _i < 2; ++_i) \
        __builtin_amdgcn_global_load_lds((const unsigned*)((const char*)(gbase) + (voff)[_i]), (LAS unsigned*)(lds + (bufoff) + ldsw + _i * 8192), 16, 0, 0); } while (0)
#define PG8_LDA(dst, b, h) do { _Pragma("unroll") for (int m = 0; m < 4; ++m) _Pragma("unroll") for (int k = 0; k < 2; ++k) dst[m][k] = *(const LAS bf16x8*)(lds + PG8_SA(b, h) + aoff + m * 2048 + k * 1024); } while (0)
#define PG8_LDB(dst, b, h) do { _Pragma("unroll") for (int n = 0; n < 2; ++n) _Pragma("unroll") for (int k = 0; k < 2; ++k) dst[n][k] = *(const LAS bf16x8*)(lds + PG8_SB(b, h) + boff + n * 2048 + k * 1024); } while (0)
#define PG8_MMA(ai, bj, At, Bt) do { __builtin_amdgcn_s_setprio(1); _Pragma("unroll") for (int m = 0; m < 4; ++m) _Pragma("unroll") for (int n = 0; n < 2; ++n) _Pragma("unroll") for (int k = 0; k < 2; ++k) \
        acc[ai][bj][m][n] = mma16(Bt[n][k], At[m][k], acc[ai][bj][m][n]); __builtin_amdgcn_s_setprio(0); } while (0)
#define PG8_WAIT_V(n) asm volatile("s_waitcnt vmcnt(" #n ")" ::: "memory")
#define PG8_WAIT_L(n) asm volatile("s_waitcnt lgkmcnt(" #n ")" ::: "memory")
#define PG8_BAR __builtin_amdgcn_s_barrier()
#define PG8_SCHED __builtin_amdgcn_sched_barrier(0)
    Unit cur, nxt; int ui = 0;
    if (!S.next(0, cur)) return;
    typename Epi::acc_t acc[2][2][4][2];
    E.init(acc, cur, wr, wc, fr, fq);
    bf16x8 At[4][2], B0[2][2], B1[2][2];
    const char* cA = (const char*)g.A + (size_t)cur.pm * tstepA; const char* cB = (const char*)g.Bt + (size_t)cur.pn * tstepB;
    PG8_STAGE(PG8_SB(0, 0), cB, voffB); PG8_STAGE(PG8_SB(0, 1), cB + hstepB, voffB); PG8_STAGE(PG8_SA(0, 0), cA, voffA); PG8_STAGE(PG8_SA(0, 1), cA + hstepA, voffA);
    if (wr == 1) PG8_BAR;
    PG8_WAIT_V(2); PG8_BAR;
    PG8_STAGE(PG8_SB(1, 0), cB + kstep, voffB); PG8_STAGE(PG8_SA(1, 0), cA + kstep, voffA); PG8_STAGE(PG8_SB(1, 1), cB + hstepB + kstep, voffB);
    PG8_WAIT_V(6); PG8_BAR;
    for (;;) {
        const bool has_next = S.next(ui + 1, nxt);
        const char* nA = has_next ? (const char*)g.A + (size_t)nxt.pm * tstepA : cA; const char* nB = has_next ? (const char*)g.Bt + (size_t)nxt.pn * tstepB : cB;
        for (int t = 0; t < nt; t += 2) {
            const bool last = (t == nt - 2);
            const char* a1 = cA + (size_t)(t + 1) * kstep;
            const char* a2 = last ? nA : cA + (size_t)(t + 2) * kstep; const char* b2 = last ? nB : cB + (size_t)(t + 2) * kstep;
            const char* a3 = a2 + kstep; const char* b3 = b2 + kstep;
            PG8_LDB(B0, 0, 0); PG8_LDB(B1, 0, 1); PG8_SCHED; PG8_LDA(At, 0, 0); PG8_STAGE(PG8_SA(1, 1), a1 + hstepA, voffA);
            PG8_WAIT_V(8); PG8_WAIT_L(0); PG8_BAR; PG8_MMA(0, 0, At, B0); PG8_MMA(0, 1, At, B1); PG8_BAR; PG8_SCHED;
            PG8_LDA(At, 0, 1); PG8_STAGE(PG8_SB(0, 0), b2, voffB); PG8_STAGE(PG8_SB(0, 1), b2 + hstepB, voffB); PG8_STAGE(PG8_SA(0, 0), a2, voffA);
            PG8_WAIT_V(8); PG8_WAIT_L(0); PG8_BAR; PG8_MMA(1, 0, At, B0); PG8_MMA(1, 1, At, B1); PG8_BAR; PG8_SCHED;
            PG8_LDB(B0, 1, 0); PG8_LDB(B1, 1, 1); PG8_SCHED; PG8_LDA(At, 1, 0); PG8_STAGE(PG8_SA(0, 1), a2 + hstepA, voffA);
            PG8_WAIT_V(8); PG8_WAIT_L(0); PG8_BAR; PG8_MMA(0, 0, At, B0); PG8_MMA(0, 1, At, B1); PG8_BAR; PG8_SCHED;
            PG8_LDA(At, 1, 1); PG8_STAGE(PG8_SB(1, 0), b3, voffB); PG8_STAGE(PG8_SB(1, 1), b3 + hstepB, voffB); PG8_STAGE(PG8_SA(1, 0), a3, voffA);
            PG8_WAIT_V(8); PG8_WAIT_L(0); PG8_BAR; PG8_MMA(1, 0, At, B0); PG8_MMA(1, 1, At, B1); PG8_BAR; PG8_SCHED;
        }
        if constexpr (ALIGN_EPI) { if (wr == 0) PG8_BAR; }
        E(acc, cur, wr, wc, fr, fq);
        if (!has_next) break;
        E.init(acc, nxt, wr, wc, fr, fq);
        cur = nxt; cA = nA; cB = nB; ++ui;
        if constexpr (ALIGN_EPI) { if (wr == 1) PG8_BAR; }
    }
    PG8_WAIT_V(0);
    if constexpr (!ALIGN_EPI) { if (wr == 0) PG8_BAR; }
    PG8_BAR;
#undef PG8_SA
#undef PG8_SB
#undef PG8_STAGE
#undef PG8_LDA
#undef PG8_LDB
#undef PG8_MMA
#undef PG8_WAIT_V
#undef PG8_WAIT_L
#undef PG8_BAR
#undef PG8_SCHED
}
}
using pg8::Unit;

#define RAW_BAR() asm volatile("s_waitcnt lgkmcnt(0)\n\ts_barrier" ::: "memory")

struct EpiG1 {
    static constexpr bool PERM = true;
    typedef f32x4 acc_t;
    __device__ __forceinline__ void init(f32x4 (&acc)[2][2][4][2], const Unit&, int, int, int, int) const {
#pragma unroll
        for (int a = 0; a < 2; ++a)
#pragma unroll
            for (int b = 0; b < 2; ++b)
#pragma unroll
                for (int m = 0; m < 4; ++m)
#pragma unroll
                    for (int n = 0; n < 2; ++n) acc[a][b][m][n] = (f32x4){0.f, 0.f, 0.f, 0.f};
    }
    unsigned char* ws; const float* bgate; float* rsq0;
    __device__ __forceinline__ void operator()(const f32x4 (&acc)[2][2][4][2], const Unit& u, int wr, int wc, int fr, int fq) const {
        asm volatile("" : "+v"(fr), "+v"(fq));
        const int pn = u.pn; bf16_t* base; int ld, ct, act = 0; const float* bias = nullptr;
        if (pn < 4)       { base = (bf16_t*)(ws + WS_CQKV); ld = 1024; ct = pn; }
        else if (pn < 8)  { base = (bf16_t*)(ws + WS_QG);   ld = 1024; ct = pn - 4; }
        else if (pn < 12) { base = (bf16_t*)(ws + WS_KG);   ld = 1024; ct = pn - 8; }
        else if (pn < 20) { base = (bf16_t*)(ws + WS_VG);   ld = 2048; ct = pn - 12; }
        else              { base = (bf16_t*)(ws + WS_MISC); ld = 256;  ct = 0; }
        const int col0 = ct * 256 + wc * 32 + 8 * fq;
        f32x4 bv[2][2];
#pragma unroll
        for (int bj = 0; bj < 2; ++bj)
#pragma unroll
            for (int n = 0; n < 2; ++n) bv[bj][n] = bias ? *(const f32x4*)(bias + col0 + bj * 128 + 4 * n) : (f32x4){0.f, 0.f, 0.f, 0.f};
#pragma unroll
        for (int ai = 0; ai < 2; ++ai)
#pragma unroll
            for (int m = 0; m < 4; ++m) {
                const int row = u.pm * 256 + ai * 128 + wr * 64 + m * 16 + fr;
                bf16_t* rowp = base + (size_t)row * ld + col0;
                float ss = 0.f;
#pragma unroll
                for (int bj = 0; bj < 2; ++bj) {
                    f32x4 v0 = acc[ai][bj][m][0] + bv[bj][0], v1 = acc[ai][bj][m][1] + bv[bj][1];
                    if (act == 1) {
#pragma unroll
                        for (int j = 0; j < 4; ++j) { v0[j] = v0[j] * fast_sigmoid(v0[j]); v1[j] = v1[j] * fast_sigmoid(v1[j]); }
                    } else if (act == 2) {
#pragma unroll
                        for (int j = 0; j < 4; ++j) { v0[j] = fast_sigmoid(v0[j]); v1[j] = fast_sigmoid(v1[j]); }
                    }
#pragma unroll
                    for (int j = 0; j < 4; ++j) ss += v0[j] * v0[j] + v1[j] * v1[j];
                    u32x4 w; w.x = pkbf(v0[0], v0[1]); w.y = pkbf(v0[2], v0[3]); w.z = pkbf(v1[0], v1[1]); w.w = pkbf(v1[2], v1[3]);
                    *(u32x4*)(rowp + bj * 128) = w;
                }
                if (pn < 4) {
                    ss += __shfl_xor(ss, 16); ss += __shfl_xor(ss, 32);
                    if (fq == 0) rsq0[((size_t)row * 4 + pn) * 4 + wc] = ss;
                }
            }
    }
};

struct EpiG1i {
    static constexpr bool PERM = true;
    typedef i32x4 acc_t;
    __device__ __forceinline__ void init(i32x4 (&acc)[2][2][4][2], const Unit&, int, int, int, int) const {
#pragma unroll
        for (int a = 0; a < 2; ++a)
#pragma unroll
            for (int b = 0; b < 2; ++b)
#pragma unroll
                for (int m = 0; m < 4; ++m)
#pragma unroll
                    for (int n = 0; n < 2; ++n) acc[a][b][m][n] = (i32x4){0, 0, 0, 0};
    }
    unsigned char* ws; const float* bgate; const float* sh; const float* swg; float* rsq0;
    __device__ __forceinline__ void operator()(const i32x4 (&acc)[2][2][4][2], const Unit& u, int wr, int wc, int fr, int fq) const {
        asm volatile("" : "+v"(fr), "+v"(fq));
        const int pn = u.pn; bf16_t* base; int ld, ct, act = 0; const float* bias = nullptr;
        if (pn < 4)       { base = (bf16_t*)(ws + WS_CQKV); ld = 1024; ct = pn; }
        else if (pn < 8)  { base = (bf16_t*)(ws + WS_QG);   ld = 1024; ct = pn - 4; }
        else if (pn < 12) { base = (bf16_t*)(ws + WS_KG);   ld = 1024; ct = pn - 8; }
        else if (pn < 20) { base = (bf16_t*)(ws + WS_VG);   ld = 2048; ct = pn - 12; }
        else if (pn < 28) { base = (bf16_t*)(ws + WS_OG);   ld = 2048; ct = pn - 20; act = 1; }
        else if (pn < 36) { base = (bf16_t*)(ws + WS_GA);   ld = 2048; ct = pn - 28; act = 2; bias = bgate; }
        else if (pn < 44) { base = (bf16_t*)(ws + WS_GB);   ld = 2048; ct = pn - 36; act = 2; bias = bgate + 2048; }
        else              { base = (bf16_t*)(ws + WS_MISC); ld = 256;  ct = 0; }
        const int col0 = ct * 256 + wc * 32 + 8 * fq, colg = pn * 256 + wc * 32 + 8 * fq;
        f32x4 bv[2][2], sw[2][2];
#pragma unroll
        for (int bj = 0; bj < 2; ++bj)
#pragma unroll
            for (int n = 0; n < 2; ++n) { bv[bj][n] = bias ? *(const f32x4*)(bias + col0 + bj * 128 + 4 * n) : (f32x4){0.f, 0.f, 0.f, 0.f}; sw[bj][n] = *(const f32x4*)(swg + colg + bj * 128 + 4 * n); }
#pragma unroll
        for (int ai = 0; ai < 2; ++ai)
#pragma unroll
            for (int m = 0; m < 4; ++m) {
                const int row = u.pm * 256 + ai * 128 + wr * 64 + m * 16 + fr;
                const float shr = sh[row];
                bf16_t* rowp = base + (size_t)row * ld + col0;
                float ss = 0.f;
#pragma unroll
                for (int bj = 0; bj < 2; ++bj) {
                    f32x4 v0, v1;
#pragma unroll
                    for (int j = 0; j < 4; ++j) { v0[j] = (float)acc[ai][bj][m][0][j] * shr * sw[bj][0][j] + bv[bj][0][j]; v1[j] = (float)acc[ai][bj][m][1][j] * shr * sw[bj][1][j] + bv[bj][1][j]; }
                    if (act == 1) {
#pragma unroll
                        for (int j = 0; j < 4; ++j) { v0[j] = v0[j] * fast_sigmoid(v0[j]); v1[j] = v1[j] * fast_sigmoid(v1[j]); }
                    } else if (act == 2) {
#pragma unroll
                        for (int j = 0; j < 4; ++j) { v0[j] = fast_sigmoid(v0[j]); v1[j] = fast_sigmoid(v1[j]); }
                    }
#pragma unroll
                    for (int j = 0; j < 4; ++j) ss += v0[j] * v0[j] + v1[j] * v1[j];
                    u32x4 w; w.x = pkbf(v0[0], v0[1]); w.y = pkbf(v0[2], v0[3]); w.z = pkbf(v1[0], v1[1]); w.w = pkbf(v1[2], v1[3]);
                    *(u32x4*)(rowp + bj * 128) = w;
                }
                if (pn < 4) {
                    ss += __shfl_xor(ss, 16); ss += __shfl_xor(ss, 32);
                    if (fq == 0) rsq0[((size_t)row * 4 + pn) * 4 + wc] = ss;
                }
            }
    }
};

template <int MODE> struct EpiUp {
    static constexpr bool PERM = true;
    typedef f32x4 acc_t;
    __device__ __forceinline__ void init(f32x4 (&acc)[2][2][4][2], const Unit&, int, int, int, int) const {
#pragma unroll
        for (int a = 0; a < 2; ++a)
#pragma unroll
            for (int b = 0; b < 2; ++b)
#pragma unroll
                for (int m = 0; m < 4; ++m)
#pragma unroll
                    for (int n = 0; n < 2; ++n) acc[a][b][m][n] = (f32x4){0.f, 0.f, 0.f, 0.f};
    }
    LAS unsigned char* lds; const float* rsq0; int rsq_off; const float* gn; const float* gr; const float* rope; bf16_t* out0; bf16_t* out1;
    __device__ __forceinline__ void operator()(const f32x4 (&acc)[2][2][4][2], const Unit& u, int wr, int wc, int fr, int fq) const {
        asm volatile("" : "+v"(fr), "+v"(fq));
        auto rcf = [&](int ai, int m) -> float {
            const int row = u.pm * 256 + ai * 128 + wr * 64 + m * 16 + fr;
            const f32x4 a = *(const f32x4*)(rsq0 + (size_t)row * 16 + rsq_off), b = *(const f32x4*)(rsq0 + (size_t)row * 16 + rsq_off + 4);
            const float s = (a[0] + a[1]) + (a[2] + a[3]) + (b[0] + b[1]) + (b[2] + b[3]);
            return __builtin_amdgcn_rsqf(s * (1.f / 512.f) + EPS);
        };
        const int pn = u.pn;
        if (pn < 8) {
            LAS float* X = (LAS float*)(lds + XCH_OFF);
#pragma unroll
            for (int ai = 0; ai < 2; ++ai)
#pragma unroll
                for (int m = 0; m < 4; ++m) {
                    const float rcv = rcf(ai, m);
#pragma unroll
                    for (int bj = 0; bj < 2; ++bj) {
                        float s = 0.f;
#pragma unroll
                        for (int n = 0; n < 2; ++n)
#pragma unroll
                            for (int j = 0; j < 4; ++j) { const float v = acc[ai][bj][m][n][j] * rcv; s += v * v; }
                        s += __shfl_xor(s, 16); s += __shfl_xor(s, 32);
                        if (fq == 0) X[((ai * 128 + wr * 64 + m * 16 + fr) * 2 + bj) * 4 + wc] = s;
                    }
                    asm volatile("" ::: "memory");
                }
            RAW_BAR();
            const int d0 = wc * 32 + 8 * fq;
            const f32x4 g0 = *(const f32x4*)(gn + d0), g1 = *(const f32x4*)(gn + d0 + 4);
#pragma unroll
            for (int ai = 0; ai < 2; ++ai)
#pragma unroll
                for (int m = 0; m < 4; ++m) {
                    const int rl = ai * 128 + wr * 64 + m * 16 + fr; const size_t row = (size_t)u.pm * 256 + rl;
                    const float rcv = rcf(ai, m);
#pragma unroll
                    for (int bj = 0; bj < 2; ++bj) {
                        const f32x4 t = *(const LAS f32x4*)(X + (rl * 2 + bj) * 4);
                        const float tot = (t[0] + t[1]) + (t[2] + t[3]);
                        float rs = __builtin_amdgcn_rsqf(tot * (1.f / 128.f) + EPS) * rcv;
                        if (MODE == 0) rs *= QSCALE;
                        const f32x4 v0 = acc[ai][bj][m][0] * rs * g0, v1 = acc[ai][bj][m][1] * rs * g1;
                        u32x4 w; w.x = pkbf(v0[0], v0[1]); w.y = pkbf(v0[2], v0[3]); w.z = pkbf(v1[0], v1[1]); w.w = pkbf(v1[2], v1[3]);
                        const int head = 2 * pn + bj;
                        if (MODE == 0) *(u32x4*)(out0 + row * 3072 + head * 192 + d0) = w;
                        else           *(u32x4*)(out0 + row * 2048 + head * 128 + d0) = w;
                    }
                    asm volatile("" ::: "memory");
                }
        } else if (MODE == 1) {
            const int d0 = wc * 32 + 8 * fq;
#pragma unroll
            for (int ai = 0; ai < 2; ++ai)
#pragma unroll
                for (int m = 0; m < 4; ++m) {
                    const size_t row = (size_t)u.pm * 256 + ai * 128 + wr * 64 + m * 16 + fr;
                    const float rcv = rcf(ai, m);
#pragma unroll
                    for (int bj = 0; bj < 2; ++bj) {
                        const f32x4 v0 = acc[ai][bj][m][0] * rcv, v1 = acc[ai][bj][m][1] * rcv;
                        u32x4 w; w.x = pkbf(v0[0], v0[1]); w.y = pkbf(v0[2], v0[3]); w.z = pkbf(v1[0], v1[1]); w.w = pkbf(v1[2], v1[3]);
                        const int head = 2 * (pn - 8) + bj;
                        *(u32x4*)(out1 + row * 2048 + head * 128 + d0) = w;
                    }
                    asm volatile("" ::: "memory");
                }
        } else {
            const int head = 4 * (pn - 8) + wc;
#pragma unroll
            for (int ai = 0; ai < 2; ++ai)
#pragma unroll
                for (int m = 0; m < 4; ++m) {
                    const size_t row = (size_t)u.pm * 256 + ai * 128 + wr * 64 + m * 16 + fr;
                    const float rcv = rcf(ai, m);
                    float s = 0.f;
#pragma unroll
                    for (int bj = 0; bj < 2; ++bj)
#pragma unroll
                        for (int n = 0; n < 2; ++n)
#pragma unroll
                            for (int j = 0; j < 4; ++j) { const float v = acc[ai][bj][m][n][j] * rcv; s += v * v; }
                    s += __shfl_xor(s, 16); s += __shfl_xor(s, 32);
                    const float rs = __builtin_amdgcn_rsqf(s * (1.f / 64.f) + EPS) * rcv;
#pragma unroll
                    for (int bj = 0; bj < 2; ++bj) {
                        unsigned wv[4];
#pragma unroll
                        for (int n = 0; n < 2; ++n) {
                            const int i0 = 16 * bj + 4 * fq + 2 * n;
                            const f32x2_t cs = *(const f32x2_t*)(rope + row * 64 + i0), sn = *(const f32x2_t*)(rope + row * 64 + 32 + i0);
                            const f32x2_t ga = *(const f32x2_t*)(gr + i0), gb = *(const f32x2_t*)(gr + 32 + i0);
                            const f32x4 a = acc[ai][bj][m][n];
                            const float x1a = a[0] * rs * ga[0], x2a = a[1] * rs * gb[0], x1b = a[2] * rs * ga[1], x2b = a[3] * rs * gb[1];
                            const float o0 = (x1a * cs[0] - x2a * sn[0]) * QSCALE, o1 = (x2a * cs[0] + x1a * sn[0]) * QSCALE;
                            const float o2 = (x1b * cs[1] - x2b * sn[1]) * QSCALE, o3 = (x2b * cs[1] + x1b * sn[1]) * QSCALE;
                            wv[2 * n] = pkbf(o0, o1); wv[2 * n + 1] = pkbf(o2, o3);
                        }
                        u32x4 w; w.x = wv[0]; w.y = wv[1]; w.z = wv[2]; w.w = wv[3];
                        *(u32x4*)(out0 + row * 3072 + head * 192 + 128 + 32 * bj + 8 * fq) = w;
                    }
                    asm volatile("" ::: "memory");
                }
        }
    }
};

struct EpiOut {
    static constexpr bool PERM = false;
    typedef f32x4 acc_t;
    const float* x; float* out; bf16_t* x1b; float* rsq1;
    __device__ __forceinline__ void init(f32x4 (&acc)[2][2][4][2], const Unit& u, int wr, int wc, int fr, int fq) const {
        asm volatile("" : "+v"(fr), "+v"(fq));
        const int col0 = u.pn * 256 + wc * 32 + 4 * fq;
#pragma unroll
        for (int ai = 0; ai < 2; ++ai)
#pragma unroll
            for (int m = 0; m < 4; ++m) { const size_t off = ((size_t)u.pm * 256 + ai * 128 + wr * 64 + m * 16 + fr) * 2048 + col0;
#pragma unroll
                for (int bj = 0; bj < 2; ++bj)
#pragma unroll
                    for (int n = 0; n < 2; ++n) acc[ai][bj][m][n] = *(const f32x4*)(x + off + bj * 128 + n * 16); }
    }
    __device__ __forceinline__ void operator()(const f32x4 (&acc)[2][2][4][2], const Unit& u, int wr, int wc, int fr, int fq) const {
        asm volatile("" : "+v"(fr), "+v"(fq));
        const int col0 = u.pn * 256 + wc * 32 + 4 * fq;
#pragma unroll
        for (int ai = 0; ai < 2; ++ai)
#pragma unroll
            for (int m = 0; m < 4; ++m) {
                const size_t row = (size_t)u.pm * 256 + ai * 128 + wr * 64 + m * 16 + fr; const size_t off = row * 2048 + col0;
                float ss = 0.f;
#pragma unroll
                for (int bj = 0; bj < 2; ++bj)
#pragma unroll
                    for (int n = 0; n < 2; ++n) {
                        const f32x4 v = acc[ai][bj][m][n];
                        *(f32x4*)(out + off + bj * 128 + n * 16) = v;
                        u32x2 w; w.x = pkbf(v[0], v[1]); w.y = pkbf(v[2], v[3]);
                        *(u32x2*)(x1b + off + bj * 128 + n * 16) = w;
                        ss += (v[0] * v[0] + v[1] * v[1]) + (v[2] * v[2] + v[3] * v[3]);
                    }
                ss += __shfl_xor(ss, 16); ss += __shfl_xor(ss, 32);
                if (fq == 0) rsq1[row * 32 + u.pn * 4 + wc] = ss;
            }
    }
};
struct EpiOutI {
    static constexpr bool PERM = true;
    typedef i32x4 acc_t;
    __device__ __forceinline__ void init(i32x4 (&acc)[2][2][4][2], const Unit&, int, int, int, int) const {
#pragma unroll
        for (int a = 0; a < 2; ++a)
#pragma unroll
            for (int b = 0; b < 2; ++b)
#pragma unroll
                for (int m = 0; m < 4; ++m)
#pragma unroll
                    for (int n = 0; n < 2; ++n) acc[a][b][m][n] = (i32x4){0, 0, 0, 0};
    }
    const float* x; bf16_t* x1b; float* rsq1; const float* sm; const float* swo;
    __device__ __forceinline__ void operator()(const i32x4 (&acc)[2][2][4][2], const Unit& u, int wr, int wc, int fr, int fq) const {
        asm volatile("" : "+v"(fr), "+v"(fq));
        const int col0 = u.pn * 256 + wc * 32 + 8 * fq;
        f32x4 sw[2][2];
#pragma unroll
        for (int bj = 0; bj < 2; ++bj)
#pragma unroll
            for (int n = 0; n < 2; ++n) sw[bj][n] = *(const f32x4*)(swo + col0 + bj * 128 + 4 * n);
#pragma unroll
        for (int ai = 0; ai < 2; ++ai)
#pragma unroll
            for (int m = 0; m < 4; ++m) {
                const size_t row = (size_t)u.pm * 256 + ai * 128 + wr * 64 + m * 16 + fr; const size_t off = row * 2048 + col0;
                const float smr = sm[row];
                f32x4 xv[2][2];
#pragma unroll
                for (int bj = 0; bj < 2; ++bj)
#pragma unroll
                    for (int n = 0; n < 2; ++n) xv[bj][n] = __builtin_nontemporal_load((const f32x4*)(x + off + bj * 128 + 4 * n));
                float ss = 0.f;
#pragma unroll
                for (int bj = 0; bj < 2; ++bj) {
                    f32x4 v0, v1;
#pragma unroll
                    for (int j = 0; j < 4; ++j) { v0[j] = xv[bj][0][j] + (float)acc[ai][bj][m][0][j] * smr * sw[bj][0][j]; v1[j] = xv[bj][1][j] + (float)acc[ai][bj][m][1][j] * smr * sw[bj][1][j]; }
                    u32x4 w; w.x = pkbf(v0[0], v0[1]); w.y = pkbf(v0[2], v0[3]); w.z = pkbf(v1[0], v1[1]); w.w = pkbf(v1[2], v1[3]);
                    *(u32x4*)(x1b + off + bj * 128) = w;
                    ss += ((v0[0] * v0[0] + v0[1] * v0[1]) + (v0[2] * v0[2] + v0[3] * v0[3])) + ((v1[0] * v1[0] + v1[1] * v1[1]) + (v1[2] * v1[2] + v1[3] * v1[3]));
                }
                ss += __shfl_xor(ss, 16); ss += __shfl_xor(ss, 32);
                if (fq == 0) rsq1[row * 32 + u.pn * 4 + wc] = ss;
                if (m & 1) asm volatile("" ::: "memory");
            }
    }
};
struct EpiQP {
    static constexpr bool PERM = true;
    typedef f32x4 acc_t;
    __device__ __forceinline__ void init(f32x4 (&acc)[2][2][4][2], const Unit&, int, int, int, int) const {
#pragma unroll
        for (int a = 0; a < 2; ++a)
#pragma unroll
            for (int b = 0; b < 2; ++b)
#pragma unroll
                for (int m = 0; m < 4; ++m)
#pragma unroll
                    for (int n = 0; n < 2; ++n) acc[a][b][m][n] = (f32x4){0.f, 0.f, 0.f, 0.f};
    }
    bf16_t* qp;
    __device__ __forceinline__ void operator()(const f32x4 (&acc)[2][2][4][2], const Unit& u, int wr, int wc, int fr, int fq) const {
        asm volatile("" : "+v"(fr), "+v"(fq));
        const int col0 = u.pn * 256 + wc * 32 + 8 * fq;
#pragma unroll
        for (int ai = 0; ai < 2; ++ai)
#pragma unroll
            for (int m = 0; m < 4; ++m) {
                const size_t row = (size_t)u.pm * 256 + ai * 128 + wr * 64 + m * 16 + fr;
#pragma unroll
                for (int bj = 0; bj < 2; ++bj) {
                    const f32x4 v0 = acc[ai][bj][m][0], v1 = acc[ai][bj][m][1];
                    u32x4 w; w.x = pkbf(v0[0], v0[1]); w.y = pkbf(v0[2], v0[3]); w.z = pkbf(v1[0], v1[1]); w.w = pkbf(v1[2], v1[3]);
                    *(u32x4*)(qp + row * 2048 + col0 + bj * 128) = w;
                }
            }
    }
};

struct EpiQPi {
    static constexpr bool PERM = true;
    typedef i32x4 acc_t;
    __device__ __forceinline__ void init(i32x4 (&acc)[2][2][4][2], const Unit&, int, int, int, int) const {
#pragma unroll
        for (int a = 0; a < 2; ++a)
#pragma unroll
            for (int b = 0; b < 2; ++b)
#pragma unroll
                for (int m = 0; m < 4; ++m)
#pragma unroll
                    for (int n = 0; n < 2; ++n) acc[a][b][m][n] = (i32x4){0, 0, 0, 0};
    }
    bf16_t* qp; const float* sx; const float* swp;
    __device__ __forceinline__ void operator()(const i32x4 (&acc)[2][2][4][2], const Unit& u, int wr, int wc, int fr, int fq) const {
        asm volatile("" : "+v"(fr), "+v"(fq));
        const int col0 = u.pn * 256 + wc * 32 + 8 * fq;
        f32x4 sw[2][2];
#pragma unroll
        for (int bj = 0; bj < 2; ++bj)
#pragma unroll
            for (int n = 0; n < 2; ++n) sw[bj][n] = *(const f32x4*)(swp + col0 + bj * 128 + 4 * n);
#pragma unroll
        for (int ai = 0; ai < 2; ++ai)
#pragma unroll
            for (int m = 0; m < 4; ++m) {
                const size_t row = (size_t)u.pm * 256 + ai * 128 + wr * 64 + m * 16 + fr; const float sxr = sx[row];
#pragma unroll
                for (int bj = 0; bj < 2; ++bj) {
                    f32x4 v0, v1;
#pragma unroll
                    for (int j = 0; j < 4; ++j) { v0[j] = (float)acc[ai][bj][m][0][j] * sxr * sw[bj][0][j]; v1[j] = (float)acc[ai][bj][m][1][j] * sxr * sw[bj][1][j]; }
                    u32x4 w; w.x = pkbf(v0[0], v0[1]); w.y = pkbf(v0[2], v0[3]); w.z = pkbf(v1[0], v1[1]); w.w = pkbf(v1[2], v1[3]);
                    *(u32x4*)(qp + row * 2048 + col0 + bj * 128) = w;
                }
            }
    }
};

template <class CM>
__device__ __forceinline__ void p0_transpose_item(const float* W, int ldw, int K, int nblk, bf16_t* WT, LAS float* scr, int item, int lane, const CM& colmap, const float* kscale) {
    const int kb = item / nblk, nb = item % nblk, k0 = 64 * kb, n0 = 32 * nb;
    const int src = colmap(n0 + (lane & 31));
    float vv[32];
#pragma unroll
    for (int i = 0; i < 32; ++i) { const int kk = 2 * i + (lane >> 5); vv[i] = (src >= 0) ? W[(size_t)(k0 + kk) * ldw + src] : 0.f; }
    if (kscale) {
#pragma unroll
        for (int i = 0; i < 32; ++i) vv[i] *= kscale[k0 + 2 * i + (lane >> 5)];
    }
#pragma unroll
    for (int i = 0; i < 32; ++i) scr[(2 * i + (lane >> 5)) * 33 + (lane & 31)] = vv[i];
    asm volatile("s_waitcnt lgkmcnt(0)" ::: "memory");
    const int c = lane & 7;
#pragma unroll
    for (int j = 0; j < 4; ++j) { const int n = (lane >> 3) + 8 * j; const LAS float* s = scr + (8 * c) * 33 + n;
        u32x4 o; o.x = pkbf(s[0 * 33], s[1 * 33]); o.y = pkbf(s[2 * 33], s[3 * 33]); o.z = pkbf(s[4 * 33], s[5 * 33]); o.w = pkbf(s[6 * 33], s[7 * 33]);
        *(u32x4*)(WT + (size_t)(n0 + n) * K + k0 + 8 * c) = o; }
    asm volatile("s_waitcnt lgkmcnt(0)" ::: "memory");
}
template <class CM>
__device__ __forceinline__ void p0_transpose_item64(const float* W, int ldw, int K, int nblk, bf16_t* WT, LAS float* scr, int item, int lane, const CM& colmap, const float* kscale) {
    const int kb = item / nblk, nb = item % nblk, k0 = 64 * kb, n0 = 64 * nb;
    const int c4 = lane & 15, rr = lane >> 4;
    const int src = colmap(n0 + 4 * c4);
    f32x4 vv[16];
#pragma unroll
    for (int i = 0; i < 16; ++i) { const int kk = 4 * i + rr; vv[i] = (src >= 0) ? *(const f32x4*)(W + (size_t)(k0 + kk) * ldw + src) : (f32x4){0.f, 0.f, 0.f, 0.f}; }
    if (kscale) {
#pragma unroll
        for (int i = 0; i < 16; ++i) vv[i] = vv[i] * kscale[k0 + 4 * i + rr];
    }
#pragma unroll
    for (int i = 0; i < 16; ++i) { LAS float* d = scr + (4 * i + rr) * 65 + 4 * c4; d[0] = vv[i][0]; d[1] = vv[i][1]; d[2] = vv[i][2]; d[3] = vv[i][3]; }
    asm volatile("s_waitcnt lgkmcnt(0)" ::: "memory");
    const int c = lane & 7;
#pragma unroll
    for (int j = 0; j < 8; ++j) { const int n = (lane >> 3) + 8 * j; const LAS float* sp = scr + (8 * c) * 65 + n;
        u32x4 o; o.x = pkbf(sp[0 * 65], sp[1 * 65]); o.y = pkbf(sp[2 * 65], sp[3 * 65]); o.z = pkbf(sp[4 * 65], sp[5 * 65]); o.w = pkbf(sp[6 * 65], sp[7 * 65]);
        *(u32x4*)(WT + (size_t)(n0 + n) * K + k0 + 8 * c) = o; }
    asm volatile("s_waitcnt lgkmcnt(0)" ::: "memory");
}
__device__ __forceinline__ int cm_win(int n) { if (n < 1024) return n; if (n < 5120) return n + 64; if (n < 11264) return n + 80; if (n < 11328) return 1024 + (n - 11264); if (n < 11344) return 5184 + (n - 11328); return -1; }
template <bool WIN> __device__ __forceinline__ void p0_gate_colmax_item(const float* W, int ldw, int nblk, float* PMAX, int item, int lane, const float* kscale = nullptr) {
    const int kb = item / nblk, nb = item % nblk, k0 = 64 * kb, n0 = 64 * nb, c4 = lane & 15, rr = lane >> 4, ncol = 64 * nblk;
    const int src = WIN ? cm_win(n0 + 4 * c4) : n0 + 4 * c4;
    f32x4 mx = (f32x4){0.f, 0.f, 0.f, 0.f};
#pragma unroll
    for (int i = 0; i < 16; ++i) { const f32x4 v = ((src >= 0) ? *(const f32x4*)(W + (size_t)(k0 + 4 * i + rr) * ldw + src) : (f32x4){0.f, 0.f, 0.f, 0.f}) * (kscale ? kscale[k0 + 4 * i + rr] : 1.f);
        mx[0] = fmaxf(mx[0], fabsf(v[0])); mx[1] = fmaxf(mx[1], fabsf(v[1])); mx[2] = fmaxf(mx[2], fabsf(v[2])); mx[3] = fmaxf(mx[3], fabsf(v[3])); }
#pragma unroll
    for (int j = 0; j < 4; ++j) { mx[j] = fmaxf(mx[j], __shfl_xor(mx[j], 16)); mx[j] = fmaxf(mx[j], __shfl_xor(mx[j], 32)); }
    if (rr == 0) *(f32x4*)(PMAX + (size_t)kb * ncol + n0 + 4 * c4) = mx;
}
template <bool WIN> __device__ __forceinline__ void p0_gate_quant_item(const float* W, int ldw, int nblk, const float* PMAX, unsigned char* WG8, float* SWG, LAS float* scr, int item, int lane, const float* kscale = nullptr) {
    const int kb = item / nblk, nb = item % nblk, k0 = 64 * kb, n0 = 64 * nb, c4 = lane & 15, rr = lane >> 4, ncol = 64 * nblk;
    const int src = WIN ? cm_win(n0 + 4 * c4) : n0 + 4 * c4;
    float cm = 0.f;
#pragma unroll 8
    for (int b = 0; b < 32; ++b) cm = fmaxf(cm, PMAX[(size_t)b * ncol + n0 + lane]);
    cm = fmaxf(cm, 1e-30f);
    if (kb == 0) SWG[n0 + lane] = cm * (1.f / 127.f);
    f32x4 vv[16];
#pragma unroll
    for (int i = 0; i < 16; ++i) vv[i] = ((src >= 0) ? *(const f32x4*)(W + (size_t)(k0 + 4 * i + rr) * ldw + src) : (f32x4){0.f, 0.f, 0.f, 0.f}) * (kscale ? kscale[k0 + 4 * i + rr] : 1.f);
#pragma unroll
    for (int i = 0; i < 16; ++i) { LAS float* d = scr + (4 * i + rr) * 65 + 4 * c4; d[0] = vv[i][0]; d[1] = vv[i][1]; d[2] = vv[i][2]; d[3] = vv[i][3]; }
    asm volatile("s_waitcnt lgkmcnt(0)" ::: "memory");
    const int c = lane & 3;
#pragma unroll
    for (int j = 0; j < 4; ++j) { const int n = (lane >> 2) + 16 * j; const LAS float* sp = scr + (16 * c) * 65 + n;
        const float inv = 127.f / __shfl(cm, n);
        u32x4 o;
        o.x = q8pack(sp[0 * 65], sp[1 * 65], sp[2 * 65], sp[3 * 65], inv); o.y = q8pack(sp[4 * 65], sp[5 * 65], sp[6 * 65], sp[7 * 65], inv);
        o.z = q8pack(sp[8 * 65], sp[9 * 65], sp[10 * 65], sp[11 * 65], inv); o.w = q8pack(sp[12 * 65], sp[13 * 65], sp[14 * 65], sp[15 * 65], inv);
        *(u32x4*)(WG8 + (size_t)(n0 + n) * 2048 + k0 + 16 * c) = o; }
    asm volatile("s_waitcnt lgkmcnt(0)" ::: "memory");
}
struct CmWin { __device__ int operator()(int n) const { if (n < 1024) return n; if (n < 5120) return n + 64; if (n < 11264) return n + 80; if (n < 11328) return 1024 + (n - 11264); if (n < 11344) return 5184 + (n - 11328); return -1; } };
struct CmWuq { __device__ int operator()(int n) const { if (n < 2048) return (n >> 7) * 192 + (n & 127);
    const int m = n - 2048, tile = m >> 8, cl = m & 255, hl = (cl >> 5) & 3, pos = 32 * (cl >> 7) + (cl & 31), head = 4 * tile + hl; return head * 192 + 128 + (pos >> 1) + 32 * (pos & 1); } };
struct CmWukv { __device__ int operator()(int n) const { if (n < 2048) return (n >> 7) * 256 + (n & 127); const int m = n - 2048; return (m >> 7) * 256 + 128 + (m & 127); } };
struct CmId { __device__ int operator()(int n) const { return n; } };

struct Args { const void* in[22]; float* out; unsigned char* ws; int ph_lo, ph_hi; };

__device__ __forceinline__ s16x4 tr_read(const LAS unsigned char* p) { return __builtin_bit_cast(s16x4, __builtin_amdgcn_ds_read_tr16_b64_v4i16((LAS v4i16_t*)p)); }
__device__ __forceinline__ bf16x8 cat8(s16x4 lo, s16x4 hi) { return (bf16x8){lo[0], lo[1], lo[2], lo[3], hi[0], hi[1], hi[2], hi[3]}; }
__device__ __forceinline__ int crow(int r, int hi) { return (r & 3) + 8 * (r >> 2) + 4 * hi; }
__device__ __forceinline__ unsigned f2key(float f) { const unsigned u = __float_as_uint(f); return (u & 0x80000000u) ? ~u : (u | 0x80000000u); }
__device__ __forceinline__ float key2f(unsigned k) { const unsigned u = (k & 0x80000000u) ? (k & 0x7fffffffu) : ~k; return __uint_as_float(u); }
__device__ __forceinline__ unsigned umed3(unsigned a, unsigned b, unsigned c) { const unsigned mx = a > b ? a : b, mn = a > b ? b : a; const unsigned t = mx < c ? mx : c; return mn > t ? mn : t; }

constexpr int GL_QS = 0, GL_KS = 33792, GL_VS = 67584, GL_ST = 76800, GL_AB = 110592, GL_OB = 119808, GL_DEC = 137216;
__device__ __forceinline__ void gla_scan_unit(LAS unsigned char* lds, unsigned char* ws, const float* g_on, int b, int hh, int sl, bool dummy) {
    int tid_ = threadIdx.x; asm volatile("" : "+v"(tid_));
    const int tid = tid_, lane = tid & 63, wid = __builtin_amdgcn_readfirstlane(tid >> 6), l15 = lane & 15, g = lane >> 4;
    const bf16_t* QG = (const bf16_t*)(ws + WS_QG); const bf16_t* KG = (const bf16_t*)(ws + WS_KG); const bf16_t* VG = (const bf16_t*)(ws + WS_VG);
    const bf16_t* OG = (const bf16_t*)(ws + WS_OG); bf16_t* GB = (bf16_t*)(ws + WS_GB); const float* DECG = (const float*)(ws + WS_DEC); float* SSQ = (float*)(ws + WS_SSQ);
    const bf16_t* ABUF = (const bf16_t*)(ws + WS_ABUF);
    bf16_t* GBo = dummy ? (bf16_t*)(ws + WS_CQKV) : GB; float* SSQo = dummy ? (float*)(ws + WS_WIN + 100 * MiB) : SSQ; const size_t omask = dummy ? (size_t)0xffffff : ~(size_t)0;
    f32x4 S[2][4];
#pragma unroll
    for (int a = 0; a < 2; ++a)
#pragma unroll
        for (int v = 0; v < 4; ++v) S[a][v] = (f32x4){0.f, 0.f, 0.f, 0.f};
    u32x4 pq[4], pk[4], pv, pab, pgb, pog; f32x4 pd = (f32x4){0.f, 0.f, 0.f, 0.f};
    const size_t tb = (size_t)b * SEQ;
    const int oi = tid >> 3, opart = tid & 7, oe0 = sl * 64 + 8 * opart;
    const f32x4 gn0 = *(const f32x4*)(g_on + oe0), gn1 = *(const f32x4*)(g_on + oe0 + 4);
    auto issue = [&](int c) {
        const size_t t0 = tb + (size_t)c * 64;
#pragma unroll
        for (int q = 0; q < 4; ++q) { const int ci = tid + 512 * q, row = ci >> 5, cc = ci & 31;
            pq[q] = *(const u32x4*)(QG + (t0 + row) * 1024 + hh * 256 + cc * 8); pk[q] = *(const u32x4*)(KG + (t0 + row) * 1024 + hh * 256 + cc * 8); }
        { const int row = tid >> 3, cc = tid & 7; pv = *(const u32x4*)(VG + (t0 + row) * 2048 + hh * 512 + sl * 64 + cc * 8);
          pab = *(const u32x4*)(ABUF + ((size_t)((b * 4 + hh) * 32 + c)) * 4096 + row * 64 + cc * 8); }
        if (tid < 64) pd = *(const f32x4*)(DECG + ((size_t)((b * 4 + hh) * 32 + c)) * 256 + 4 * tid);
        { const size_t off = (t0 + oi) * 2048 + hh * 512 + oe0; pgb = *(const u32x4*)(GB + off); pog = *(const u32x4*)(OG + off); }
    };
    issue(0);
    for (int c = 0; c < 32; ++c) {
#ifdef REP_GA
        for (int rep_ = 0; rep_ < 2; ++rep_) {
#else
        {
#endif
#pragma unroll
        for (int q = 0; q < 4; ++q) { const int ci = tid + 512 * q, row = ci >> 5, cc = ci & 31;
            *(LAS u32x4*)(lds + GL_QS + row * 528 + cc * 16) = pq[q]; *(LAS u32x4*)(lds + GL_KS + row * 528 + cc * 16) = pk[q]; }
        { const int row = tid >> 3, cc = tid & 7; *(LAS u32x4*)(lds + GL_VS + row * 144 + cc * 16) = pv; *(LAS u32x4*)(lds + GL_AB + row * 144 + cc * 16) = pab; }
        if (tid < 64) *(LAS f32x4*)(lds + GL_DEC + 16 * tid) = pd;
#pragma unroll
        for (int a = 0; a < 2; ++a)
#pragma unroll
            for (int vt = 0; vt < 4; ++vt) { const int dt = 2 * wid + a; u32x2 w; w.x = pkbf(S[a][vt][0], S[a][vt][1]); w.y = pkbf(S[a][vt][2], S[a][vt][3]);
                *(LAS u32x2*)(lds + GL_ST + (16 * vt + l15) * 528 + (16 * dt + 4 * g) * 2) = w; }
        RAW_BAR();
        }
        const u32x4 cgb = pgb, cog = pog;
        if (c + 1 < 32) issue(c + 1);
#ifdef REP_GF1
        for (int rep_ = 0; rep_ < 2; ++rep_)
#endif
        {
            const int it = wid >> 1;
#pragma unroll
            for (int vv = 0; vv < 2; ++vv) {
                const int vt = 2 * (wid & 1) + vv;
                f32x4 o = (f32x4){0.f, 0.f, 0.f, 0.f};
#pragma unroll
                for (int ks = 0; ks < 8; ++ks) {
                    const bf16x8 fa = *(const LAS bf16x8*)(lds + GL_QS + (16 * it + l15) * 528 + (32 * ks + 8 * g) * 2);
                    const bf16x8 fb = *(const LAS bf16x8*)(lds + GL_ST + (16 * vt + l15) * 528 + (32 * ks + 8 * g) * 2);
                    o = __builtin_amdgcn_mfma_f32_16x16x32_bf16(fa, fb, o, 0, 0, 0);
                }
#pragma unroll
                for (int ks = 0; ks < 2; ++ks) {
                    const bf16x8 fa = *(const LAS bf16x8*)(lds + GL_AB + (16 * it + l15) * 144 + (32 * ks + 8 * g) * 2);
                    const LAS unsigned char* vp = lds + GL_VS + (32 * ks + 8 * g + (l15 >> 2)) * 144 + (16 * vt + 4 * (l15 & 3)) * 2;
                    const bf16x8 fb = cat8(tr_read(vp), tr_read(vp + 4 * 144));
                    o = __builtin_amdgcn_mfma_f32_16x16x32_bf16(fa, fb, o, 0, 0, 0);
                }
#pragma unroll
                for (int r = 0; r < 4; ++r) *(LAS float*)(lds + GL_OB + ((16 * it + 4 * g + r) * 68 + 16 * vt + l15) * 4) = o[r];
            }
        }
        {
            bf16x8 fv[4][2];
#pragma unroll
            for (int vt = 0; vt < 4; ++vt)
#pragma unroll
                for (int ks = 0; ks < 2; ++ks) { const LAS unsigned char* vp = lds + GL_VS + (32 * ks + 8 * g + (l15 >> 2)) * 144 + (16 * vt + 4 * (l15 & 3)) * 2;
                    fv[vt][ks] = cat8(tr_read(vp), tr_read(vp + 4 * 144)); }
#pragma unroll
            for (int a = 0; a < 2; ++a) {
                const int dt = 2 * wid + a;
#pragma unroll
                for (int ks = 0; ks < 2; ++ks) {
                    const LAS unsigned char* kp = lds + GL_KS + (32 * ks + 8 * g + (l15 >> 2)) * 528 + (16 * dt + 4 * (l15 & 3)) * 2;
                    const bf16x8 fk = cat8(tr_read(kp), tr_read(kp + 4 * 528));
#pragma unroll
                    for (int vt = 0; vt < 4; ++vt) S[a][vt] = __builtin_amdgcn_mfma_f32_16x16x32_bf16(fk, fv[vt][ks], S[a][vt], 0, 0, 0);
                }
                const f32x4 dc = *(const LAS f32x4*)(lds + GL_DEC + (16 * dt + 4 * g) * 4);
#pragma unroll
                for (int vt = 0; vt < 4; ++vt) S[a][vt] = S[a][vt] * dc;
            }
        }
        RAW_BAR();
        {
            const int i = oi, part = opart; const size_t t = tb + (size_t)c * 64 + i;
            const f32x4 o0 = *(const LAS f32x4*)(lds + GL_OB + (i * 68 + 8 * part) * 4), o1 = *(const LAS f32x4*)(lds + GL_OB + (i * 68 + 8 * part + 4) * 4);
            float ss = (o0[0] * o0[0] + o0[1] * o0[1]) + (o0[2] * o0[2] + o0[3] * o0[3]) + (o1[0] * o1[0] + o1[1] * o1[1]) + (o1[2] * o1[2] + o1[3] * o1[3]);
            ss += __shfl_xor(ss, 1); ss += __shfl_xor(ss, 2); ss += __shfl_xor(ss, 4);
            if (part == 0) SSQo[(t * 4 + hh) * 8 + sl] = ss;
            const size_t off = t * 2048 + hh * 512 + oe0;
            const u32x4 gb = cgb, og = cog;
            u32x4 w;
            w.x = pkbf(o0[0] * bf_lo(gb.x) * bf_lo(og.x) * gn0[0], o0[1] * bf_hi(gb.x) * bf_hi(og.x) * gn0[1]);
            w.y = pkbf(o0[2] * bf_lo(gb.y) * bf_lo(og.y) * gn0[2], o0[3] * bf_hi(gb.y) * bf_hi(og.y) * gn0[3]);
            w.z = pkbf(o1[0] * bf_lo(gb.z) * bf_lo(og.z) * gn1[0], o1[1] * bf_hi(gb.z) * bf_hi(og.z) * gn1[1]);
            w.w = pkbf(o1[2] * bf_lo(gb.w) * bf_lo(og.w) * gn1[2], o1[3] * bf_hi(gb.w) * bf_hi(og.w) * gn1[3]);
            *(u32x4*)(GBo + (off & omask)) = w;
        }
    }
    __syncthreads();
}

constexpr int AT_KSTR = 400, AT_VSTR = 320, AT_VOFF = 64 * AT_KSTR, AT_BUF = 64 * AT_KSTR + 64 * AT_VSTR;
__device__ __forceinline__ void attn_unit(LAS unsigned char* lds, const bf16_t* Qh, const bf16_t* Kh, const bf16_t* Vh, const bf16_t* KPE, const bf16_t* GAin, bf16_t* GAout, size_t omask, int b, int hh, int qb) {
    int tid_ = threadIdx.x; asm volatile("" : "+v"(tid_));
    const int tid = tid_, lane = tid & 63, wid = __builtin_amdgcn_readfirstlane(tid >> 6), r32 = lane & 31, hi = lane >> 5;
    const size_t tb = (size_t)b * SEQ; const int q0 = qb * 256;
    const int NT = (q0 + 256) / 64;
    u32x4 sk[2], sr, sv[2];
    auto issue = [&](int jt) {
        const size_t t0 = tb + (size_t)jt * 64;
#pragma unroll
        for (int q = 0; q < 2; ++q) { const int ci = tid + 512 * q, row = ci >> 4, cc = ci & 15;
            sk[q] = *(const u32x4*)(Kh + (t0 + row) * 2048 + hh * 128 + cc * 8); sv[q] = *(const u32x4*)(Vh + (t0 + row) * 2048 + hh * 128 + cc * 8); }
        { const int row = tid >> 3, cc = tid & 7; sr = *(const u32x4*)(KPE + (t0 + row) * 64 + cc * 8); }
    };
    auto stash = [&](int buf) {
        LAS unsigned char* kb = lds + buf * AT_BUF; LAS unsigned char* vb = kb + AT_VOFF;
#pragma unroll
        for (int q = 0; q < 2; ++q) { const int ci = tid + 512 * q, row = ci >> 4, cc = ci & 15;
            *(LAS u32x4*)(kb + row * AT_KSTR + cc * 16) = sk[q]; *(LAS u32x4*)(vb + row * AT_VSTR + cc * 16) = sv[q]; }
        { const int row = tid >> 3, cc = tid & 7; *(LAS u32x4*)(kb + row * AT_KSTR + 256 + cc * 16) = sr; }
    };
    issue(0);
    bf16x8 qf[12];
    { const bf16_t* qp = Qh + (tb + q0 + wid * 32 + r32) * 3072 + hh * 192 + hi * 8;
#pragma unroll
      for (int d0 = 0; d0 < 12; ++d0) qf[d0] = *(const bf16x8*)(qp + d0 * 16); }
    f32x16 o[4];
#pragma unroll
    for (int d = 0; d < 4; ++d)
#pragma unroll
        for (int r = 0; r < 16; ++r) o[d][r] = 0.f;
    float mrun = -1e30f, lrun = 0.f;
    stash(0);
    if (NT > 1) issue(1);
    RAW_BAR();
    const int qidx = q0 + wid * 32 + r32;
    for (int jt = 0; jt < NT; ++jt) {
        const int buf = jt & 1;
        const LAS unsigned char* kb = lds + buf * AT_BUF; const LAS unsigned char* vb = kb + AT_VOFF;
        f32x16 p0, p1;
#pragma unroll
        for (int r = 0; r < 16; ++r) { p0[r] = 0.f; p1[r] = 0.f; }
        __builtin_amdgcn_s_setprio(1);
#pragma unroll
        for (int d0 = 0; d0 < 12; ++d0) {
            const bf16x8 k0 = *(const LAS bf16x8*)(kb + r32 * AT_KSTR + (16 * d0 + 8 * hi) * 2);
            const bf16x8 k1 = *(const LAS bf16x8*)(kb + (32 + r32) * AT_KSTR + (16 * d0 + 8 * hi) * 2);
            p0 = __builtin_amdgcn_mfma_f32_32x32x16_bf16(k0, qf[d0], p0, 0, 0, 0);
            p1 = __builtin_amdgcn_mfma_f32_32x32x16_bf16(k1, qf[d0], p1, 0, 0, 0);
        }
        __builtin_amdgcn_s_setprio(0);
        if (jt >= NT - 4) {
            const int kbase = jt * 64 + 4 * hi;
#pragma unroll
            for (int r = 0; r < 16; ++r) { const int kv = kbase + (r & 3) + 8 * (r >> 2); if (kv > qidx) p0[r] = -1e30f; if (kv + 32 > qidx) p1[r] = -1e30f; }
        }
        float mxa = fmaxf(fmaxf(p0[0], p0[1]), p0[2]), mxb = fmaxf(fmaxf(p1[0], p1[1]), p1[2]);
#pragma unroll
        for (int r = 3; r < 15; r += 2) { mxa = fmaxf(fmaxf(mxa, p0[r]), p0[r + 1]); mxb = fmaxf(fmaxf(mxb, p1[r]), p1[r + 1]); }
        float mx = fmaxf(fmaxf(mxa, p0[15]), fmaxf(mxb, p1[15]));
        mx = fmaxf(mx, __shfl_xor(mx, 32));
        const bool grow = mx > mrun + 6.0f;
        if (__builtin_amdgcn_ballot_w64(grow) != 0ull) {
            const float mnew = fmaxf(mrun, mx);
            const float alpha = __builtin_amdgcn_exp2f(mrun - mnew);
            mrun = mnew; lrun *= alpha;
#pragma unroll
            for (int d = 0; d < 4; ++d)
#pragma unroll
                for (int r = 0; r < 16; ++r) o[d][r] *= alpha;
        }
        float ls = 0.f;
#pragma unroll
        for (int r = 0; r < 16; ++r) { p0[r] = __builtin_amdgcn_exp2f(p0[r] - mrun); p1[r] = __builtin_amdgcn_exp2f(p1[r] - mrun); ls += p0[r] + p1[r]; }
        lrun += ls;
        bf16x8 pf[4];
        { u32x4 w;
          w.x = pkbf(p0[0], p0[1]); w.y = pkbf(p0[2], p0[3]); w.z = pkbf(p0[4], p0[5]); w.w = pkbf(p0[6], p0[7]); pf[0] = __builtin_bit_cast(bf16x8, w);
          w.x = pkbf(p0[8], p0[9]); w.y = pkbf(p0[10], p0[11]); w.z = pkbf(p0[12], p0[13]); w.w = pkbf(p0[14], p0[15]); pf[1] = __builtin_bit_cast(bf16x8, w);
          w.x = pkbf(p1[0], p1[1]); w.y = pkbf(p1[2], p1[3]); w.z = pkbf(p1[4], p1[5]); w.w = pkbf(p1[6], p1[7]); pf[2] = __builtin_bit_cast(bf16x8, w);
          w.x = pkbf(p1[8], p1[9]); w.y = pkbf(p1[10], p1[11]); w.z = pkbf(p1[12], p1[13]); w.w = pkbf(p1[14], p1[15]); pf[3] = __builtin_bit_cast(bf16x8, w); }
        const int i16 = lane & 15;
        const LAS unsigned char* vbase = vb + ((4 * hi) + (i16 >> 2)) * AT_VSTR + (16 * ((lane >> 4) & 1) + 4 * (i16 & 3)) * 2;
        __builtin_amdgcn_s_setprio(1);
#pragma unroll
        for (int ks = 0; ks < 4; ++ks) {
#pragma unroll
            for (int d = 0; d < 4; ++d) {
                const LAS unsigned char* vp = vbase + (16 * ks) * AT_VSTR + (32 * d) * 2;
                const bf16x8 fv = cat8(tr_read(vp), tr_read(vp + 8 * AT_VSTR));
                o[d] = __builtin_amdgcn_mfma_f32_32x32x16_bf16(fv, pf[ks], o[d], 0, 0, 0);
            }
        }
        __builtin_amdgcn_s_setprio(0);
        if (jt + 1 < NT) stash(buf ^ 1);
        if (jt + 2 < NT) issue(jt + 2);
        RAW_BAR();
    }
    lrun += __shfl_xor(lrun, 32);
    const float inv = __builtin_amdgcn_rcpf(lrun);
    bf16_t* op = GAout + (((tb + qidx) * 2048 + hh * 128) & omask); const bf16_t* ip = GAin + (tb + qidx) * 2048 + hh * 128;
#pragma unroll
    for (int d = 0; d < 4; ++d)
#pragma unroll
        for (int g4 = 0; g4 < 4; ++g4) {
            const int dv = 32 * d + 8 * g4 + 4 * hi;
            const u32x2 ga = *(const u32x2*)(ip + dv);
            u32x2 w;
            w.x = pkbf(o[d][4 * g4 + 0] * inv * bf_lo(ga.x), o[d][4 * g4 + 1] * inv * bf_hi(ga.x));
            w.y = pkbf(o[d][4 * g4 + 2] * inv * bf_lo(ga.y), o[d][4 * g4 + 3] * inv * bf_hi(ga.y));
            *(u32x2*)(op + dv) = w;
        }
}

__device__ __forceinline__ void x1_quant_unit(unsigned char* ws, int unit) {
    int tid_ = threadIdx.x; asm volatile("" : "+v"(tid_));
    const int tid = tid_, lane = tid & 63, wid = __builtin_amdgcn_readfirstlane(tid >> 6);
    const bf16_t* X1B = (const bf16_t*)(ws + WS_X1B); const size_t t0 = (size_t)unit * 64;
    {
        unsigned char* X8 = ws + WS_X8; float* SX = (float*)(ws + WS_SX);
        u32x4 xv[8][4];
#pragma unroll
        for (int it = 0; it < 8; ++it)
#pragma unroll
            for (int q = 0; q < 2; ++q)
#pragma unroll
                for (int hf = 0; hf < 2; ++hf) xv[it][2 * q + hf] = __builtin_nontemporal_load((const u32x4*)(X1B + (t0 + wid + 8 * it) * 2048 + (size_t)(lane + 64 * q) * 16 + 8 * hf));
#pragma unroll
        for (int it = 0; it < 8; ++it) { const size_t t = t0 + wid + 8 * it; float ax = 0.f;
#pragma unroll
            for (int k = 0; k < 4; ++k)
#pragma unroll
                for (int d = 0; d < 4; ++d) ax = fmaxf(ax, fmaxf(fabsf(bf_lo(xv[it][k][d])), fabsf(bf_hi(xv[it][k][d]))));
            ax = fmaxf(wave_max(ax), 1e-30f); const float ix = 127.f / ax;
#pragma unroll
            for (int q = 0; q < 2; ++q) { u32x4 w;
                w.x = q8pack(bf_lo(xv[it][2 * q].x), bf_hi(xv[it][2 * q].x), bf_lo(xv[it][2 * q].y), bf_hi(xv[it][2 * q].y), ix); w.y = q8pack(bf_lo(xv[it][2 * q].z), bf_hi(xv[it][2 * q].z), bf_lo(xv[it][2 * q].w), bf_hi(xv[it][2 * q].w), ix);
                w.z = q8pack(bf_lo(xv[it][2 * q + 1].x), bf_hi(xv[it][2 * q + 1].x), bf_lo(xv[it][2 * q + 1].y), bf_hi(xv[it][2 * q + 1].y), ix); w.w = q8pack(bf_lo(xv[it][2 * q + 1].z), bf_hi(xv[it][2 * q + 1].z), bf_lo(xv[it][2 * q + 1].w), bf_hi(xv[it][2 * q + 1].w), ix);
                *(u32x4*)(X8 + t * 2048 + (size_t)(lane + 64 * q) * 16) = w; }
            if (lane == 0) SX[t] = ax * (1.f / 127.f); }
    }
}

constexpr int PE_KEYS = 0, PE_R1 = 135168;
__device__ __forceinline__ void sort16_insert(unsigned (&L)[16], unsigned x) {
#pragma unroll
    for (int i = 15; i >= 1; --i) L[i] = umed3(L[i - 1], L[i], x);
    L[0] = L[0] > x ? L[0] : x;
}
__device__ __forceinline__ void cex(unsigned& a, unsigned& b) { const unsigned hi = a > b ? a : b, lo = a > b ? b : a; a = hi; b = lo; }
__device__ __forceinline__ unsigned sel4(unsigned p0, unsigned p1, unsigned p2, unsigned p3, int i) {
    const unsigned w = (i & 8) ? ((i & 4) ? p3 : p2) : ((i & 4) ? p1 : p0);
    return (w >> (8 * (i & 3))) & 0xffu;
}
__device__ __forceinline__ void peer_unit(LAS unsigned char* lds, unsigned char* ws, float* out, int unit) {
    unsigned short* SELT = (unsigned short*)(ws + WS_SELT); float* GATE = (float*)(ws + WS_GATE); float* R1G = (float*)(ws + WS_R1G);
    int tid_ = threadIdx.x; asm volatile("" : "+v"(tid_));
    const int tid = tid_, lane = tid & 63, wid = __builtin_amdgcn_readfirstlane(tid >> 6), r32 = lane & 31, hi = lane >> 5;
    const bf16_t* QP = (const bf16_t*)(ws + WS_QP); const bf16_t* KEYS = (const bf16_t*)(ws + WS_KEYS); const bf16_t* X1B = (const bf16_t*)(ws + WS_X1B);
    const unsigned char* U8 = ws + WS_UB; const unsigned char* V8 = ws + WS_VB; const float* RSQ1 = (const float*)(ws + WS_RSQ1);
    LAS float* R1 = (LAS float*)(lds + PE_R1);
    const size_t t0 = (size_t)unit * 64;
    if (tid < 64) { const float* p = RSQ1 + (t0 + tid) * 32; float s = 0.f;
#pragma unroll
        for (int i = 0; i < 8; ++i) { const f32x4 v = *(const f32x4*)(p + 4 * i); s += (v[0] + v[1]) + (v[2] + v[3]); }
        const float r1v = __builtin_amdgcn_rsqf(s * (1.f / 2048.f) + EPS); R1[tid] = r1v; R1G[t0 + tid] = r1v; }
    __syncthreads();
#ifndef NO_PEER1
    {
        const int tg = wid & 1; const int tl = 32 * tg + r32; const size_t t = t0 + tl;
        const float rstd = R1[tl];
#define PEER_STAGE_KEYS(step) do { const int hx_ = (step) >> 1, p_ = (step) & 1; \
            _Pragma("unroll") for (int i_ = 0; i_ < 16; ++i_) { const int r_ = (wid & 1) * 64 + 4 * i_ + (lane >> 4); \
                __builtin_amdgcn_global_load_lds((const unsigned*)(KEYS + ((size_t)(((4 * hx_ + (wid >> 1)) * 2 + p_) * 128 + r_)) * 128 + (((lane & 15) ^ (r_ & 15)) * 8)), \
                                                 (LAS unsigned*)(lds + PE_KEYS + (wid * 16 + i_) * 1024), 16, 0, 0); } } while (0)
        PEER_STAGE_KEYS(0);
        const unsigned kbase = (unsigned)(PE_KEYS + (wid >> 1) * 32768 + r32 * 256); const int kx = r32 & 15;
        bf16x8 qf[8];
        { const bf16_t* qn = QP + t * 2048 + (wid >> 1) * 256 + 8 * hi;
#pragma unroll
          for (int d0 = 0; d0 < 8; ++d0) qf[d0] = *(const bf16x8*)(qn + 16 * d0); }
        asm volatile("s_waitcnt vmcnt(0)" ::: "memory"); __syncthreads();
#pragma unroll 1
        for (int hx = 0; hx < 2; ++hx) {
            const int h = (wid >> 1) + 4 * hx;
            unsigned LA[16], LB[16];
#pragma unroll 1
            for (int p = 0; p < 2; ++p) {
                f32x16 acc[4];
#pragma unroll
                for (int kb = 0; kb < 4; ++kb)
#pragma unroll
                    for (int r = 0; r < 16; ++r) acc[kb][r] = 0.f;
#pragma unroll
                for (int d0 = 0; d0 < 8; ++d0) {
                    const unsigned ko = kbase + (unsigned)(((2 * d0 + hi) ^ kx) << 4);
#pragma unroll
                    for (int kb = 0; kb < 4; ++kb) { const bf16x8 kf = *(const LAS bf16x8*)(lds + ko + kb * 8192);
                        acc[kb] = __builtin_amdgcn_mfma_f32_32x32x16_bf16(kf, qf[d0], acc[kb], 0, 0, 0); }
                }
                if (hx * 2 + p < 3) { __syncthreads(); PEER_STAGE_KEYS(hx * 2 + p + 1);
                    const int sn = hx * 2 + p + 1; const bf16_t* qn = QP + t * 2048 + ((wid >> 1) + 4 * (sn >> 1)) * 256 + (sn & 1) * 128 + 8 * hi;
#pragma unroll
                    for (int d0 = 0; d0 < 8; ++d0) qf[d0] = *(const bf16x8*)(qn + 16 * d0); }
                unsigned L[16];
#pragma unroll
                for (int i = 0; i < 16; ++i) L[i] = 0u;
#pragma unroll
                for (int kb = 0; kb < 4; ++kb)
#pragma unroll
                    for (int r = 0; r < 16; ++r) { const int key = 32 * kb + (r & 3) + 8 * (r >> 2);
                        const unsigned x = (f2key(acc[kb][r]) & ~127u) | (unsigned)(127 - key - 4 * hi); sort16_insert(L, x); }
                unsigned M[16];
#pragma unroll
                for (int i = 0; i < 16; ++i) { const unsigned o = (unsigned)__shfl_xor((int)L[15 - i], 32); M[i] = L[i] > o ? L[i] : o; }
#pragma unroll
                for (int dd = 8; dd >= 1; dd >>= 1)
#pragma unroll
                    for (int i = 0; i < 16; ++i) if ((i & dd) == 0) cex(M[i], M[i + dd]);
                if (p == 0) {
#pragma unroll
                    for (int i = 0; i < 16; ++i) LA[i] = M[i];
                } else {
#pragma unroll
                    for (int i = 0; i < 16; ++i) LB[i] = M[i];
                }
                if (hx * 2 + p < 3) { asm volatile("s_waitcnt vmcnt(0)" ::: "memory"); __syncthreads(); }
            }
            float fa[16], fb[16]; unsigned ia0 = 0u, ia1 = 0u, ia2 = 0u, ia3 = 0u, ib0 = 0u, ib1 = 0u, ib2 = 0u, ib3 = 0u;
#pragma unroll
            for (int i = 0; i < 16; ++i) { fa[i] = key2f(LA[i] & ~127u); fb[i] = key2f(LB[i] & ~127u);
                const unsigned va = (127u - (LA[i] & 127u)) << (8 * (i & 3)), vb = (127u - (LB[i] & 127u)) << (8 * (i & 3));
                if ((i >> 2) == 0) { ia0 |= va; ib0 |= vb; } else if ((i >> 2) == 1) { ia1 |= va; ib1 |= vb; } else if ((i >> 2) == 2) { ia2 |= va; ib2 |= vb; } else { ia3 |= va; ib3 |= vb; } }
            unsigned C[16];
#pragma unroll
            for (int i = 0; i < 16; ++i) C[i] = 0u;
#pragma unroll
            for (int i = 0; i < 16; ++i)
#pragma unroll
                for (int j = 0; j < 16; ++j) if ((i + 1) * (j + 1) <= 16) { const unsigned x = (f2key(fa[i] + fb[j]) & ~255u) | (unsigned)(i * 16 + j); sort16_insert(C, x); }
            const float smax = key2f(C[0] & ~255u);
            float e[16], den = 0.f;
#pragma unroll
            for (int k = 0; k < 16; ++k) { e[k] = __builtin_amdgcn_exp2f((key2f(C[k] & ~255u) - smax) * rstd * 1.4426950408889634f); den += e[k]; }
            const float rden = 1.f / den;
            if (hi == 0) {
#pragma unroll
                for (int k = 0; k < 16; ++k) { const int ij = (int)(C[k] & 255u); const unsigned id = sel4(ia0, ia1, ia2, ia3, ij >> 4) * 128u + sel4(ib0, ib1, ib2, ib3, ij & 15);
                    const int pos = (k & 7) * 16 + 2 * h + (k >> 3);
                    SELT[t * 128 + pos] = (unsigned short)id; GATE[t * 128 + pos] = e[k] * rden; }
            }
        }
    }
#endif
    __syncthreads();
    __syncthreads();
}


#define PEER_IDS(dst0, dst1, tt) do { dst0 = __builtin_nontemporal_load((const u32x4*)(SELT + (tt) * 128 + es * 16)); dst1 = __builtin_nontemporal_load((const u32x4*)(SELT + (tt) * 128 + es * 16 + 8)); } while (0)
#define PEER_ROWS(rowv, i0v, i1v) do { _Pragma("unroll") for (int q = 0; q < 16; ++q) { const unsigned w_ = (q < 8) ? i0v[q >> 1] : i1v[(q - 8) >> 1]; const unsigned id_ = (q & 1) ? (w_ >> 16) : (w_ & 0xffffu); \
        rowv[q] = *(const u32x4*)(tab + (size_t)id_ * 128); } } while (0)
#define PERMB(s0, s1, sel) __builtin_amdgcn_perm((s0), (s1), (sel))
__device__ __forceinline__ void peer_v_token(const u32x4 (&row)[16], const u32x4 wq, float sw, const bf16_t* xp, float* op, int lane) {
    const unsigned xb = __builtin_nontemporal_load((const unsigned*)xp); const f32x2_t xo = {bf_lo(xb), bf_hi(xb)};
    int a[16];
#pragma unroll
    for (int k = 0; k < 16; ++k) a[k] = 0;
#pragma unroll
    for (int g4 = 0; g4 < 4; ++g4) {
        const int wd = (int)wq[g4];
#pragma unroll
        for (int dw = 0; dw < 4; ++dw) {
            const unsigned A = row[4 * g4][dw], B = row[4 * g4 + 1][dw], C = row[4 * g4 + 2][dw], D = row[4 * g4 + 3][dw];
            const unsigned ablo = PERMB(B, A, 0x05010400u), abhi = PERMB(B, A, 0x07030602u), cdlo = PERMB(D, C, 0x05010400u), cdhi = PERMB(D, C, 0x07030602u);
            a[4 * dw + 0] = __builtin_amdgcn_sdot4((int)PERMB(cdlo, ablo, 0x05040100u), wd, a[4 * dw + 0], false);
            a[4 * dw + 1] = __builtin_amdgcn_sdot4((int)PERMB(cdlo, ablo, 0x07060302u), wd, a[4 * dw + 1], false);
            a[4 * dw + 2] = __builtin_amdgcn_sdot4((int)PERMB(cdhi, abhi, 0x05040100u), wd, a[4 * dw + 2], false);
            a[4 * dw + 3] = __builtin_amdgcn_sdot4((int)PERMB(cdhi, abhi, 0x07060302u), wd, a[4 * dw + 3], false);
        }
    }
    int r4a[4], r4b[4], r2a[2], r2b[2], r1a, r1b;
#pragma unroll
    for (int j = 0; j < 4; ++j) { const bool up = (lane & 8) != 0;
        const int ka = up ? a[4 * j + 2] : a[4 * j], kb = up ? a[4 * j + 3] : a[4 * j + 1], sa = up ? a[4 * j] : a[4 * j + 2], sb = up ? a[4 * j + 1] : a[4 * j + 3];
        r4a[j] = ka + __shfl_xor(sa, 8); r4b[j] = kb + __shfl_xor(sb, 8); }
#pragma unroll
    for (int j = 0; j < 2; ++j) { const bool up = (lane & 16) != 0;
        const int ka = up ? r4a[2 * j + 1] : r4a[2 * j], kb = up ? r4b[2 * j + 1] : r4b[2 * j], sa = up ? r4a[2 * j] : r4a[2 * j + 1], sb = up ? r4b[2 * j] : r4b[2 * j + 1];
        r2a[j] = ka + __shfl_xor(sa, 16); r2b[j] = kb + __shfl_xor(sb, 16); }
    { const bool up = (lane & 32) != 0;
        const int ka = up ? r2a[1] : r2a[0], kb = up ? r2b[1] : r2b[0], sa = up ? r2a[0] : r2a[1], sb = up ? r2b[0] : r2b[1];
        r1a = ka + __shfl_xor(sa, 32); r1b = kb + __shfl_xor(sb, 32); }
    __builtin_nontemporal_store((f32x2_t){xo[0] + sw * (float)r1a, xo[1] + sw * (float)r1b}, (f32x2_t*)op);
}

__device__ __forceinline__ void peer_u_sum(const u32x4 (&row)[16], const u32x4 xq, int lane, int& s0, int& s1) {
    int part[16];
#pragma unroll
    for (int q = 0; q < 16; ++q) { int a = 0;
#pragma unroll
        for (int dw = 0; dw < 4; ++dw) a = __builtin_amdgcn_sdot4((int)xq[dw], (int)row[q][dw], a, false);
        part[q] = a; }
    int r8[8], r4[4];
#pragma unroll
    for (int j = 0; j < 8; ++j) { const int keep = (lane & 1) ? part[2 * j + 1] : part[2 * j], send = (lane & 1) ? part[2 * j] : part[2 * j + 1]; r8[j] = keep + __shfl_xor(send, 1); }
#pragma unroll
    for (int j = 0; j < 4; ++j) { const int keep = (lane & 2) ? r8[2 * j + 1] : r8[2 * j], send = (lane & 2) ? r8[2 * j] : r8[2 * j + 1]; r4[j] = keep + __shfl_xor(send, 2); }
    { const int keep = (lane & 4) ? r4[1] : r4[0], send = (lane & 4) ? r4[0] : r4[1]; s0 += keep + __shfl_xor(send, 4); }
    { const int keep = (lane & 4) ? r4[3] : r4[2], send = (lane & 4) ? r4[2] : r4[3]; s1 += keep + __shfl_xor(send, 4); }
}
__device__ __forceinline__ void peer_fused_rounds(LAS unsigned char* lds, unsigned char* ws, float* out, int unit) {
    int tid_ = threadIdx.x; asm volatile("" : "+v"(tid_));
    const int tid = tid_, lane = tid & 63, wid = __builtin_amdgcn_readfirstlane(tid >> 6), es = lane >> 3, cb = lane & 7;
    const unsigned short* SELT = (const unsigned short*)(ws + WS_SELT); const unsigned char* X8 = ws + WS_X8; const float* GATE = (const float*)(ws + WS_GATE);
    const float* R1G = (const float*)(ws + WS_R1G); const float* SX = (const float*)(ws + WS_SX); const float* SU = (const float*)(ws + WS_SU); const float* SV = (const float*)(ws + WS_SV);
    LAS unsigned char* W8L = lds + 70000 + wid * 1024;
    const size_t tw = (size_t)unit * 64 + (size_t)wid * 8;
    u32x4 idr[8][2];
#pragma unroll
    for (int i = 0; i < 8; ++i) { idr[i][0] = *(const u32x4*)(SELT + (tw + i) * 128 + es * 16); idr[i][1] = *(const u32x4*)(SELT + (tw + i) * 128 + es * 16 + 8); }
    int acc[8][2];
#pragma unroll
    for (int i = 0; i < 8; ++i) { acc[i][0] = 0; acc[i][1] = 0; }
#pragma unroll 1
    for (int sidx = 0; sidx < 16; ++sidx) {
        const unsigned char* tab = ws + WS_UB + (size_t)sidx * (2 * MiB) + cb * 16;
        u32x4 xq[8];
#pragma unroll
        for (int i = 0; i < 8; ++i) xq[i] = *(const u32x4*)(X8 + (tw + i) * 2048 + sidx * 128 + cb * 16);
#pragma unroll
        for (int i = 0; i < 8; ++i) { u32x4 row[16]; u32x4 ia = idr[i][0], ib = idr[i][1]; asm volatile("" : "+v"(ia), "+v"(ib));
            PEER_ROWS(row, ia, ib); peer_u_sum(row, xq[i], lane, acc[i][0], acc[i][1]); asm volatile("" ::: "memory"); }
    }
    float swv[8];
#pragma unroll
    for (int i = 0; i < 8; ++i) { const size_t t = tw + i; const float tsc = SX[t] * R1G[t]; float wv[2];
#pragma unroll
        for (int hf = 0; hf < 2; ++hf) { const size_t idx = t * 128 + es * 16 + 8 * hf + cb; const unsigned id = SELT[idx];
            const float act = (float)acc[i][hf] * tsc * SU[id];
            wv[hf] = GATE[idx] * 0.5f * act * (1.f + erff(act * 0.70710678118654752f)) * SV[id]; }
        const float aw = fmaxf(wave_max(fmaxf(fabsf(wv[0]), fabsf(wv[1]))), 1e-30f); const float iw = 127.f / aw;
        W8L[i * 128 + es * 16 + cb] = (unsigned char)((int)__builtin_rintf(wv[0] * iw) & 0xff); W8L[i * 128 + es * 16 + 8 + cb] = (unsigned char)((int)__builtin_rintf(wv[1] * iw) & 0xff);
        swv[i] = aw * (1.f / 127.f); }
    asm volatile("s_waitcnt lgkmcnt(0)" ::: "memory");
    u32x4 wq[8];
#pragma unroll
    for (int i = 0; i < 8; ++i) wq[i] = *(const LAS u32x4*)(W8L + i * 128 + es * 16);
#pragma unroll 1
    for (int sidx = 0; sidx < 16; ++sidx) {
        const unsigned char* tab = ws + WS_VB + (size_t)sidx * (2 * MiB) + cb * 16;
        float* ob = out + sidx * 128 + cb * 16 + 2 * es; const bf16_t* xb1 = (const bf16_t*)(ws + WS_X1B) + sidx * 128 + cb * 16 + 2 * es;
#pragma unroll
        for (int i = 0; i < 8; ++i) { u32x4 row[16]; u32x4 ia = idr[i][0], ib = idr[i][1]; asm volatile("" : "+v"(ia), "+v"(ib));
            PEER_ROWS(row, ia, ib); peer_v_token(row, wq[i], swv[i], xb1 + (tw + i) * 2048, ob + (tw + i) * 2048, lane); asm volatile("" ::: "memory"); }
    }
}

#define XB_TMO      128
#define XB_XCNT(j)  (256  + 64 * (j))
#define XB_XSUB(j)  (1280 + 64 * (j))
#define XB_XGEN(j)  (2304 + 64 * (j))
#define XB_TOP      3328
#define XB_TOPGEN   3392
#define XB_SPIN_CAP (1u << 22)
__device__ __forceinline__ unsigned xb_ld(unsigned* p)              { return __hip_atomic_load(p, __ATOMIC_RELAXED, __HIP_MEMORY_SCOPE_AGENT); }
__device__ __forceinline__ unsigned xb_add(unsigned* p, unsigned v) { return __hip_atomic_fetch_add(p, v, __ATOMIC_RELAXED, __HIP_MEMORY_SCOPE_AGENT); }
__device__ __forceinline__ unsigned xb_xcc_id() { return (unsigned)__builtin_amdgcn_s_getreg((3 << 11) | 20) & 0xFu; }
#define XB_SPIN(cond, bar) do { unsigned _sp = 0; while (cond) { __builtin_amdgcn_s_sleep(1); \
    if ((++_sp & 255u) == 0u) { if (xb_ld(&(bar)[XB_TMO])) break; if (_sp > XB_SPIN_CAP) { atomicAdd(&(bar)[XB_TMO], 1u); break; } } } } while (0)
struct XcdBarrier { unsigned* bar; unsigned x; volatile LAS unsigned* st; };
__device__ __forceinline__ XcdBarrier xcd_barrier_post(unsigned* bar, volatile LAS unsigned* st) {
    XcdBarrier b; b.bar = bar; b.x = xb_xcc_id(); b.st = st;
    if (threadIdx.x == 0) (void)xb_add(&bar[XB_XCNT(b.x)], 1u);
    return b;
}
__device__ __forceinline__ void xcd_barrier_complete(unsigned* bar, unsigned x, unsigned& nloc, unsigned& nx) {
    const unsigned G = gridDim.x * gridDim.y * gridDim.z;
    unsigned sum, cnt, mine, sp = 0u;
    for (;;) {
        sum = 0u; cnt = 0u; mine = 0u;
#pragma unroll
        for (unsigned j = 0; j < 16; ++j) { const unsigned c = xb_ld(&bar[XB_XCNT(j)]); sum += c; cnt += (c > 0u) ? 1u : 0u; mine = (j == x) ? c : mine; }
        if (sum == G) break;
        __builtin_amdgcn_s_sleep(1);
        if ((++sp & 255u) == 0u) { if (xb_ld(&bar[XB_TMO])) break; if (sp > XB_SPIN_CAP) { atomicAdd(&bar[XB_TMO], 1u); break; } }
    }
    nloc = mine > 0u ? mine : 1u; nx = cnt > 0u ? cnt : 1u;
}
__device__ __forceinline__ void xcd_barrier(const XcdBarrier& b) {
    asm volatile("s_waitcnt vmcnt(0)" ::: "memory");
    __syncthreads();
    if (threadIdx.x == 0) {
        unsigned* bar = b.bar;
        __builtin_amdgcn_s_waitcnt(0);
        unsigned nloc = b.st[0], nx = b.st[1];
        if (nloc == 0u) { xcd_barrier_complete(bar, b.x, nloc, nx); b.st[0] = nloc; b.st[1] = nx; }
        const unsigned old = xb_add(&bar[XB_XSUB(b.x)], 1u);
        const unsigned gen = old / nloc;
        if (old + 1u == (gen + 1u) * nloc) {
            __builtin_amdgcn_fence(__ATOMIC_RELEASE, "agent");
            asm volatile("s_waitcnt vmcnt(0)" ::: "memory");
            const unsigned og = xb_add(&bar[XB_TOP], 1u);
            const unsigned tg = og / nx;
            if (og + 1u == (tg + 1u) * nx) xb_add(&bar[XB_TOPGEN], 1u);
            else XB_SPIN(xb_ld(&bar[XB_TOPGEN]) == tg, bar);
            __builtin_amdgcn_fence(__ATOMIC_ACQUIRE, "agent");
            xb_add(&bar[XB_XGEN(b.x)], 1u);
            asm volatile("s_waitcnt vmcnt(0)" ::: "memory");
        } else {
            XB_SPIN(xb_ld(&bar[XB_XGEN(b.x)]) == gen, bar);
            __builtin_amdgcn_fence(__ATOMIC_ACQUIRE, "agent");
            asm volatile("s_waitcnt vmcnt(0)" ::: "memory");
        }
    }
    __syncthreads();
}

__global__ void __launch_bounds__(512, 2) mk_fwd(Args args) {
    extern __shared__ __attribute__((aligned(16))) unsigned char lds_raw[];
    LAS unsigned char* lds = (LAS unsigned char*)lds_raw;
    const int tid = threadIdx.x, lane = tid & 63, wave = __builtin_amdgcn_readfirstlane(tid >> 6);
    const int G = gridDim.x, bx = blockIdx.x;
    const int vcu = (G % 8 == 0) ? (bx % 8) * (G / 8) + bx / 8 : bx;
    unsigned char* ws = args.ws;
    const float* x = (const float*)args.in[0]; const int* positions = (const int*)args.in[1];
    const float* g_norm_mix = (const float*)args.in[2]; const float* w_in = (const float*)args.in[3]; const float* b_gate = (const float*)args.in[4];
    const float* g_cq = (const float*)args.in[5]; const float* w_uq = (const float*)args.in[6]; const float* g_ckv = (const float*)args.in[7]; const float* w_ukv = (const float*)args.in[8];
    const float* g_qn = (const float*)args.in[9]; const float* g_qr = (const float*)args.in[10]; const float* g_kn = (const float*)args.in[11]; const float* g_kr = (const float*)args.in[12];
    const float* w_a2 = (const float*)args.in[13]; const float* b_a = (const float*)args.in[14]; const float* g_on = (const float*)args.in[15];
    const float* w_out = (const float*)args.in[16]; const float* g_ffn = (const float*)args.in[17]; const float* w_pq = (const float*)args.in[18]; const float* sub_keys = (const float*)args.in[19];
    const float* u_emb = (const float*)args.in[20]; const float* v_emb = (const float*)args.in[21];
    float* out = args.out;
    const int lo = args.ph_lo, hi_ph = args.ph_hi;
#ifndef PH_MASK
#define PH_MASK 0xff
#endif
#define IN(k) (((PH_MASK >> (k)) & 1) && lo <= (k) && (k) < hi_ph)
#define SEAM(k) do { if (IN(k) && IN((k) + 1)) { if (args.ph_lo < 0) cg::this_grid().sync(); else xcd_barrier(xbar); } } while (0)
    volatile LAS unsigned* xst = (volatile LAS unsigned*)(lds + (LDS_BYTES - 64));
    if (tid < 2) xst[tid] = 0u;
    __syncthreads();
    XcdBarrier xbar = xcd_barrier_post((unsigned*)ws, xst);
    const int gw = vcu * 8 + wave, NGW = G * 8;

    if (IN(0)) {
#ifdef REP_P0
      for (int rep_ = 0; rep_ < 2; ++rep_) {
#else
      {
#endif
        LAS float* scr = (LAS float*)(lds + wave * 16896);
        constexpr int I_UQ = 8 * 96, I_UKV = 8 * 64, I_OUT = 32 * 32, I_PQ = 32 * 32, I_GM = 32 * 180;
        constexpr int NITEMS = I_UQ + I_UKV + I_OUT + I_PQ + I_GM;
        for (int it = gw; it < NITEMS; it += NGW) {
            int r = it;
            if (r < I_GM) { p0_gate_colmax_item<true>(w_in, 11344, 180, (float*)(ws + WS_PMAX), r, lane); continue; } r -= I_GM;
            if (r < I_UQ) { p0_transpose_item(w_uq, 3072, 512, 96, (bf16_t*)(ws + WS_WUQ), scr, r, lane, CmWuq(), g_cq); continue; } r -= I_UQ;
            if (r < I_UKV) { p0_transpose_item64(w_ukv, 4096, 512, 64, (bf16_t*)(ws + WS_WUKV), scr, r, lane, CmWukv(), g_ckv); continue; } r -= I_UKV;
            if (r < I_OUT) { p0_gate_colmax_item<false>(w_out, 2048, 32, (float*)(ws + WS_PMAXO), r, lane); continue; } r -= I_OUT;
            p0_gate_colmax_item<false>(w_pq, 2048, 32, (float*)(ws + WS_PMAXP), r, lane, g_ffn);
        }
        for (int m = gw; m < T; m += 2 * NGW) {
            const int m2 = m + NGW;
            const f32x4* xr = (const f32x4*)(x + (size_t)m * 2048) + lane; const f32x4* xr2 = (const f32x4*)(x + (size_t)(m2 < T ? m2 : m) * 2048) + lane;
            f32x4 v[8], v2[8]; float s = 0.f, s2 = 0.f;
#pragma unroll
            for (int j = 0; j < 8; ++j) { v[j] = xr[64 * j]; v2[j] = xr2[64 * j]; }
#pragma unroll
            for (int j = 0; j < 8; ++j) { s += (v[j][0] * v[j][0] + v[j][1] * v[j][1]) + (v[j][2] * v[j][2] + v[j][3] * v[j][3]); s2 += (v2[j][0] * v2[j][0] + v2[j][1] * v2[j][1]) + (v2[j][2] * v2[j][2] + v2[j][3] * v2[j][3]); }
            const float rstd = 1.f / sqrtf(wave_sum(s) * (1.f / 2048.f) + EPS), rstd2 = 1.f / sqrtf(wave_sum(s2) * (1.f / 2048.f) + EPS);
            float am = 0.f, am2 = 0.f;
#pragma unroll
            for (int j = 0; j < 8; ++j) { const f32x4 gg = *((const f32x4*)g_norm_mix + lane + 64 * j);
                v[j] = v[j] * rstd * gg; v2[j] = v2[j] * rstd2 * gg;
                am = fmaxf(am, fmaxf(fmaxf(fabsf(v[j][0]), fabsf(v[j][1])), fmaxf(fabsf(v[j][2]), fabsf(v[j][3])))); am2 = fmaxf(am2, fmaxf(fmaxf(fabsf(v2[j][0]), fabsf(v2[j][1])), fmaxf(fabsf(v2[j][2]), fabsf(v2[j][3]))));
                }
            am = fmaxf(wave_max(am), 1e-30f); am2 = fmaxf(wave_max(am2), 1e-30f);
            const float ih = 127.f / am, ih2 = 127.f / am2;
            unsigned* h8 = (unsigned*)((unsigned char*)out + (size_t)m * 2048) + lane; unsigned* h82 = (unsigned*)((unsigned char*)out + (size_t)m2 * 2048) + lane;
#pragma unroll
            for (int j = 0; j < 8; ++j) { h8[64 * j] = q8pack(v[j][0], v[j][1], v[j][2], v[j][3], ih); if (m2 < T) h82[64 * j] = q8pack(v2[j][0], v2[j][1], v2[j][2], v2[j][3], ih2); }
            if (lane == 0) { float* SH = (float*)((unsigned char*)out + 32 * MiB); SH[m] = am * (1.f / 127.f); if (m2 < T) SH[m2] = am2 * (1.f / 127.f); }
        }
        { float* ROPE = (float*)(ws + WS_ROPE);
          for (int i = bx * 512 + tid; i < T * 32; i += G * 512) { const int t = i >> 5, f = i & 31; const float inv = powf(10000.f, -(float)(2 * f) / 64.f); const float ang = (float)positions[t] * inv;
              ROPE[(size_t)t * 64 + f] = cosf(ang); ROPE[(size_t)t * 64 + 32 + f] = sinf(ang); } }
        { bf16_t* KEYS = (bf16_t*)(ws + WS_KEYS);
          for (int i = bx * 512 + tid; i < 8 * 2 * 128 * 128 / 2; i += G * 512) { const f32x2_t v = *(const f32x2_t*)(sub_keys + 2 * (size_t)i); *(unsigned*)(KEYS + 2 * (size_t)i) = pkbf(v[0], v[1]); } }
      }
    }
    SEAM(0);
    if (IN(1)) {
        {   LAS float* scr = (LAS float*)(lds + wave * 16896);
            for (int it = gw; it < 32 * 180 + 2 * 32 * 32; it += NGW) {
                if (it < 32 * 180) p0_gate_quant_item<true>(w_in, 11344, 180, (const float*)(ws + WS_PMAX), ws + WS_WG8, (float*)(ws + WS_SWG), scr, it, lane);
                else if (it < 32 * 180 + 32 * 32) p0_gate_quant_item<false>(w_out, 2048, 32, (const float*)(ws + WS_PMAXO), ws + WS_WOUT, (float*)(ws + WS_SWO), scr, it - 32 * 180, lane);
                else p0_gate_quant_item<false>(w_pq, 2048, 32, (const float*)(ws + WS_PMAXP), ws + WS_WPQ, (float*)(ws + WS_SWP), scr, it - 32 * 180 - 32 * 32, lane, g_ffn); }
            __syncthreads(); }
        if (lo == 0 && hi_ph == NPH) xcd_barrier(xbar);
        {
            pg8::Gemm g{(const bf16_t*)out, (const bf16_t*)(ws + WS_WG8), T, N1, 1024, 1024, 1024}; pg8::StaticOrder S; S.init(T, N1, G, bx);
            EpiG1i E{ws, b_gate, (const float*)((const unsigned char*)out + 32 * MiB), (const float*)(ws + WS_SWG), (float*)(ws + WS_RSQ0)};
            pg8::gemm_phase<EpiG1i, true>(lds, g, S, E); }
    }
    SEAM(1);
    if (IN(2)) {
        {
            const bf16_t* MISC = (const bf16_t*)(ws + WS_MISC); const float* ROPE = (const float*)(ws + WS_ROPE); bf16_t* KPE = (bf16_t*)(ws + WS_KPE);
            for (int t = gw; t < T; t += NGW) {
                const float v = bf1(MISC[(size_t)t * 256 + lane]);
                const float ss = wave_sum(v * v);
                const float xn = v * __builtin_amdgcn_rsqf(ss * (1.f / 64.f) + EPS) * g_kr[lane];
                const float other = __shfl_xor(xn, 32);
                const int f = lane & 31; const float c = ROPE[(size_t)t * 64 + f], s = ROPE[(size_t)t * 64 + 32 + f];
                const float o = (lane < 32) ? (xn * c - other * s) : (xn * c + other * s);
                KPE[(size_t)t * 64 + 2 * f + (lane >> 5)] = f2bf(o);
            }
        }
#ifndef NO_PREP
        {
            bf16_t* QG = (bf16_t*)(ws + WS_QG); bf16_t* KG = (bf16_t*)(ws + WS_KG); const bf16_t* MISC = (const bf16_t*)(ws + WS_MISC); float* DECG = (float*)(ws + WS_DEC);
            LAS float* alr = (LAS float*)lds; LAS float* tot = (LAS float*)(lds + 4096);
            const int d = tid & 255, half = tid >> 8;
            for (int un = vcu; un < 1024; un += G) {
                const int c = un & 31, hh = (un >> 5) & 3, b = un >> 7; const size_t t0 = (size_t)b * SEQ + (size_t)c * 64;
                for (int i = tid; i < 1024; i += 512) alr[i] = bf1(MISC[(t0 + (i >> 4)) * 256 + 64 + (i & 15)]);
                float w[16];
#pragma unroll
                for (int r = 0; r < 16; ++r) w[r] = w_a2[r * 1024 + hh * 256 + d];
                const float ba = b_a[hh * 256 + d];
                __syncthreads();
                float la[32]; float sum = 0.f;
#pragma unroll
                for (int jj = 0; jj < 32; ++jj) { const int j = 32 * half + jj; float z = ba;
#pragma unroll
                    for (int r4 = 0; r4 < 4; ++r4) { const f32x4 a = *(const LAS f32x4*)(alr + j * 16 + 4 * r4); z += a[0] * w[4 * r4] + a[1] * w[4 * r4 + 1] + a[2] * w[4 * r4 + 2] + a[3] * w[4 * r4 + 3]; }
                    const float ls = fminf(z, 0.f) - __logf(1.f + __expf(-fabsf(z)));
                    la[jj] = ls * (1.f / 16.f); sum += la[jj]; }
                if (half == 0) tot[d] = sum;
                __syncthreads();
                float cum = half ? tot[d] : 0.f;
#pragma unroll
                for (int jj = 0; jj < 32; ++jj) { cum += la[jj]; const size_t off = (t0 + 32 * half + jj) * 1024 + hh * 256 + d;
                    const float eq = __expf(cum); const float q = bf1(QG[off]), k = bf1(KG[off]);
                    QG[off] = f2bf(q * eq * 0.0625f); KG[off] = f2bf(k * __builtin_amdgcn_rcpf(eq)); }
                if (half == 1) DECG[((size_t)((b * 4 + hh) * 32 + c)) * 256 + d] = __expf(cum);
                __syncthreads();
                {
                    bf16_t* ABUF = (bf16_t*)(ws + WS_ABUF) + ((size_t)((b * 4 + hh) * 32 + c)) * 4096;
                    const int l15 = lane & 15, g = lane >> 4, it = wave >> 1;
#pragma unroll
                    for (int jj = 0; jj < 2; ++jj) {
                        const int jt = 2 * (wave & 1) + jj;
                        f32x4 a = (f32x4){0.f, 0.f, 0.f, 0.f};
                        if (jt <= it) {
#pragma unroll
                            for (int ks = 0; ks < 8; ++ks) {
                                const bf16x8 fa = *(const bf16x8*)(QG + (t0 + 16 * it + l15) * 1024 + hh * 256 + 32 * ks + 8 * g);
                                const bf16x8 fb = *(const bf16x8*)(KG + (t0 + 16 * jt + l15) * 1024 + hh * 256 + 32 * ks + 8 * g);
                                a = __builtin_amdgcn_mfma_f32_16x16x32_bf16(fa, fb, a, 0, 0, 0);
                            }
                        }
#pragma unroll
                        for (int r = 0; r < 4; ++r) { const int i = 16 * it + 4 * g + r, j = 16 * jt + l15; ABUF[i * 64 + j] = f2bf((j <= i) ? a[r] : 0.f); }
                    }
                }
                __syncthreads();
            }
        }
#endif
#ifndef NO_G2
        {
            pg8::Gemm g{(const bf16_t*)(ws + WS_CQKV), (const bf16_t*)(ws + WS_WUQ), T, 3072, 512, 1024, 512}; pg8::StaticOrder S; S.init(T, 3072, G, bx);
            EpiUp<0> E{lds, (const float*)(ws + WS_RSQ0), 0, g_qn, g_qr, (const float*)(ws + WS_ROPE), (bf16_t*)(ws + WS_QH), nullptr};
            pg8::gemm_phase<EpiUp<0>, true>(lds, g, S, E);
#ifdef REP_G2
            pg8::gemm_phase<EpiUp<0>, true>(lds, g, S, E);
#endif
        }
#endif
#ifndef NO_G3
        {
            pg8::Gemm g{(const bf16_t*)(ws + WS_CQKV) + 512, (const bf16_t*)(ws + WS_WUKV), T, 4096, 512, 1024, 512}; pg8::StaticOrder S; S.init(T, 4096, G, bx);
            EpiUp<1> E{lds, (const float*)(ws + WS_RSQ0), 8, g_kn, nullptr, nullptr, (bf16_t*)out, (bf16_t*)out + (size_t)T * 2048};
            pg8::gemm_phase<EpiUp<1>, true>(lds, g, S, E);
#ifdef REP_G2
            pg8::gemm_phase<EpiUp<1>, true>(lds, g, S, E);
#endif
        }
#endif
    }
    SEAM(2);
    if (IN(3)) {
#ifndef NO_GLA
        for (int un = vcu; un < 256; un += G) gla_scan_unit(lds, ws, g_on, un >> 5, (un >> 3) & 3, un & 7, false);
#endif
#ifdef REP_GLA
        for (int un = vcu; un < 256; un += G) gla_scan_unit(lds, ws, g_on, un >> 5, (un >> 3) & 3, un & 7, true);
#endif
        const bf16_t* Qh = (const bf16_t*)(ws + WS_QH); const bf16_t* Kh = (const bf16_t*)out; const bf16_t* Vh = (const bf16_t*)out + (size_t)T * 2048;
        const bf16_t* KPE = (const bf16_t*)(ws + WS_KPE); bf16_t* GA = (bf16_t*)(ws + WS_GA);
#ifndef NO_ATTN
        for (int pr = vcu; pr < 512; pr += G) {
            const int bh = pr >> 2, s = pr & 3;
            attn_unit(lds, Qh, Kh, Vh, KPE, GA, GA, ~(size_t)0, bh >> 4, bh & 15, 7 - s);
            attn_unit(lds, Qh, Kh, Vh, KPE, GA, GA, ~(size_t)0, bh >> 4, bh & 15, s);
        }
#endif
#ifdef REP_ATTN
        for (int pr = vcu; pr < 512; pr += G) { const int bh = pr >> 2, s = pr & 3;
            attn_unit(lds, Qh, Kh, Vh, KPE, GA, (bf16_t*)(ws + WS_CQKV), (size_t)0xffffff, bh >> 4, bh & 15, 7 - s);
            attn_unit(lds, Qh, Kh, Vh, KPE, GA, (bf16_t*)(ws + WS_CQKV), (size_t)0xffffff, bh >> 4, bh & 15, s); }
#endif
    }
    SEAM(3);
    if (IN(4)) {
        const bf16_t* GA = (const bf16_t*)(ws + WS_GA); const bf16_t* GB = (const bf16_t*)(ws + WS_GB); const float* SSQ = (const float*)(ws + WS_SSQ);
        unsigned char* M8 = ws + WS_M8; float* SM = (float*)(ws + WS_SM);
        for (int t = gw; t < T; t += NGW) {
            float mv[4][8]; float am = 0.f;
#pragma unroll
            for (int q = 0; q < 4; ++q) {
                const f32x4 s0 = *(const f32x4*)(SSQ + ((size_t)t * 4 + q) * 8), s1 = *(const f32x4*)(SSQ + ((size_t)t * 4 + q) * 8 + 4);
                const float rs = __builtin_amdgcn_rsqf(((s0[0] + s0[1]) + (s0[2] + s0[3]) + (s1[0] + s1[1]) + (s1[2] + s1[3])) * (1.f / 512.f) + EPS);
                const size_t off = (size_t)t * 2048 + (size_t)(lane + 64 * q) * 8;
                const u32x4 a = *(const u32x4*)(GA + off), bb = *(const u32x4*)(GB + off);
                mv[q][0] = bf_lo(a.x) + rs * bf_lo(bb.x); mv[q][1] = bf_hi(a.x) + rs * bf_hi(bb.x); mv[q][2] = bf_lo(a.y) + rs * bf_lo(bb.y); mv[q][3] = bf_hi(a.y) + rs * bf_hi(bb.y);
                mv[q][4] = bf_lo(a.z) + rs * bf_lo(bb.z); mv[q][5] = bf_hi(a.z) + rs * bf_hi(bb.z); mv[q][6] = bf_lo(a.w) + rs * bf_lo(bb.w); mv[q][7] = bf_hi(a.w) + rs * bf_hi(bb.w);
#pragma unroll
                for (int e = 0; e < 8; ++e) am = fmaxf(am, fabsf(mv[q][e]));
            }
            am = fmaxf(wave_max(am), 1e-30f); const float im = 127.f / am;
#pragma unroll
            for (int q = 0; q < 4; ++q) { u32x2 w; w.x = q8pack(mv[q][0], mv[q][1], mv[q][2], mv[q][3], im); w.y = q8pack(mv[q][4], mv[q][5], mv[q][6], mv[q][7], im);
                *(u32x2*)(M8 + (size_t)t * 2048 + (size_t)(lane + 64 * q) * 8) = w; }
            if (lane == 0) SM[t] = am * (1.f / 127.f);
        }
        unsigned char* U8 = ws + WS_UB; unsigned char* V8 = ws + WS_VB;
        float* SU = (float*)(ws + WS_SU); float* SV = (float*)(ws + WS_SV);
#ifdef REP_P4C
      for (int rep_ = 0; rep_ < 2; ++rep_)
#endif
        for (int e = gw; e < 16384; e += NGW) {
            f32x4 uv[8], vv[8]; float au = 0.f, av = 0.f;
#pragma unroll
            for (int q = 0; q < 2; ++q)
#pragma unroll
                for (int h4 = 0; h4 < 4; ++h4) { const int col = 16 * (lane + 64 * q) + 4 * h4;
                    uv[4 * q + h4] = *(const f32x4*)(u_emb + (size_t)e * 2048 + col) * *(const f32x4*)(g_ffn + col); vv[4 * q + h4] = *(const f32x4*)(v_emb + (size_t)e * 2048 + col); }
#pragma unroll
            for (int k = 0; k < 8; ++k) { au = fmaxf(au, fmaxf(fmaxf(fabsf(uv[k][0]), fabsf(uv[k][1])), fmaxf(fabsf(uv[k][2]), fabsf(uv[k][3]))));
                av = fmaxf(av, fmaxf(fmaxf(fabsf(vv[k][0]), fabsf(vv[k][1])), fmaxf(fabsf(vv[k][2]), fabsf(vv[k][3])))); }
            au = fmaxf(wave_max(au), 1e-30f); av = fmaxf(wave_max(av), 1e-30f);
            const float iu = 127.f / au, iv = 127.f / av;
#pragma unroll
            for (int q = 0; q < 2; ++q) { const int cc = lane + 64 * q; const size_t dst = (size_t)(cc >> 3) * (2 * MiB) + (size_t)e * 128 + (size_t)(cc & 7) * 16;
                u32x4 wu, wv;
#pragma unroll
                for (int h4 = 0; h4 < 4; ++h4) { wu[h4] = q8pack(uv[4 * q + h4][0], uv[4 * q + h4][1], uv[4 * q + h4][2], uv[4 * q + h4][3], iu); wv[h4] = q8pack(vv[4 * q + h4][0], vv[4 * q + h4][1], vv[4 * q + h4][2], vv[4 * q + h4][3], iv); }
                *(u32x4*)(U8 + dst) = wu; *(u32x4*)(V8 + dst) = wv; }
            if (lane == 0) { SU[e] = au * (1.f / 127.f); SV[e] = av * (1.f / 127.f); }
        }
    }
    SEAM(4);
    if (IN(5)) {
        pg8::Gemm g{(const bf16_t*)(ws + WS_M8), (const bf16_t*)(ws + WS_WOUT), T, 2048, 1024, 1024, 1024}; pg8::StaticOrder S; S.init(T, 2048, G, bx);
        EpiOutI E{x, (bf16_t*)(ws + WS_X1B), (float*)(ws + WS_RSQ1), (const float*)(ws + WS_SM), (const float*)(ws + WS_SWO)};
        pg8::gemm_phase<EpiOutI, true>(lds, g, S, E);
    }
    SEAM(5);
    if (IN(6)) {
        for (int un = vcu; un < 256; un += G) x1_quant_unit(ws, un);
        if (lo == 0 && hi_ph == NPH) xcd_barrier(xbar);
        pg8::Gemm g{(const bf16_t*)(ws + WS_X8), (const bf16_t*)(ws + WS_WPQ), T, 2048, 1024, 1024, 1024}; pg8::StaticOrder S; S.init(T, 2048, G, bx);
        EpiQPi E{(bf16_t*)(ws + WS_QP), (const float*)(ws + WS_SX), (const float*)(ws + WS_SWP)};
        pg8::gemm_phase<EpiQPi, true>(lds, g, S, E);
    }
    SEAM(6);
    if (IN(7)) {
        for (int un = vcu; un < 256; un += G) { peer_unit(lds, ws, out, un); peer_fused_rounds(lds, ws, out, un); __syncthreads(); }
    }
#undef IN
#undef SEAM
}

extern "C" void kernel_launch(void* const* d_in, const int* in_sizes, int n_in, void* d_out, int out_size, void* d_ws, size_t ws_size, hipStream_t stream) {
    static int grid = 0;
    if (grid == 0) {
        if (n_in != 22 || out_size != T * DM || ws_size < WS_END) { fprintf(stderr, "kernel_launch: unexpected problem (n_in %d out %d ws %zu)\n", n_in, out_size, ws_size); grid = -1; return; }
        int dev = 0, cus = 0, per_cu = 0;
        (void)hipGetDevice(&dev); (void)hipDeviceGetAttribute(&cus, hipDeviceAttributeMultiprocessorCount, dev);
        if (hipFuncSetAttribute((const void*)mk_fwd, hipFuncAttributeMaxDynamicSharedMemorySize, LDS_BYTES) != hipSuccess) { fprintf(stderr, "kernel_launch: hipFuncSetAttribute failed\n"); grid = -1; return; }
        if (hipOccupancyMaxActiveBlocksPerMultiprocessor(&per_cu, (const void*)mk_fwd, 512, LDS_BYTES) != hipSuccess || per_cu < 1) { fprintf(stderr, "kernel_launch: occupancy query says %d\n", per_cu); (void)hipGetLastError(); grid = -1; return; }
        grid = cus;
        fprintf(stderr, "kernel_launch: grid %d (per_cu %d)\n", grid, per_cu);
    }
    if (grid < 0) return;
    if (hipMemsetAsync(d_ws, 0, 16384, stream) != hipSuccess) { fprintf(stderr, "kernel_launch: memset failed\n"); return; }
    Args a{};
    for (int i = 0; i < 22; ++i) a.in[i] = d_in[i];
    a.out = (float*)d_out; a.ws = (unsigned char*)d_ws;
#if MK_N_LAUNCHES == 1
    a.ph_lo = 0; a.ph_hi = NPH;
    void* kargs[] = {&a};
    hipError_t e = hipLaunchCooperativeKernel((const void*)mk_fwd, dim3(grid), dim3(512), kargs, LDS_BYTES, stream);
    if (e != hipSuccess) fprintf(stderr, "kernel_launch: cooperative launch failed: %s\n", hipGetErrorString(e));
#else
    for (int p = 0; p < NPH; ++p) { a.ph_lo = p; a.ph_hi = p + 1; hipLaunchKernelGGL(mk_fwd, dim3(grid), dim3(512), LDS_BYTES, stream, a); }
#endif
}
```

```cpp
#include <hip/hip_runtime.h>
#include <hip/hip_cooperative_groups.h>
#include <cstdio>
#include <cstdint>
namespace cg = cooperative_groups;

#ifndef MK_N_LAUNCHES
#define MK_N_LAUNCHES 1
#endif

#define LAS __attribute__((address_space(3)))
typedef unsigned short bf16_t;
typedef short bf16x8 __attribute__((ext_vector_type(8)));
typedef short s16x4 __attribute__((ext_vector_type(4)));
typedef float f32x4 __attribute__((ext_vector_type(4)));
typedef int i32x4 __attribute__((ext_vector_type(4)));
typedef float f32x16 __attribute__((ext_vector_type(16)));
typedef unsigned u32x4 __attribute__((ext_vector_type(4)));
typedef unsigned u32x2 __attribute__((ext_vector_type(2)));
typedef float f32x2_t __attribute__((ext_vector_type(2)));
typedef __bf16 bf16x2_t __attribute__((ext_vector_type(2)));
typedef short v4i16_t __attribute__((ext_vector_type(4)));

constexpr int T = 16384, DM = 2048, NB = 8, SEQ = 2048;
constexpr float EPS = 1e-6f;
constexpr int N1 = 11520;
constexpr float QSCALE = 0.07216878364870322f * 1.4426950408889634f;

constexpr size_t MiB = 1u << 20;
constexpr size_t WS_WUQ = 1 * MiB, WS_WUKV = 4 * MiB, WS_WOUT = 8 * MiB, WS_WPQ = 16 * MiB, WS_KEYS = 24 * MiB, WS_ROPE = 25 * MiB;
constexpr size_t WS_RSQ0 = 29 * MiB, WS_RSQ1 = 30 * MiB, WS_DEC = 32 * MiB, WS_SSQ = 33 * MiB, WS_KPE = 35 * MiB;
constexpr size_t WS_WIN = 40 * MiB, WS_H = 85 * MiB;
constexpr size_t WS_QH = 40 * MiB;
constexpr size_t WS_X1B = 40 * MiB;
constexpr size_t WS_CQKV = 149 * MiB, WS_QG = 181 * MiB, WS_KG = 213 * MiB, WS_VG = 245 * MiB, WS_OG = 309 * MiB, WS_GA = 373 * MiB, WS_GB = 437 * MiB, WS_MISC = 501 * MiB;
constexpr size_t WS_UB = WS_QG, WS_VB = WS_VG, WS_QP = WS_OG;
constexpr size_t WS_ABUF = 138 * MiB;
constexpr size_t WS_WG8 = 40 * MiB;
constexpr size_t WS_PMAX = 37 * MiB, WS_SWG = 39 * MiB;
constexpr size_t WS_SM = 39 * MiB + 512 * 1024, WS_SWO = 39 * MiB + 768 * 1024, WS_PMAXO = 38 * MiB + 512 * 1024;
constexpr size_t WS_PMAXP = 38 * MiB + 768 * 1024, WS_SWP = 39 * MiB + 832 * 1024;
constexpr size_t WS_M8 = WS_OG;
constexpr size_t WS_END = 509 * MiB;
constexpr size_t WS_SELT = WS_CQKV, WS_GATE = WS_CQKV + 4 * MiB, WS_R1G = WS_CQKV + 20 * MiB, WS_ACTP = WS_GA;
constexpr size_t WS_SX = WS_CQKV + 21 * MiB, WS_SU = WS_CQKV + 22 * MiB, WS_SV = WS_CQKV + 23 * MiB, WS_SW = WS_CQKV + 24 * MiB, WS_W8 = WS_CQKV + 25 * MiB;
constexpr size_t WS_X8 = WS_KG;
constexpr int NPH = 8;

constexpr int LDS_BYTES = 163840;
constexpr int XCH_OFF = 132096;

__device__ __forceinline__ unsigned pkbf(float lo, float hi) { f32x2_t v = {lo, hi}; bf16x2_t b = __builtin_convertvector(v, bf16x2_t); return __builtin_bit_cast(unsigned, b); }
__device__ __forceinline__ float bf_lo(unsigned u) { return __uint_as_float(u << 16); }
__device__ __forceinline__ float bf_hi(unsigned u) { return __uint_as_float(u & 0xffff0000u); }
__device__ __forceinline__ float bf1(bf16_t u) { return __uint_as_float(((unsigned)u) << 16); }
__device__ __forceinline__ bf16_t f2bf(float f) { return (bf16_t)(pkbf(f, 0.f) & 0xffffu); }
__device__ __forceinline__ float wave_sum(float v) {
#pragma unroll
    for (int o = 1; o < 64; o <<= 1) v += __shfl_xor(v, o);
    return v;
}
__device__ __forceinline__ float wave_max(float v) {
#pragma unroll
    for (int o = 1; o < 64; o <<= 1) v = fmaxf(v, __shfl_xor(v, o));
    return v;
}
__device__ __forceinline__ unsigned q8pack(float a, float b, float c, float d, float inv) {
    const int ia = (int)__builtin_rintf(a * inv), ib = (int)__builtin_rintf(b * inv), ic = (int)__builtin_rintf(c * inv), id = (int)__builtin_rintf(d * inv);
    return ((unsigned)ia & 0xffu) | (((unsigned)ib & 0xffu) << 8) | (((unsigned)ic & 0xffu) << 16) | ((unsigned)id << 24);
}
__device__ __forceinline__ float fast_sigmoid(float v) { return __builtin_amdgcn_rcpf(1.f + __builtin_amdgcn_exp2f(-1.4426950408889634f * v)); }

namespace pg8 {
constexpr int BM = 256, BK = 64, HALF = 128, HTB = HALF * BK * 2, STAGE_BYTES = 8 * HTB, NXCD = 8, WGM = 8;
__host__ __device__ __forceinline__ int lds_byte(int r, int c) { const int st = (r >> 4) * 2 + (c >> 5), rr = r & 15, cc = c & 31, ob = rr * 64 + cc * 2; return st * 1024 + (ob ^ (((ob >> 9) & 1) << 5)); }
__host__ __device__ __forceinline__ void stage_rc(int b, int& R, int& C) { const int st = b / 1024, sb = b % 1024, swz = sb ^ (((sb >> 9) & 1) << 5); R = (st >> 1) * 16 + swz / 64; C = (st & 1) * 32 + (swz % 64) / 2; }
__host__ __device__ __forceinline__ int perm32(int rho) { const int n = rho >> 4, i = rho & 15; return 8 * (i >> 2) + 4 * n + (i & 3); }
struct Unit { int pm, pn; };
struct Gemm { const bf16_t* A; const bf16_t* Bt; int M, N, K, lda, ldb; };
struct StaticOrder {
    int nM, nN, nwg, G, c;
    __device__ void init(int M, int N, int G_, int c_) { nM = M / BM; nN = N / BM; nwg = nM * nN; G = G_; c = c_; }
    __device__ bool next(int i, Unit& u) const {
        const long L = (long)i * G + c; if (L >= nwg) return false;
        int wgid = (int)L; { const int q = nwg / NXCD, r = nwg % NXCD, xcd = wgid % NXCD, off = wgid / NXCD; wgid = (xcd < r ? xcd * (q + 1) : r * (q + 1) + (xcd - r) * q) + off; }
        const int nig = WGM * nN, gid = wgid / nig, fm = gid * WGM, gsz = (nM - fm) < WGM ? (nM - fm) : WGM;
        u.pm = fm + ((wgid % nig) % gsz); u.pn = (wgid % nig) / gsz; return true;
    }
};
__device__ __forceinline__ f32x4 mma16(bf16x8 a, bf16x8 b, f32x4 c) { return __builtin_amdgcn_mfma_f32_16x16x32_bf16(a, b, c, 0, 0, 0); }
__device__ __forceinline__ i32x4 mma16(bf16x8 a, bf16x8 b, i32x4 c) { return __builtin_amdgcn_mfma_i32_16x16x64_i8(__builtin_bit_cast(i32x4, a), __builtin_bit_cast(i32x4, b), c, 0, 0, 0); }
template <class Epi, bool ALIGN_EPI>
__device__ __forceinline__ void gemm_phase(LAS unsigned char* lds, const Gemm g, const StaticOrder& S, const Epi& E) {
    const int tid = threadIdx.x, wid = __builtin_amdgcn_readfirstlane(tid >> 6), lane = tid & 63, wr = wid >> 2, wc = wid & 3, fr = lane & 15, fq = lane >> 4;
    const int K = g.K, nt = K / BK;
    unsigned voffA[2], voffB[2];
#pragma unroll
    for (int i = 0; i < 2; ++i) { int R, C; stage_rc(tid * 16 + i * 8192, R, C); const int Rb = Epi::PERM ? ((R & ~31) + perm32(R & 31)) : R;
        voffA[i] = (unsigned)(R * g.lda + C) * 2u; voffB[i] = (unsigned)(Rb * g.ldb + C) * 2u; }
    const size_t kstep = (size_t)(BK * 2);
    const size_t hstepA = (size_t)HALF * g.lda * 2, hstepB = (size_t)HALF * g.ldb * 2;
    const size_t tstepA = 2 * hstepA, tstepB = 2 * hstepB;
    const unsigned ldsw = (unsigned)wid * 1024u;
    const int aoff = lds_byte(wr * 64 + fr, fq * 8), boff = lds_byte(wc * 32 + fr, fq * 8);
#define PG8_SA(b, h) (((b) * 2 + (h)) * HTB)
#define PG8_SB(b, h) ((4 + (b) * 2 + (h)) * HTB)
#define PG8_STAGE(bufoff, gbase, voff) do { _Pragma("unroll") for (int _i = 0; _i < 2; ++_i) \
        __builtin_amdgcn_global_load_lds((const unsigned*)((const char*)(gbase) + (voff)[_i]), (LAS unsigned*)(lds + (bufoff) + ldsw + _i * 8192), 16, 0, 0); } while (0)
#define PG8_LDA(dst, b, h) do { _Pragma("unroll") for (int m = 0; m < 4; ++m) _Pragma("unroll") for (int k = 0; k < 2; ++k) dst[m][k] = *(const LAS bf16x8*)(lds + PG8_SA(b, h) + aoff + m * 2048 + k * 1024); } while (0)
#define PG8_LDB(dst, b, h) do { _Pragma("unroll") for (int n = 0; n < 2; ++n) _Pragma("unroll") for (int k = 0; k < 2; ++k) dst[n][k] = *(const LAS bf16x8*)(lds + PG8_SB(b, h) + boff + n * 2048 + k * 1024); } while (0)
#define PG8_MMA(ai, bj, At, Bt) do { __builtin_amdgcn_s_setprio(1); _Pragma("unroll") for (int m = 0; m < 4; ++m) _Pragma("unroll") for (int n = 0; n < 2; ++n) _Pragma("unroll") for (int k = 0; k < 2; ++k) \
        acc[ai][bj][m][n] = mma16(Bt[n][k], At[m][k], acc[ai][bj][m][n]); __builtin_amdgcn_s_setprio(0); } while (0)
#define PG8_WAIT_V(n) asm volatile("s_waitcnt vmcnt(" #n ")" ::: "memory")
#define PG8_WAIT_L(n) asm volatile("s_waitcnt lgkmcnt(" #n ")" ::: "memory")
#define PG8_BAR __builtin_amdgcn_s_barrier()
#define PG8_SCHED __builtin_amdgcn_sched_barrier(0)
    Unit cur, nxt; int ui = 0;
    if (!S.next(0, cur)) return;
    typename Epi::acc_t acc[2][2][4][2];
    E.init(acc, cur, wr, wc, fr, fq);
    bf16x8 At[4][2], B0[2][2], B1[2][2];
    const char* cA = (const char*)g.A + (size_t)cur.pm * tstepA; const char* cB = (const char*)g.Bt + (size_t)cur.pn * tstepB;
    PG8_STAGE(PG8_SB(0, 0), cB, voffB); PG8_STAGE(PG8_SB(0, 1), cB + hstepB, voffB); PG8_STAGE(PG8_SA(0, 0), cA, voffA); PG8_STAGE(PG8_SA(0, 1), cA + hstepA, voffA);
    if (wr == 1) PG8_BAR;
    PG8_WAIT_V(2); PG8_BAR;
    PG8_STAGE(PG8_SB(1, 0), cB + kstep, voffB); PG8_STAGE(PG8_SA(1, 0), cA + kstep, voffA); PG8_STAGE(PG8_SB(1, 1), cB + hstepB + kstep, voffB);
    PG8_WAIT_V(6); PG8_BAR;
    for (;;) {
        const bool has_next = S.next(ui + 1, nxt);
        const char* nA = has_next ? (const char*)g.A + (size_t)nxt.pm * tstepA : cA; const char* nB = has_next ? (const char*)g.Bt + (size_t)nxt.pn * tstepB : cB;
        for (int t = 0; t < nt; t += 2) {
            const bool last = (t == nt - 2);
            const char* a1 = cA + (size_t)(t + 1) * kstep;
            const char* a2 = last ? nA : cA + (size_t)(t + 2) * kstep; const char* b2 = last ? nB : cB + (size_t)(t + 2) * kstep;
            const char* a3 = a2 + kstep; const char* b3 = b2 + kstep;
            PG8_LDB(B0, 0, 0); PG8_LDB(B1, 0, 1); PG8_SCHED; PG8_LDA(At, 0, 0); PG8_STAGE(PG8_SA(1, 1), a1 + hstepA, voffA);
            PG8_WAIT_V(8); PG8_WAIT_L(0); PG8_BAR; PG8_MMA(0, 0, At, B0); PG8_MMA(0, 1, At, B1); PG8_BAR; PG8_SCHED;
            PG8_LDA(At, 0, 1); PG8_STAGE(PG8_SB(0, 0), b2, voffB); PG8_STAGE(PG8_SB(0, 1), b2 + hstepB, voffB); PG8_STAGE(PG8_SA(0, 0), a2, voffA);
            PG8_WAIT_V(8); PG8_WAIT_L(0); PG8_BAR; PG8_MMA(1, 0, At, B0); PG8_MMA(1, 1, At, B1); PG8_BAR; PG8_SCHED;
            PG8_LDB(B0, 1, 0); PG8_LDB(B1, 1, 1); PG8_SCHED; PG8_LDA(At, 1, 0); PG8_STAGE(PG8_SA(0, 1), a2 + hstepA, voffA);
            PG8_WAIT_V(8); PG8_WAIT_L(0); PG8_BAR; PG8_MMA(0, 0, At, B0); PG8_MMA(0, 1, At, B1); PG8_BAR; PG8_SCHED;
            PG8_LDA(At, 1, 1); PG8_STAGE(PG8_SB(1, 0), b3, voffB); PG8_STAGE(PG8_SB(1, 1), b3 + hstepB, voffB); PG8_STAGE(PG8_SA(1, 0), a3, voffA);
            PG8_WAIT_V(8); PG8_WAIT_L(0); PG8_BAR; PG8_MMA(1, 0, At, B0); PG8_MMA(1, 1, At, B1); PG8_BAR; PG8_SCHED;
        }
        if constexpr (ALIGN_EPI) { if (wr == 0) PG8_BAR; }
        E(acc, cur, wr, wc, fr, fq);
        if (!has_next) break;
        E.init(acc, nxt, wr, wc, fr, fq);
        cur = nxt; cA = nA; cB = nB; ++ui;
        if constexpr (ALIGN_EPI) { if (wr == 1) PG8_BAR; }
    }
    PG8_WAIT_V(0);
    if constexpr (!ALIGN_EPI) { if (wr == 0) PG8_BAR; }
    PG8_BAR;
#undef PG8_SA
#undef PG8_SB
#undef PG8_STAGE
#undef PG8_LDA
#undef PG8_LDB
#undef PG8_MMA
#undef PG8_WAIT_V
#undef PG8_WAIT_L
#undef PG8_BAR
#undef PG8_SCHED
}
}
using pg8::Unit;

#define RAW_BAR() asm volatile("s_waitcnt lgkmcnt(0)\n\ts_barrier" ::: "memory")

struct EpiG1 {
    static constexpr bool PERM = true;
    typedef f32x4 acc_t;
    __device__ __forceinline__ void init(f32x4 (&acc)[2][2][4][2], const Unit&, int, int, int, int) const {
#pragma unroll
        for (int a = 0; a < 2; ++a)
#pragma unroll
            for (int b = 0; b < 2; ++b)
#pragma unroll
                for (int m = 0; m < 4; ++m)
#pragma unroll
                    for (int n = 0; n < 2; ++n) acc[a][b][m][n] = (f32x4){0.f, 0.f, 0.f, 0.f};
    }
    unsigned char* ws; const float* bgate; float* rsq0;
    __device__ __forceinline__ void operator()(const f32x4 (&acc)[2][2][4][2], const Unit& u, int wr, int wc, int fr, int fq) const {
        asm volatile("" : "+v"(fr), "+v"(fq));
        const int pn = u.pn; bf16_t* base; int ld, ct, act = 0; const float* bias = nullptr;
        if (pn < 4)       { base = (bf16_t*)(ws + WS_CQKV); ld = 1024; ct = pn; }
        else if (pn < 8)  { base = (bf16_t*)(ws + WS_QG);   ld = 1024; ct = pn - 4; }
        else if (pn < 12) { base = (bf16_t*)(ws + WS_KG);   ld = 1024; ct = pn - 8; }
        else if (pn < 20) { base = (bf16_t*)(ws + WS_VG);   ld = 2048; ct = pn - 12; }
        else              { base = (bf16_t*)(ws + WS_MISC); ld = 256;  ct = 0; }
        const int col0 = ct * 256 + wc * 32 + 8 * fq;
        f32x4 bv[2][2];
#pragma unroll
        for (int bj = 0; bj < 2; ++bj)
#pragma unroll
            for (int n = 0; n < 2; ++n) bv[bj][n] = bias ? *(const f32x4*)(bias + col0 + bj * 128 + 4 * n) : (f32x4){0.f, 0.f, 0.f, 0.f};
#pragma unroll
        for (int ai = 0; ai < 2; ++ai)
#pragma unroll
            for (int m = 0; m < 4; ++m) {
                const int row = u.pm * 256 + ai * 128 + wr * 64 + m * 16 + fr;
                bf16_t* rowp = base + (size_t)row * ld + col0;
                float ss = 0.f;
#pragma unroll
                for (int bj = 0; bj < 2; ++bj) {
                    f32x4 v0 = acc[ai][bj][m][0] + bv[bj][0], v1 = acc[ai][bj][m][1] + bv[bj][1];
                    if (act == 1) {
#pragma unroll
                        for (int j = 0; j < 4; ++j) { v0[j] = v0[j] * fast_sigmoid(v0[j]); v1[j] = v1[j] * fast_sigmoid(v1[j]); }
                    } else if (act == 2) {
#pragma unroll
                        for (int j = 0; j < 4; ++j) { v0[j] = fast_sigmoid(v0[j]); v1[j] = fast_sigmoid(v1[j]); }
                    }
#pragma unroll
                    for (int j = 0; j < 4; ++j) ss += v0[j] * v0[j] + v1[j] * v1[j];
                    u32x4 w; w.x = pkbf(v0[0], v0[1]); w.y = pkbf(v0[2], v0[3]); w.z = pkbf(v1[0], v1[1]); w.w = pkbf(v1[2], v1[3]);
                    *(u32x4*)(rowp + bj * 128) = w;
                }
                if (pn < 4) {
                    ss += __shfl_xor(ss, 16); ss += __shfl_xor(ss, 32);
                    if (fq == 0) rsq0[((size_t)row * 4 + pn) * 4 + wc] = ss;
                }
            }
    }
};

struct EpiG1i {
    static constexpr bool PERM = true;
    typedef i32x4 acc_t;
    __device__ __forceinline__ void init(i32x4 (&acc)[2][2][4][2], const Unit&, int, int, int, int) const {
#pragma unroll
        for (int a = 0; a < 2; ++a)
#pragma unroll
            for (int b = 0; b < 2; ++b)
#pragma unroll
                for (int m = 0; m < 4; ++m)
#pragma unroll
                    for (int n = 0; n < 2; ++n) acc[a][b][m][n] = (i32x4){0, 0, 0, 0};
    }
    unsigned char* ws; const float* bgate; const float* sh; const float* swg; float* rsq0;
    __device__ __forceinline__ void operator()(const i32x4 (&acc)[2][2][4][2], const Unit& u, int wr, int wc, int fr, int fq) const {
        asm volatile("" : "+v"(fr), "+v"(fq));
        const int pn = u.pn; bf16_t* base; int ld, ct, act = 0; const float* bias = nullptr;
        if (pn < 4)       { base = (bf16_t*)(ws + WS_CQKV); ld = 1024; ct = pn; }
        else if (pn < 8)  { base = (bf16_t*)(ws + WS_QG);   ld = 1024; ct = pn - 4; }
        else if (pn < 12) { base = (bf16_t*)(ws + WS_KG);   ld = 1024; ct = pn - 8; }
        else if (pn < 20) { base = (bf16_t*)(ws + WS_VG);   ld = 2048; ct = pn - 12; }
        else if (pn < 28) { base = (bf16_t*)(ws + WS_OG);   ld = 2048; ct = pn - 20; act = 1; }
        else if (pn < 36) { base = (bf16_t*)(ws + WS_GA);   ld = 2048; ct = pn - 28; act = 2; bias = bgate; }
        else if (pn < 44) { base = (bf16_t*)(ws + WS_GB);   ld = 2048; ct = pn - 36; act = 2; bias = bgate + 2048; }
        else              { base = (bf16_t*)(ws + WS_MISC); ld = 256;  ct = 0; }
        const int col0 = ct * 256 + wc * 32 + 8 * fq, colg = pn * 256 + wc * 32 + 8 * fq;
        f32x4 bv[2][2], sw[2][2];
#pragma unroll
        for (int bj = 0; bj < 2; ++bj)
#pragma unroll
            for (int n = 0; n < 2; ++n) { bv[bj][n] = bias ? *(const f32x4*)(bias + col0 + bj * 128 + 4 * n) : (f32x4){0.f, 0.f, 0.f, 0.f}; sw[bj][n] = *(const f32x4*)(swg + colg + bj * 128 + 4 * n); }
        float shv[2][4];
#pragma unroll
        for (int ai = 0; ai < 2; ++ai)
#pragma unroll
            for (int m = 0; m < 4; ++m) shv[ai][m] = sh[u.pm * 256 + ai * 128 + wr * 64 + m * 16 + fr];
#pragma unroll
        for (int ai = 0; ai < 2; ++ai)
#pragma unroll
            for (int m = 0; m < 4; ++m) {
                const int row = u.pm * 256 + ai * 128 + wr * 64 + m * 16 + fr;
                const float shr = shv[ai][m];
                bf16_t* rowp = base + (size_t)row * ld + col0;
                float ss = 0.f;
#pragma unroll
                for (int bj = 0; bj < 2; ++bj) {
                    f32x4 v0, v1;
#pragma unroll
                    for (int j = 0; j < 4; ++j) { v0[j] = (float)acc[ai][bj][m][0][j] * shr * sw[bj][0][j] + bv[bj][0][j]; v1[j] = (float)acc[ai][bj][m][1][j] * shr * sw[bj][1][j] + bv[bj][1][j]; }
                    if (act == 1) {
#pragma unroll
                        for (int j = 0; j < 4; ++j) { v0[j] = v0[j] * fast_sigmoid(v0[j]); v1[j] = v1[j] * fast_sigmoid(v1[j]); }
                    } else if (act == 2) {
#pragma unroll
                        for (int j = 0; j < 4; ++j) { v0[j] = fast_sigmoid(v0[j]); v1[j] = fast_sigmoid(v1[j]); }
                    }
#pragma unroll
                    for (int j = 0; j < 4; ++j) ss += v0[j] * v0[j] + v1[j] * v1[j];
                    u32x4 w; w.x = pkbf(v0[0], v0[1]); w.y = pkbf(v0[2], v0[3]); w.z = pkbf(v1[0], v1[1]); w.w = pkbf(v1[2], v1[3]);
                    __builtin_nontemporal_store(w, (u32x4*)(rowp + bj * 128));
                }
                if (pn < 4) {
                    ss += __shfl_xor(ss, 16); ss += __shfl_xor(ss, 32);
                    if (fq == 0) rsq0[((size_t)row * 4 + pn) * 4 + wc] = ss;
                }
            }
    }
};

template <int MODE> struct EpiUp {
    static constexpr bool PERM = true;
    typedef f32x4 acc_t;
    __device__ __forceinline__ void init(f32x4 (&acc)[2][2][4][2], const Unit&, int, int, int, int) const {
#pragma unroll
        for (int a = 0; a < 2; ++a)
#pragma unroll
            for (int b = 0; b < 2; ++b)
#pragma unroll
                for (int m = 0; m < 4; ++m)
#pragma unroll
                    for (int n = 0; n < 2; ++n) acc[a][b][m][n] = (f32x4){0.f, 0.f, 0.f, 0.f};
    }
    LAS unsigned char* lds; const float* rsq0; int rsq_off; const float* gn; const float* gr; const float* rope; bf16_t* out0; bf16_t* out1;
    __device__ __forceinline__ void operator()(const f32x4 (&acc)[2][2][4][2], const Unit& u, int wr, int wc, int fr, int fq) const {
        asm volatile("" : "+v"(fr), "+v"(fq));
        auto rcf = [&](int ai, int m) -> float {
            const int row = u.pm * 256 + ai * 128 + wr * 64 + m * 16 + fr;
            const f32x4 a = *(const f32x4*)(rsq0 + (size_t)row * 16 + rsq_off), b = *(const f32x4*)(rsq0 + (size_t)row * 16 + rsq_off + 4);
            const float s = (a[0] + a[1]) + (a[2] + a[3]) + (b[0] + b[1]) + (b[2] + b[3]);
            return __builtin_amdgcn_rsqf(s * (1.f / 512.f) + EPS);
        };
        const int pn = u.pn;
        if (pn < 8) {
            LAS float* X = (LAS float*)(lds + XCH_OFF);
#pragma unroll
            for (int ai = 0; ai < 2; ++ai)
#pragma unroll
                for (int m = 0; m < 4; ++m) {
                    const float rcv = rcf(ai, m);
#pragma unroll
                    for (int bj = 0; bj < 2; ++bj) {
                        float s = 0.f;
#pragma unroll
                        for (int n = 0; n < 2; ++n)
#pragma unroll
                            for (int j = 0; j < 4; ++j) { const float v = acc[ai][bj][m][n][j] * rcv; s += v * v; }
                        s += __shfl_xor(s, 16); s += __shfl_xor(s, 32);
                        if (fq == 0) X[((ai * 128 + wr * 64 + m * 16 + fr) * 2 + bj) * 4 + wc] = s;
                    }
                    asm volatile("" ::: "memory");
                }
            RAW_BAR();
            const int d0 = wc * 32 + 8 * fq;
            const f32x4 g0 = *(const f32x4*)(gn + d0), g1 = *(const f32x4*)(gn + d0 + 4);
#pragma unroll
            for (int ai = 0; ai < 2; ++ai)
#pragma unroll
                for (int m = 0; m < 4; ++m) {
                    const int rl = ai * 128 + wr * 64 + m * 16 + fr; const size_t row = (size_t)u.pm * 256 + rl;
                    const float rcv = rcf(ai, m);
#pragma unroll
                    for (int bj = 0; bj < 2; ++bj) {
                        const f32x4 t = *(const LAS f32x4*)(X + (rl * 2 + bj) * 4);
                        const float tot = (t[0] + t[1]) + (t[2] + t[3]);
                        float rs = __builtin_amdgcn_rsqf(tot * (1.f / 128.f) + EPS) * rcv;
                        if (MODE == 0) rs *= QSCALE;
                        const f32x4 v0 = acc[ai][bj][m][0] * rs * g0, v1 = acc[ai][bj][m][1] * rs * g1;
                        u32x4 w; w.x = pkbf(v0[0], v0[1]); w.y = pkbf(v0[2], v0[3]); w.z = pkbf(v1[0], v1[1]); w.w = pkbf(v1[2], v1[3]);
                        const int head = 2 * pn + bj;
                        if (MODE == 0) __builtin_nontemporal_store(w, (u32x4*)(out0 + row * 3072 + head * 192 + d0));
                        else           __builtin_nontemporal_store(w, (u32x4*)(out0 + row * 2048 + head * 128 + d0));
                    }
                    asm volatile("" ::: "memory");
                }
        } else if (MODE == 1) {
            const int d0 = wc * 32 + 8 * fq;
#pragma unroll
            for (int ai = 0; ai < 2; ++ai)
#pragma unroll
                for (int m = 0; m < 4; ++m) {
                    const size_t row = (size_t)u.pm * 256 + ai * 128 + wr * 64 + m * 16 + fr;
                    const float rcv = rcf(ai, m);
#pragma unroll
                    for (int bj = 0; bj < 2; ++bj) {
                        const f32x4 v0 = acc[ai][bj][m][0] * rcv, v1 = acc[ai][bj][m][1] * rcv;
                        u32x4 w; w.x = pkbf(v0[0], v0[1]); w.y = pkbf(v0[2], v0[3]); w.z = pkbf(v1[0], v1[1]); w.w = pkbf(v1[2], v1[3]);
                        const int head = 2 * (pn - 8) + bj;
                        __builtin_nontemporal_store(w, (u32x4*)(out1 + row * 2048 + head * 128 + d0));
                    }
                    asm volatile("" ::: "memory");
                }
        } else {
            const int head = 4 * (pn - 8) + wc;
#pragma unroll
            for (int ai = 0; ai < 2; ++ai)
#pragma unroll
                for (int m = 0; m < 4; ++m) {
                    const size_t row = (size_t)u.pm * 256 + ai * 128 + wr * 64 + m * 16 + fr;
                    const float rcv = rcf(ai, m);
                    float s = 0.f;
#pragma unroll
                    for (int bj = 0; bj < 2; ++bj)
#pragma unroll
                        for (int n = 0; n < 2; ++n)
#pragma unroll
                            for (int j = 0; j < 4; ++j) { const float v = acc[ai][bj][m][n][j] * rcv; s += v * v; }
                    s += __shfl_xor(s, 16); s += __shfl_xor(s, 32);
                    const float rs = __builtin_amdgcn_rsqf(s * (1.f / 64.f) + EPS) * rcv;
#pragma unroll
                    for (int bj = 0; bj < 2; ++bj) {
                        unsigned wv[4];
#pragma unroll
                        for (int n = 0; n < 2; ++n) {
                            const int i0 = 16 * bj + 4 * fq + 2 * n;
                            const f32x2_t cs = *(const f32x2_t*)(rope + row * 64 + i0), sn = *(const f32x2_t*)(rope + row * 64 + 32 + i0);
                            const f32x2_t ga = *(const f32x2_t*)(gr + i0), gb = *(const f32x2_t*)(gr + 32 + i0);
                            const f32x4 a = acc[ai][bj][m][n];
                            const float x1a = a[0] * rs * ga[0], x2a = a[1] * rs * gb[0], x1b = a[2] * rs * ga[1], x2b = a[3] * rs * gb[1];
                            const float o0 = (x1a * cs[0] - x2a * sn[0]) * QSCALE, o1 = (x2a * cs[0] + x1a * sn[0]) * QSCALE;
                            const float o2 = (x1b * cs[1] - x2b * sn[1]) * QSCALE, o3 = (x2b * cs[1] + x1b * sn[1]) * QSCALE;
                            wv[2 * n] = pkbf(o0, o1); wv[2 * n + 1] = pkbf(o2, o3);
                        }
                        u32x4 w; w.x = wv[0]; w.y = wv[1]; w.z = wv[2]; w.w = wv[3];
                        __builtin_nontemporal_store(w, (u32x4*)(out0 + row * 3072 + head * 192 + 128 + 32 * bj + 8 * fq));
                    }
                    asm volatile("" ::: "memory");
                }
        }
    }
};

struct EpiOut {
    static constexpr bool PERM = false;
    typedef f32x4 acc_t;
    const float* x; float* out; bf16_t* x1b; float* rsq1;
    __device__ __forceinline__ void init(f32x4 (&acc)[2][2][4][2], const Unit& u, int wr, int wc, int fr, int fq) const {
        asm volatile("" : "+v"(fr), "+v"(fq));
        const int col0 = u.pn * 256 + wc * 32 + 4 * fq;
#pragma unroll
        for (int ai = 0; ai < 2; ++ai)
#pragma unroll
            for (int m = 0; m < 4; ++m) { const size_t off = ((size_t)u.pm * 256 + ai * 128 + wr * 64 + m * 16 + fr) * 2048 + col0;
#pragma unroll
                for (int bj = 0; bj < 2; ++bj)
#pragma unroll
                    for (int n = 0; n < 2; ++n) acc[ai][bj][m][n] = *(const f32x4*)(x + off + bj * 128 + n * 16); }
    }
    __device__ __forceinline__ void operator()(const f32x4 (&acc)[2][2][4][2], const Unit& u, int wr, int wc, int fr, int fq) const {
        asm volatile("" : "+v"(fr), "+v"(fq));
        const int col0 = u.pn * 256 + wc * 32 + 4 * fq;
#pragma unroll
        for (int ai = 0; ai < 2; ++ai)
#pragma unroll
            for (int m = 0; m < 4; ++m) {
                const size_t row = (size_t)u.pm * 256 + ai * 128 + wr * 64 + m * 16 + fr; const size_t off = row * 2048 + col0;
                float ss = 0.f;
#pragma unroll
                for (int bj = 0; bj < 2; ++bj)
#pragma unroll
                    for (int n = 0; n < 2; ++n) {
                        const f32x4 v = acc[ai][bj][m][n];
                        *(f32x4*)(out + off + bj * 128 + n * 16) = v;
                        u32x2 w; w.x = pkbf(v[0], v[1]); w.y = pkbf(v[2], v[3]);
                        *(u32x2*)(x1b + off + bj * 128 + n * 16) = w;
                        ss += (v[0] * v[0] + v[1] * v[1]) + (v[2] * v[2] + v[3] * v[3]);
                    }
                ss += __shfl_xor(ss, 16); ss += __shfl_xor(ss, 32);
                if (fq == 0) rsq1[row * 32 + u.pn * 4 + wc] = ss;
            }
    }
};
struct EpiOutI {
    static constexpr bool PERM = true;
    typedef i32x4 acc_t;
    __device__ __forceinline__ void init(i32x4 (&acc)[2][2][4][2], const Unit&, int, int, int, int) const {
#pragma unroll
        for (int a = 0; a < 2; ++a)
#pragma unroll
            for (int b = 0; b < 2; ++b)
#pragma unroll
                for (int m = 0; m < 4; ++m)
#pragma unroll
                    for (int n = 0; n < 2; ++n) acc[a][b][m][n] = (i32x4){0, 0, 0, 0};
    }
    const float* x; bf16_t* x1b; float* rsq1; const float* sm; const float* swo;
    __device__ __forceinline__ void operator()(const i32x4 (&acc)[2][2][4][2], const Unit& u, int wr, int wc, int fr, int fq) const {
        asm volatile("" : "+v"(fr), "+v"(fq));
        const int col0 = u.pn * 256 + wc * 32 + 8 * fq;
        f32x4 sw[2][2];
#pragma unroll
        for (int bj = 0; bj < 2; ++bj)
#pragma unroll
            for (int n = 0; n < 2; ++n) sw[bj][n] = *(const f32x4*)(swo + col0 + bj * 128 + 4 * n);
#pragma unroll
        for (int ai = 0; ai < 2; ++ai)
#pragma unroll
            for (int m = 0; m < 4; ++m) {
                const size_t row = (size_t)u.pm * 256 + ai * 128 + wr * 64 + m * 16 + fr; const size_t off = row * 2048 + col0;
                const float smr = sm[row];
                f32x4 xv[2][2];
#pragma unroll
                for (int bj = 0; bj < 2; ++bj)
#pragma unroll
                    for (int n = 0; n < 2; ++n) xv[bj][n] = __builtin_nontemporal_load((const f32x4*)(x + off + bj * 128 + 4 * n));
                float ss = 0.f;
#pragma unroll
                for (int bj = 0; bj < 2; ++bj) {
                    f32x4 v0, v1;
#pragma unroll
                    for (int j = 0; j < 4; ++j) { v0[j] = xv[bj][0][j] + (float)acc[ai][bj][m][0][j] * smr * sw[bj][0][j]; v1[j] = xv[bj][1][j] + (float)acc[ai][bj][m][1][j] * smr * sw[bj][1][j]; }
                    u32x4 w; w.x = pkbf(v0[0], v0[1]); w.y = pkbf(v0[2], v0[3]); w.z = pkbf(v1[0], v1[1]); w.w = pkbf(v1[2], v1[3]);
                    *(u32x4*)(x1b + off + bj * 128) = w;
                    ss += ((v0[0] * v0[0] + v0[1] * v0[1]) + (v0[2] * v0[2] + v0[3] * v0[3])) + ((v1[0] * v1[0] + v1[1] * v1[1]) + (v1[2] * v1[2] + v1[3] * v1[3]));
                }
                ss += __shfl_xor(ss, 16); ss += __shfl_xor(ss, 32);
                if (fq == 0) rsq1[row * 32 + u.pn * 4 + wc] = ss;
                if (m & 1) asm volatile("" ::: "memory");
            }
    }
};
struct EpiQP {
    static constexpr bool PERM = true;
    typedef f32x4 acc_t;
    __device__ __forceinline__ void init(f32x4 (&acc)[2][2][4][2], const Unit&, int, int, int, int) const {
#pragma unroll
        for (int a = 0; a < 2; ++a)
#pragma unroll
            for (int b = 0; b < 2; ++b)
#pragma unroll
                for (int m = 0; m < 4; ++m)
#pragma unroll
                    for (int n = 0; n < 2; ++n) acc[a][b][m][n] = (f32x4){0.f, 0.f, 0.f, 0.f};
    }
    bf16_t* qp;
    __device__ __forceinline__ void operator()(const f32x4 (&acc)[2][2][4][2], const Unit& u, int wr, int wc, int fr, int fq) const {
        asm volatile("" : "+v"(fr), "+v"(fq));
        const int col0 = u.pn * 256 + wc * 32 + 8 * fq;
#pragma unroll
        for (int ai = 0; ai < 2; ++ai)
#pragma unroll
            for (int m = 0; m < 4; ++m) {
                const size_t row = (size_t)u.pm * 256 + ai * 128 + wr * 64 + m * 16 + fr;
#pragma unroll
                for (int bj = 0; bj < 2; ++bj) {
                    const f32x4 v0 = acc[ai][bj][m][0], v1 = acc[ai][bj][m][1];
                    u32x4 w; w.x = pkbf(v0[0], v0[1]); w.y = pkbf(v0[2], v0[3]); w.z = pkbf(v1[0], v1[1]); w.w = pkbf(v1[2], v1[3]);
                    *(u32x4*)(qp + row * 2048 + col0 + bj * 128) = w;
                }
            }
    }
};

struct EpiQPi {
    static constexpr bool PERM = true;
    typedef i32x4 acc_t;
    __device__ __forceinline__ void init(i32x4 (&acc)[2][2][4][2], const Unit&, int, int, int, int) const {
#pragma unroll
        for (int a = 0; a < 2; ++a)
#pragma unroll
            for (int b = 0; b < 2; ++b)
#pragma unroll
                for (int m = 0; m < 4; ++m)
#pragma unroll
                    for (int n = 0; n < 2; ++n) acc[a][b][m][n] = (i32x4){0, 0, 0, 0};
    }
    bf16_t* qp; const float* sx; const float* swp;
    __device__ __forceinline__ void operator()(const i32x4 (&acc)[2][2][4][2], const Unit& u, int wr, int wc, int fr, int fq) const {
        asm volatile("" : "+v"(fr), "+v"(fq));
        const int col0 = u.pn * 256 + wc * 32 + 8 * fq;
        f32x4 sw[2][2];
#pragma unroll
        for (int bj = 0; bj < 2; ++bj)
#pragma unroll
            for (int n = 0; n < 2; ++n) sw[bj][n] = *(const f32x4*)(swp + col0 + bj * 128 + 4 * n);
#pragma unroll
        for (int ai = 0; ai < 2; ++ai)
#pragma unroll
            for (int m = 0; m < 4; ++m) {
                const size_t row = (size_t)u.pm * 256 + ai * 128 + wr * 64 + m * 16 + fr; const float sxr = sx[row];
#pragma unroll
                for (int bj = 0; bj < 2; ++bj) {
                    f32x4 v0, v1;
#pragma unroll
                    for (int j = 0; j < 4; ++j) { v0[j] = (float)acc[ai][bj][m][0][j] * sxr * sw[bj][0][j]; v1[j] = (float)acc[ai][bj][m][1][j] * sxr * sw[bj][1][j]; }
                    u32x4 w; w.x = pkbf(v0[0], v0[1]); w.y = pkbf(v0[2], v0[3]); w.z = pkbf(v1[0], v1[1]); w.w = pkbf(v1[2], v1[3]);
                    __builtin_nontemporal_store(w, (u32x4*)(qp + row * 2048 + col0 + bj * 128));
                }
            }
    }
};

template <class CM>
__device__ __forceinline__ void p0_transpose_item(const float* W, int ldw, int K, int nblk, bf16_t* WT, LAS float* scr, int item, int lane, const CM& colmap, const float* kscale) {
    const int kb = item / nblk, nb = item % nblk, k0 = 64 * kb, n0 = 32 * nb;
    const int src = colmap(n0 + (lane & 31));
    float vv[32];
#pragma unroll
    for (int i = 0; i < 32; ++i) { const int kk = 2 * i + (lane >> 5); vv[i] = (src >= 0) ? W[(size_t)(k0 + kk) * ldw + src] : 0.f; }
    if (kscale) {
#pragma unroll
        for (int i = 0; i < 32; ++i) vv[i] *= kscale[k0 + 2 * i + (lane >> 5)];
    }
#pragma unroll
    for (int i = 0; i < 32; ++i) scr[(2 * i + (lane >> 5)) * 33 + (lane & 31)] = vv[i];
    asm volatile("s_waitcnt lgkmcnt(0)" ::: "memory");
    const int c = lane & 7;
#pragma unroll
    for (int j = 0; j < 4; ++j) { const int n = (lane >> 3) + 8 * j; const LAS float* s = scr + (8 * c) * 33 + n;
        u32x4 o; o.x = pkbf(s[0 * 33], s[1 * 33]); o.y = pkbf(s[2 * 33], s[3 * 33]); o.z = pkbf(s[4 * 33], s[5 * 33]); o.w = pkbf(s[6 * 33], s[7 * 33]);
        *(u32x4*)(WT + (size_t)(n0 + n) * K + k0 + 8 * c) = o; }
    asm volatile("s_waitcnt lgkmcnt(0)" ::: "memory");
}
template <class CM>
__device__ __forceinline__ void p0_transpose_item64(const float* W, int ldw, int K, int nblk, bf16_t* WT, LAS float* scr, int item, int lane, const CM& colmap, const float* kscale) {
    const int kb = item / nblk, nb = item % nblk, k0 = 64 * kb, n0 = 64 * nb;
    const int c4 = lane & 15, rr = lane >> 4;
    const int src = colmap(n0 + 4 * c4);
    f32x4 vv[16];
#pragma unroll
    for (int i = 0; i < 16; ++i) { const int kk = 4 * i + rr; vv[i] = (src >= 0) ? *(const f32x4*)(W + (size_t)(k0 + kk) * ldw + src) : (f32x4){0.f, 0.f, 0.f, 0.f}; }
    if (kscale) {
#pragma unroll
        for (int i = 0; i < 16; ++i) vv[i] = vv[i] * kscale[k0 + 4 * i + rr];
    }
#pragma unroll
    for (int i = 0; i < 16; ++i) { LAS float* d = scr + (4 * i + rr) * 65 + 4 * c4; d[0] = vv[i][0]; d[1] = vv[i][1]; d[2] = vv[i][2]; d[3] = vv[i][3]; }
    asm volatile("s_waitcnt lgkmcnt(0)" ::: "memory");
    const int c = lane & 7;
#pragma unroll
    for (int j = 0; j < 8; ++j) { const int n = (lane >> 3) + 8 * j; const LAS float* sp = scr + (8 * c) * 65 + n;
        u32x4 o; o.x = pkbf(sp[0 * 65], sp[1 * 65]); o.y = pkbf(sp[2 * 65], sp[3 * 65]); o.z = pkbf(sp[4 * 65], sp[5 * 65]); o.w = pkbf(sp[6 * 65], sp[7 * 65]);
        *(u32x4*)(WT + (size_t)(n0 + n) * K + k0 + 8 * c) = o; }
    asm volatile("s_waitcnt lgkmcnt(0)" ::: "memory");
}
__device__ __forceinline__ int cm_win(int n) { if (n < 1024) return n; if (n < 5120) return n + 64; if (n < 11264) return n + 80; if (n < 11328) return 1024 + (n - 11264); if (n < 11344) return 5184 + (n - 11328); return -1; }
template <bool WIN> __device__ __forceinline__ void p0_gate_colmax_item(const float* W, int ldw, int nblk, float* PMAX, int item, int lane, const float* kscale = nullptr) {
    const int kb = item / nblk, nb = item % nblk, k0 = 64 * kb, n0 = 64 * nb, c4 = lane & 15, rr = lane >> 4, ncol = 64 * nblk;
    const int src = WIN ? cm_win(n0 + 4 * c4) : n0 + 4 * c4;
    f32x4 mx = (f32x4){0.f, 0.f, 0.f, 0.f};
#pragma unroll
    for (int i = 0; i < 16; ++i) { const f32x4 v = ((src >= 0) ? *(const f32x4*)(W + (size_t)(k0 + 4 * i + rr) * ldw + src) : (f32x4){0.f, 0.f, 0.f, 0.f}) * (kscale ? kscale[k0 + 4 * i + rr] : 1.f);
        mx[0] = fmaxf(mx[0], fabsf(v[0])); mx[1] = fmaxf(mx[1], fabsf(v[1])); mx[2] = fmaxf(mx[2], fabsf(v[2])); mx[3] = fmaxf(mx[3], fabsf(v[3])); }
#pragma unroll
    for (int j = 0; j < 4; ++j) { mx[j] = fmaxf(mx[j], __shfl_xor(mx[j], 16)); mx[j] = fmaxf(mx[j], __shfl_xor(mx[j], 32)); }
    if (rr == 0) *(f32x4*)(PMAX + (size_t)kb * ncol + n0 + 4 * c4) = mx;
}
template <bool WIN> __device__ __forceinline__ void p0_gate_quant_item(const float* W, int ldw, int nblk, const float* PMAX, unsigned char* WG8, float* SWG, LAS float* scr, int item, int lane, const float* kscale = nullptr) {
    const int kb = item / nblk, nb = item % nblk, k0 = 64 * kb, n0 = 64 * nb, c4 = lane & 15, rr = lane >> 4, ncol = 64 * nblk;
    const int src = WIN ? cm_win(n0 + 4 * c4) : n0 + 4 * c4;
    float cm = 0.f;
#pragma unroll 8
    for (int b = 0; b < 32; ++b) cm = fmaxf(cm, PMAX[(size_t)b * ncol + n0 + lane]);
    cm = fmaxf(cm, 1e-30f);
    if (kb == 0) SWG[n0 + lane] = cm * (1.f / 127.f);
    f32x4 vv[16];
#pragma unroll
    for (int i = 0; i < 16; ++i) vv[i] = ((src >= 0) ? __builtin_nontemporal_load((const f32x4*)(W + (size_t)(k0 + 4 * i + rr) * ldw + src)) : (f32x4){0.f, 0.f, 0.f, 0.f}) * (kscale ? kscale[k0 + 4 * i + rr] : 1.f);
#pragma unroll
    for (int i = 0; i < 16; ++i) { LAS float* d = scr + (4 * i + rr) * 65 + 4 * c4; d[0] = vv[i][0]; d[1] = vv[i][1]; d[2] = vv[i][2]; d[3] = vv[i][3]; }
    asm volatile("s_waitcnt lgkmcnt(0)" ::: "memory");
    const int c = lane & 3;
#pragma unroll
    for (int j = 0; j < 4; ++j) { const int n = (lane >> 2) + 16 * j; const LAS float* sp = scr + (16 * c) * 65 + n;
        const float inv = 127.f / __shfl(cm, n);
        u32x4 o;
        o.x = q8pack(sp[0 * 65], sp[1 * 65], sp[2 * 65], sp[3 * 65], inv); o.y = q8pack(sp[4 * 65], sp[5 * 65], sp[6 * 65], sp[7 * 65], inv);
        o.z = q8pack(sp[8 * 65], sp[9 * 65], sp[10 * 65], sp[11 * 65], inv); o.w = q8pack(sp[12 * 65], sp[13 * 65], sp[14 * 65], sp[15 * 65], inv);
        *(u32x4*)(WG8 + (size_t)(n0 + n) * 2048 + k0 + 16 * c) = o; }
    asm volatile("s_waitcnt lgkmcnt(0)" ::: "memory");
}
struct CmWin { __device__ int operator()(int n) const { if (n < 1024) return n; if (n < 5120) return n + 64; if (n < 11264) return n + 80; if (n < 11328) return 1024 + (n - 11264); if (n < 11344) return 5184 + (n - 11328); return -1; } };
struct CmWuq { __device__ int operator()(int n) const { if (n < 2048) return (n >> 7) * 192 + (n & 127);
    const int m = n - 2048, tile = m >> 8, cl = m & 255, hl = (cl >> 5) & 3, pos = 32 * (cl >> 7) + (cl & 31), head = 4 * tile + hl; return head * 192 + 128 + (pos >> 1) + 32 * (pos & 1); } };
struct CmWukv { __device__ int operator()(int n) const { if (n < 2048) return (n >> 7) * 256 + (n & 127); const int m = n - 2048; return (m >> 7) * 256 + 128 + (m & 127); } };
struct CmId { __device__ int operator()(int n) const { return n; } };

struct Args { const void* in[22]; float* out; unsigned char* ws; int ph_lo, ph_hi; };

__device__ __forceinline__ s16x4 tr_read(const LAS unsigned char* p) { return __builtin_bit_cast(s16x4, __builtin_amdgcn_ds_read_tr16_b64_v4i16((LAS v4i16_t*)p)); }
__device__ __forceinline__ bf16x8 cat8(s16x4 lo, s16x4 hi) { return (bf16x8){lo[0], lo[1], lo[2], lo[3], hi[0], hi[1], hi[2], hi[3]}; }
__device__ __forceinline__ int crow(int r, int hi) { return (r & 3) + 8 * (r >> 2) + 4 * hi; }
__device__ __forceinline__ unsigned f2key(float f) { const unsigned u = __float_as_uint(f); return (u & 0x80000000u) ? ~u : (u | 0x80000000u); }
__device__ __forceinline__ float key2f(unsigned k) { const unsigned u = (k & 0x80000000u) ? (k & 0x7fffffffu) : ~k; return __uint_as_float(u); }
__device__ __forceinline__ unsigned umed3(unsigned a, unsigned b, unsigned c) { const unsigned mx = a > b ? a : b, mn = a > b ? b : a; const unsigned t = mx < c ? mx : c; return mn > t ? mn : t; }

constexpr int GL_QS = 0, GL_KS = 33792, GL_VS = 67584, GL_ST = 76800, GL_AB = 110592, GL_OB = 119808, GL_DEC = 137216;
__device__ __forceinline__ void gla_scan_unit(LAS unsigned char* lds, unsigned char* ws, const float* g_on, int b, int hh, int sl, bool dummy) {
    int tid_ = threadIdx.x; asm volatile("" : "+v"(tid_));
    const int tid = tid_, lane = tid & 63, wid = __builtin_amdgcn_readfirstlane(tid >> 6), l15 = lane & 15, g = lane >> 4;
    const bf16_t* QG = (const bf16_t*)(ws + WS_QG); const bf16_t* KG = (const bf16_t*)(ws + WS_KG); const bf16_t* VG = (const bf16_t*)(ws + WS_VG);
    const bf16_t* OG = (const bf16_t*)(ws + WS_OG); bf16_t* GB = (bf16_t*)(ws + WS_GB); const float* DECG = (const float*)(ws + WS_DEC); float* SSQ = (float*)(ws + WS_SSQ);
    const bf16_t* ABUF = (const bf16_t*)(ws + WS_ABUF);
    bf16_t* GBo = dummy ? (bf16_t*)(ws + WS_CQKV) : GB; float* SSQo = dummy ? (float*)(ws + WS_WIN + 100 * MiB) : SSQ; const size_t omask = dummy ? (size_t)0xffffff : ~(size_t)0;
    f32x4 S[2][4];
#pragma unroll
    for (int a = 0; a < 2; ++a)
#pragma unroll
        for (int v = 0; v < 4; ++v) S[a][v] = (f32x4){0.f, 0.f, 0.f, 0.f};
    u32x4 pq[4], pk[4], pv, pab, pgb, pog; f32x4 pd = (f32x4){0.f, 0.f, 0.f, 0.f};
    const size_t tb = (size_t)b * SEQ;
    const int oi = tid >> 3, opart = tid & 7, oe0 = sl * 64 + 8 * opart;
    const f32x4 gn0 = *(const f32x4*)(g_on + oe0), gn1 = *(const f32x4*)(g_on + oe0 + 4);
    auto issue = [&](int c) {
        const size_t t0 = tb + (size_t)c * 64;
#pragma unroll
        for (int q = 0; q < 4; ++q) { const int ci = tid + 512 * q, row = ci >> 5, cc = ci & 31;
            pq[q] = *(const u32x4*)(QG + (t0 + row) * 1024 + hh * 256 + cc * 8); pk[q] = *(const u32x4*)(KG + (t0 + row) * 1024 + hh * 256 + cc * 8); }
        { const int row = tid >> 3, cc = tid & 7; pv = *(const u32x4*)(VG + (t0 + row) * 2048 + hh * 512 + sl * 64 + cc * 8);
          pab = *(const u32x4*)(ABUF + ((size_t)((b * 4 + hh) * 32 + c)) * 4096 + row * 64 + cc * 8); }
        if (tid < 64) pd = *(const f32x4*)(DECG + ((size_t)((b * 4 + hh) * 32 + c)) * 256 + 4 * tid);
        { const size_t off = (t0 + oi) * 2048 + hh * 512 + oe0; pgb = *(const u32x4*)(GB + off); pog = *(const u32x4*)(OG + off); }
    };
    issue(0);
    for (int c = 0; c < 32; ++c) {
#ifdef REP_GA
        for (int rep_ = 0; rep_ < 2; ++rep_) {
#else
        {
#endif
#pragma unroll
        for (int q = 0; q < 4; ++q) { const int ci = tid + 512 * q, row = ci >> 5, cc = ci & 31;
            *(LAS u32x4*)(lds + GL_QS + row * 528 + cc * 16) = pq[q]; *(LAS u32x4*)(lds + GL_KS + row * 528 + cc * 16) = pk[q]; }
        { const int row = tid >> 3, cc = tid & 7; *(LAS u32x4*)(lds + GL_VS + row * 144 + cc * 16) = pv; *(LAS u32x4*)(lds + GL_AB + row * 144 + cc * 16) = pab; }
        if (tid < 64) *(LAS f32x4*)(lds + GL_DEC + 16 * tid) = pd;
#pragma unroll
        for (int a = 0; a < 2; ++a)
#pragma unroll
            for (int vt = 0; vt < 4; ++vt) { const int dt = 2 * wid + a; u32x2 w; w.x = pkbf(S[a][vt][0], S[a][vt][1]); w.y = pkbf(S[a][vt][2], S[a][vt][3]);
                *(LAS u32x2*)(lds + GL_ST + (16 * vt + l15) * 528 + (16 * dt + 4 * g) * 2) = w; }
        RAW_BAR();
        }
        const u32x4 cgb = pgb, cog = pog;
        if (c + 1 < 32) issue(c + 1);
#ifdef REP_GF1
        for (int rep_ = 0; rep_ < 2; ++rep_)
#endif
        {
            const int it = wid >> 1;
#pragma unroll
            for (int vv = 0; vv < 2; ++vv) {
                const int vt = 2 * (wid & 1) + vv;
                f32x4 o = (f32x4){0.f, 0.f, 0.f, 0.f};
#pragma unroll
                for (int ks = 0; ks < 8; ++ks) {
                    const bf16x8 fa = *(const LAS bf16x8*)(lds + GL_QS + (16 * it + l15) * 528 + (32 * ks + 8 * g) * 2);
                    const bf16x8 fb = *(const LAS bf16x8*)(lds + GL_ST + (16 * vt + l15) * 528 + (32 * ks + 8 * g) * 2);
                    o = __builtin_amdgcn_mfma_f32_16x16x32_bf16(fa, fb, o, 0, 0, 0);
                }
#pragma unroll
                for (int ks = 0; ks < 2; ++ks) {
                    const bf16x8 fa = *(const LAS bf16x8*)(lds + GL_AB + (16 * it + l15) * 144 + (32 * ks + 8 * g) * 2);
                    const LAS unsigned char* vp = lds + GL_VS + (32 * ks + 8 * g + (l15 >> 2)) * 144 + (16 * vt + 4 * (l15 & 3)) * 2;
                    const bf16x8 fb = cat8(tr_read(vp), tr_read(vp + 4 * 144));
                    o = __builtin_amdgcn_mfma_f32_16x16x32_bf16(fa, fb, o, 0, 0, 0);
                }
#pragma unroll
                for (int r = 0; r < 4; ++r) *(LAS float*)(lds + GL_OB + ((16 * it + 4 * g + r) * 68 + 16 * vt + l15) * 4) = o[r];
            }
        }
        {
            bf16x8 fv[4][2];
#pragma unroll
            for (int vt = 0; vt < 4; ++vt)
#pragma unroll
                for (int ks = 0; ks < 2; ++ks) { const LAS unsigned char* vp = lds + GL_VS + (32 * ks + 8 * g + (l15 >> 2)) * 144 + (16 * vt + 4 * (l15 & 3)) * 2;
                    fv[vt][ks] = cat8(tr_read(vp), tr_read(vp + 4 * 144)); }
#pragma unroll
            for (int a = 0; a < 2; ++a) {
                const int dt = 2 * wid + a;
#pragma unroll
                for (int ks = 0; ks < 2; ++ks) {
                    const LAS unsigned char* kp = lds + GL_KS + (32 * ks + 8 * g + (l15 >> 2)) * 528 + (16 * dt + 4 * (l15 & 3)) * 2;
                    const bf16x8 fk = cat8(tr_read(kp), tr_read(kp + 4 * 528));
#pragma unroll
                    for (int vt = 0; vt < 4; ++vt) S[a][vt] = __builtin_amdgcn_mfma_f32_16x16x32_bf16(fk, fv[vt][ks], S[a][vt], 0, 0, 0);
                }
                const f32x4 dc = *(const LAS f32x4*)(lds + GL_DEC + (16 * dt + 4 * g) * 4);
#pragma unroll
                for (int vt = 0; vt < 4; ++vt) S[a][vt] = S[a][vt] * dc;
            }
        }
        RAW_BAR();
        {
            const int i = oi, part = opart; const size_t t = tb + (size_t)c * 64 + i;
            const f32x4 o0 = *(const LAS f32x4*)(lds + GL_OB + (i * 68 + 8 * part) * 4), o1 = *(const LAS f32x4*)(lds + GL_OB + (i * 68 + 8 * part + 4) * 4);
            float ss = (o0[0] * o0[0] + o0[1] * o0[1]) + (o0[2] * o0[2] + o0[3] * o0[3]) + (o1[0] * o1[0] + o1[1] * o1[1]) + (o1[2] * o1[2] + o1[3] * o1[3]);
            ss += __shfl_xor(ss, 1); ss += __shfl_xor(ss, 2); ss += __shfl_xor(ss, 4);
            if (part == 0) SSQo[(t * 4 + hh) * 8 + sl] = ss;
            const size_t off = t * 2048 + hh * 512 + oe0;
            const u32x4 gb = cgb, og = cog;
            u32x4 w;
            w.x = pkbf(o0[0] * bf_lo(gb.x) * bf_lo(og.x) * gn0[0], o0[1] * bf_hi(gb.x) * bf_hi(og.x) * gn0[1]);
            w.y = pkbf(o0[2] * bf_lo(gb.y) * bf_lo(og.y) * gn0[2], o0[3] * bf_hi(gb.y) * bf_hi(og.y) * gn0[3]);
            w.z = pkbf(o1[0] * bf_lo(gb.z) * bf_lo(og.z) * gn1[0], o1[1] * bf_hi(gb.z) * bf_hi(og.z) * gn1[1]);
            w.w = pkbf(o1[2] * bf_lo(gb.w) * bf_lo(og.w) * gn1[2], o1[3] * bf_hi(gb.w) * bf_hi(og.w) * gn1[3]);
            *(u32x4*)(GBo + (off & omask)) = w;
        }
    }
    __syncthreads();
}

constexpr int AT_KSTR = 400, AT_VSTR = 320, AT_VOFF = 64 * AT_KSTR, AT_BUF = 64 * AT_KSTR + 64 * AT_VSTR;
__device__ __forceinline__ void attn_unit(LAS unsigned char* lds, const bf16_t* Qh, const bf16_t* Kh, const bf16_t* Vh, const bf16_t* KPE, const bf16_t* GAin, bf16_t* GAout, size_t omask, int b, int hh, int qb) {
    int tid_ = threadIdx.x; asm volatile("" : "+v"(tid_));
    const int tid = tid_, lane = tid & 63, wid = __builtin_amdgcn_readfirstlane(tid >> 6), r32 = lane & 31, hi = lane >> 5;
    const size_t tb = (size_t)b * SEQ; const int q0 = qb * 256;
    const int NT = (q0 + 256) / 64;
    u32x4 sk[2], sr, sv[2];
    auto issue = [&](int jt) {
        const size_t t0 = tb + (size_t)jt * 64;
#pragma unroll
        for (int q = 0; q < 2; ++q) { const int ci = tid + 512 * q, row = ci >> 4, cc = ci & 15;
            sk[q] = *(const u32x4*)(Kh + (t0 + row) * 2048 + hh * 128 + cc * 8); sv[q] = *(const u32x4*)(Vh + (t0 + row) * 2048 + hh * 128 + cc * 8); }
        { const int row = tid >> 3, cc = tid & 7; sr = *(const u32x4*)(KPE + (t0 + row) * 64 + cc * 8); }
    };
    auto stash = [&](int buf) {
        LAS unsigned char* kb = lds + buf * AT_BUF; LAS unsigned char* vb = kb + AT_VOFF;
#pragma unroll
        for (int q = 0; q < 2; ++q) { const int ci = tid + 512 * q, row = ci >> 4, cc = ci & 15;
            *(LAS u32x4*)(kb + row * AT_KSTR + cc * 16) = sk[q]; *(LAS u32x4*)(vb + row * AT_VSTR + cc * 16) = sv[q]; }
        { const int row = tid >> 3, cc = tid & 7; *(LAS u32x4*)(kb + row * AT_KSTR + 256 + cc * 16) = sr; }
    };
    issue(0);
    bf16x8 qf[12];
    { const bf16_t* qp = Qh + (tb + q0 + wid * 32 + r32) * 3072 + hh * 192 + hi * 8;
#pragma unroll
      for (int d0 = 0; d0 < 12; ++d0) qf[d0] = *(const bf16x8*)(qp + d0 * 16); }
    f32x16 o[4];
#pragma unroll
    for (int d = 0; d < 4; ++d)
#pragma unroll
        for (int r = 0; r < 16; ++r) o[d][r] = 0.f;
    float mrun = -1e30f, lrun = 0.f;
    stash(0);
    if (NT > 1) issue(1);
    RAW_BAR();
    const int qidx = q0 + wid * 32 + r32;
    for (int jt = 0; jt < NT; ++jt) {
        const int buf = jt & 1;
        const LAS unsigned char* kb = lds + buf * AT_BUF; const LAS unsigned char* vb = kb + AT_VOFF;
        f32x16 p0, p1;
#pragma unroll
        for (int r = 0; r < 16; ++r) { p0[r] = 0.f; p1[r] = 0.f; }
        __builtin_amdgcn_s_setprio(1);
#pragma unroll
        for (int d0 = 0; d0 < 12; ++d0) {
            const bf16x8 k0 = *(const LAS bf16x8*)(kb + r32 * AT_KSTR + (16 * d0 + 8 * hi) * 2);
            const bf16x8 k1 = *(const LAS bf16x8*)(kb + (32 + r32) * AT_KSTR + (16 * d0 + 8 * hi) * 2);
            p0 = __builtin_amdgcn_mfma_f32_32x32x16_bf16(k0, qf[d0], p0, 0, 0, 0);
            p1 = __builtin_amdgcn_mfma_f32_32x32x16_bf16(k1, qf[d0], p1, 0, 0, 0);
        }
        __builtin_amdgcn_s_setprio(0);
        if (jt >= NT - 4) {
            const int kbase = jt * 64 + 4 * hi;
#pragma unroll
            for (int r = 0; r < 16; ++r) { const int kv = kbase + (r & 3) + 8 * (r >> 2); if (kv > qidx) p0[r] = -1e30f; if (kv + 32 > qidx) p1[r] = -1e30f; }
        }
        float mxa = fmaxf(fmaxf(p0[0], p0[1]), p0[2]), mxb = fmaxf(fmaxf(p1[0], p1[1]), p1[2]);
#pragma unroll
        for (int r = 3; r < 15; r += 2) { mxa = fmaxf(fmaxf(mxa, p0[r]), p0[r + 1]); mxb = fmaxf(fmaxf(mxb, p1[r]), p1[r + 1]); }
        float mx = fmaxf(fmaxf(mxa, p0[15]), fmaxf(mxb, p1[15]));
        mx = fmaxf(mx, __shfl_xor(mx, 32));
        const bool grow = mx > mrun + 6.0f;
        if (__builtin_amdgcn_ballot_w64(grow) != 0ull) {
            const float mnew = fmaxf(mrun, mx);
            const float alpha = __builtin_amdgcn_exp2f(mrun - mnew);
            mrun = mnew; lrun *= alpha;
#pragma unroll
            for (int d = 0; d < 4; ++d)
#pragma unroll
                for (int r = 0; r < 16; ++r) o[d][r] *= alpha;
        }
        float ls = 0.f;
#pragma unroll
        for (int r = 0; r < 16; ++r) { p0[r] = __builtin_amdgcn_exp2f(p0[r] - mrun); p1[r] = __builtin_amdgcn_exp2f(p1[r] - mrun); ls += p0[r] + p1[r]; }
        lrun += ls;
        bf16x8 pf[4];
        { u32x4 w;
          w.x = pkbf(p0[0], p0[1]); w.y = pkbf(p0[2], p0[3]); w.z = pkbf(p0[4], p0[5]); w.w = pkbf(p0[6], p0[7]); pf[0] = __builtin_bit_cast(bf16x8, w);
          w.x = pkbf(p0[8], p0[9]); w.y = pkbf(p0[10], p0[11]); w.z = pkbf(p0[12], p0[13]); w.w = pkbf(p0[14], p0[15]); pf[1] = __builtin_bit_cast(bf16x8, w);
          w.x = pkbf(p1[0], p1[1]); w.y = pkbf(p1[2], p1[3]); w.z = pkbf(p1[4], p1[5]); w.w = pkbf(p1[6], p1[7]); pf[2] = __builtin_bit_cast(bf16x8, w);
          w.x = pkbf(p1[8], p1[9]); w.y = pkbf(p1[10], p1[11]); w.z = pkbf(p1[12], p1[13]); w.w = pkbf(p1[14], p1[15]); pf[3] = __builtin_bit_cast(bf16x8, w); }
        const int i16 = lane & 15;
        const LAS unsigned char* vbase = vb + ((4 * hi) + (i16 >> 2)) * AT_VSTR + (16 * ((lane >> 4) & 1) + 4 * (i16 & 3)) * 2;
        __builtin_amdgcn_s_setprio(1);
#pragma unroll
        for (int ks = 0; ks < 4; ++ks) {
#pragma unroll
            for (int d = 0; d < 4; ++d) {
                const LAS unsigned char* vp = vbase + (16 * ks) * AT_VSTR + (32 * d) * 2;
                const bf16x8 fv = cat8(tr_read(vp), tr_read(vp + 8 * AT_VSTR));
                o[d] = __builtin_amdgcn_mfma_f32_32x32x16_bf16(fv, pf[ks], o[d], 0, 0, 0);
            }
        }
        __builtin_amdgcn_s_setprio(0);
        if (jt + 1 < NT) stash(buf ^ 1);
        if (jt + 2 < NT) issue(jt + 2);
        RAW_BAR();
    }
    lrun += __shfl_xor(lrun, 32);
    const float inv = __builtin_amdgcn_rcpf(lrun);
    bf16_t* op = GAout + (((tb + qidx) * 2048 + hh * 128) & omask); const bf16_t* ip = GAin + (tb + qidx) * 2048 + hh * 128;
#pragma unroll
    for (int d = 0; d < 4; ++d)
#pragma unroll
        for (int g4 = 0; g4 < 4; ++g4) {
            const int dv = 32 * d + 8 * g4 + 4 * hi;
            const u32x2 ga = *(const u32x2*)(ip + dv);
            u32x2 w;
            w.x = pkbf(o[d][4 * g4 + 0] * inv * bf_lo(ga.x), o[d][4 * g4 + 1] * inv * bf_hi(ga.x));
            w.y = pkbf(o[d][4 * g4 + 2] * inv * bf_lo(ga.y), o[d][4 * g4 + 3] * inv * bf_hi(ga.y));
            *(u32x2*)(op + dv) = w;
        }
}

__device__ __forceinline__ void x1_quant_unit(unsigned char* ws, int unit) {
    int tid_ = threadIdx.x; asm volatile("" : "+v"(tid_));
    const int tid = tid_, lane = tid & 63, wid = __builtin_amdgcn_readfirstlane(tid >> 6);
    const bf16_t* X1B = (const bf16_t*)(ws + WS_X1B); const size_t t0 = (size_t)unit * 64;
    {
        unsigned char* X8 = ws + WS_X8; float* SX = (float*)(ws + WS_SX);
        u32x4 xv[8][4];
#pragma unroll
        for (int it = 0; it < 8; ++it)
#pragma unroll
            for (int k = 0; k < 4; ++k) xv[it][k] = *(const u32x4*)(X1B + (t0 + wid + 8 * it) * 2048 + (size_t)(lane + 64 * k) * 8);
#pragma unroll
        for (int it = 0; it < 8; ++it) { const size_t t = t0 + wid + 8 * it; float ax = 0.f;
#pragma unroll
            for (int k = 0; k < 4; ++k)
#pragma unroll
                for (int d = 0; d < 4; ++d) ax = fmaxf(ax, fmaxf(fabsf(bf_lo(xv[it][k][d])), fabsf(bf_hi(xv[it][k][d]))));
            ax = fmaxf(wave_max(ax), 1e-30f); const float ix = 127.f / ax;
#pragma unroll
            for (int k = 0; k < 4; ++k) { u32x2 w;
                w.x = q8pack(bf_lo(xv[it][k].x), bf_hi(xv[it][k].x), bf_lo(xv[it][k].y), bf_hi(xv[it][k].y), ix); w.y = q8pack(bf_lo(xv[it][k].z), bf_hi(xv[it][k].z), bf_lo(xv[it][k].w), bf_hi(xv[it][k].w), ix);
                *(u32x2*)(X8 + t * 2048 + (size_t)(lane + 64 * k) * 8) = w; }
            if (lane == 0) SX[t] = ax * (1.f / 127.f); }
    }
}

constexpr int PE_KEYS = 0, PE_R1 = 135168;
__device__ __forceinline__ void sort16_insert(unsigned (&L)[16], unsigned x) {
#pragma unroll
    for (int i = 15; i >= 1; --i) L[i] = umed3(L[i - 1], L[i], x);
    L[0] = L[0] > x ? L[0] : x;
}
__device__ __forceinline__ void cex(unsigned& a, unsigned& b) { const unsigned hi = a > b ? a : b, lo = a > b ? b : a; a = hi; b = lo; }
__device__ __forceinline__ unsigned sel4(unsigned p0, unsigned p1, unsigned p2, unsigned p3, int i) {
    const unsigned w = (i & 8) ? ((i & 4) ? p3 : p2) : ((i & 4) ? p1 : p0);
    return (w >> (8 * (i & 3))) & 0xffu;
}
__device__ __forceinline__ void peer_unit(LAS unsigned char* lds, unsigned char* ws, float* out, int unit) {
    unsigned short* SELT = (unsigned short*)(ws + WS_SELT); float* GATE = (float*)(ws + WS_GATE); float* R1G = (float*)(ws + WS_R1G);
    int tid_ = threadIdx.x; asm volatile("" : "+v"(tid_));
    const int tid = tid_, lane = tid & 63, wid = __builtin_amdgcn_readfirstlane(tid >> 6), r32 = lane & 31, hi = lane >> 5;
    const bf16_t* QP = (const bf16_t*)(ws + WS_QP); const bf16_t* KEYS = (const bf16_t*)(ws + WS_KEYS); const bf16_t* X1B = (const bf16_t*)(ws + WS_X1B);
    const unsigned char* U8 = ws + WS_UB; const unsigned char* V8 = ws + WS_VB; const float* RSQ1 = (const float*)(ws + WS_RSQ1);
    LAS float* R1 = (LAS float*)(lds + PE_R1);
    const size_t t0 = (size_t)unit * 64;
    if (tid < 64) { const float* p = RSQ1 + (t0 + tid) * 32; float s = 0.f;
#pragma unroll
        for (int i = 0; i < 8; ++i) { const f32x4 v = *(const f32x4*)(p + 4 * i); s += (v[0] + v[1]) + (v[2] + v[3]); }
        const float r1v = __builtin_amdgcn_rsqf(s * (1.f / 2048.f) + EPS); R1[tid] = r1v; R1G[t0 + tid] = r1v; }
    __syncthreads();
#ifndef NO_PEER1
    {
        const int tg = wid & 1; const int tl = 32 * tg + r32; const size_t t = t0 + tl;
        const float rstd = R1[tl];
#define PEER_STAGE_KEYS(step) do { const int hx_ = (step) >> 1, p_ = (step) & 1; \
            _Pragma("unroll") for (int i_ = 0; i_ < 16; ++i_) { const int r_ = (wid & 1) * 64 + 4 * i_ + (lane >> 4); \
                __builtin_amdgcn_global_load_lds((const unsigned*)(KEYS + ((size_t)(((4 * hx_ + (wid >> 1)) * 2 + p_) * 128 + r_)) * 128 + (((lane & 15) ^ (r_ & 15)) * 8)), \
                                                 (LAS unsigned*)(lds + PE_KEYS + (wid * 16 + i_) * 1024), 16, 0, 0); } } while (0)
        PEER_STAGE_KEYS(0);
        const unsigned kbase = (unsigned)(PE_KEYS + (wid >> 1) * 32768 + r32 * 256); const int kx = r32 & 15;
        bf16x8 qf[8];
        { const bf16_t* qn = QP + t * 2048 + (wid >> 1) * 256 + 8 * hi;
#pragma unroll
          for (int d0 = 0; d0 < 8; ++d0) qf[d0] = *(const bf16x8*)(qn + 16 * d0); }
        asm volatile("s_waitcnt vmcnt(0)" ::: "memory"); __syncthreads();
#pragma unroll 1
        for (int hx = 0; hx < 2; ++hx) {
            const int h = (wid >> 1) + 4 * hx;
            unsigned LA[16], LB[16];
#pragma unroll 1
            for (int p = 0; p < 2; ++p) {
                f32x16 acc[4];
#pragma unroll
                for (int kb = 0; kb < 4; ++kb)
#pragma unroll
                    for (int r = 0; r < 16; ++r) acc[kb][r] = 0.f;
#pragma unroll
                for (int d0 = 0; d0 < 8; ++d0) {
                    const unsigned ko = kbase + (unsigned)(((2 * d0 + hi) ^ kx) << 4);
#pragma unroll
                    for (int kb = 0; kb < 4; ++kb) { const bf16x8 kf = *(const LAS bf16x8*)(lds + ko + kb * 8192);
                        acc[kb] = __builtin_amdgcn_mfma_f32_32x32x16_bf16(kf, qf[d0], acc[kb], 0, 0, 0); }
                }
                if (hx * 2 + p < 3) { __syncthreads(); PEER_STAGE_KEYS(hx * 2 + p + 1);
                    const int sn = hx * 2 + p + 1; const bf16_t* qn = QP + t * 2048 + ((wid >> 1) + 4 * (sn >> 1)) * 256 + (sn & 1) * 128 + 8 * hi;
#pragma unroll
                    for (int d0 = 0; d0 < 8; ++d0) qf[d0] = *(const bf16x8*)(qn + 16 * d0); }
                unsigned L[16];
#pragma unroll
                for (int i = 0; i < 16; ++i) L[i] = 0u;
#pragma unroll
                for (int kb = 0; kb < 4; ++kb)
#pragma unroll
                    for (int r = 0; r < 16; ++r) { const int key = 32 * kb + (r & 3) + 8 * (r >> 2);
                        const unsigned x = (f2key(acc[kb][r]) & ~127u) | (unsigned)(127 - key - 4 * hi); sort16_insert(L, x); }
                unsigned M[16];
#pragma unroll
                for (int i = 0; i < 16; ++i) { const unsigned o = (unsigned)__shfl_xor((int)L[15 - i], 32); M[i] = L[i] > o ? L[i] : o; }
#pragma unroll
                for (int dd = 8; dd >= 1; dd >>= 1)
#pragma unroll
                    for (int i = 0; i < 16; ++i) if ((i & dd) == 0) cex(M[i], M[i + dd]);
                if (p == 0) {
#pragma unroll
                    for (int i = 0; i < 16; ++i) LA[i] = M[i];
                } else {
#pragma unroll
                    for (int i = 0; i < 16; ++i) LB[i] = M[i];
                }
                if (hx * 2 + p < 3) { asm volatile("s_waitcnt vmcnt(0)" ::: "memory"); __syncthreads(); }
            }
            float fa[16], fb[16]; unsigned ia0 = 0u, ia1 = 0u, ia2 = 0u, ia3 = 0u, ib0 = 0u, ib1 = 0u, ib2 = 0u, ib3 = 0u;
#pragma unroll
            for (int i = 0; i < 16; ++i) { fa[i] = key2f(LA[i] & ~127u); fb[i] = key2f(LB[i] & ~127u);
                const unsigned va = (127u - (LA[i] & 127u)) << (8 * (i & 3)), vb = (127u - (LB[i] & 127u)) << (8 * (i & 3));
                if ((i >> 2) == 0) { ia0 |= va; ib0 |= vb; } else if ((i >> 2) == 1) { ia1 |= va; ib1 |= vb; } else if ((i >> 2) == 2) { ia2 |= va; ib2 |= vb; } else { ia3 |= va; ib3 |= vb; } }
            unsigned C[16];
#pragma unroll
            for (int i = 0; i < 16; ++i) C[i] = 0u;
#pragma unroll
            for (int i = 0; i < 16; ++i)
#pragma unroll
                for (int j = 0; j < 16; ++j) if ((i + 1) * (j + 1) <= 16) { const unsigned x = (f2key(fa[i] + fb[j]) & ~255u) | (unsigned)(i * 16 + j); sort16_insert(C, x); }
            const float smax = key2f(C[0] & ~255u);
            float e[16], den = 0.f;
#pragma unroll
            for (int k = 0; k < 16; ++k) { e[k] = __builtin_amdgcn_exp2f((key2f(C[k] & ~255u) - smax) * rstd * 1.4426950408889634f); den += e[k]; }
            const float rden = 1.f / den;
            if (hi == 0) {
#pragma unroll
                for (int k = 0; k < 16; ++k) { const int ij = (int)(C[k] & 255u); const unsigned id = sel4(ia0, ia1, ia2, ia3, ij >> 4) * 128u + sel4(ib0, ib1, ib2, ib3, ij & 15);
                    const int pos = (k & 7) * 16 + 2 * h + (k >> 3);
                    SELT[t * 128 + pos] = (unsigned short)id; GATE[t * 128 + pos] = e[k] * rden; }
            }
        }
    }
#endif
    __syncthreads();
    __syncthreads();
}


#define PEER_IDS(dst0, dst1, tt) do { dst0 = __builtin_nontemporal_load((const u32x4*)(SELT + (tt) * 128 + es * 16)); dst1 = __builtin_nontemporal_load((const u32x4*)(SELT + (tt) * 128 + es * 16 + 8)); } while (0)
#define PEER_ROWS(rowv, i0v, i1v) do { _Pragma("unroll") for (int q = 0; q < 16; ++q) { const unsigned w_ = (q < 8) ? i0v[q >> 1] : i1v[(q - 8) >> 1]; const unsigned id_ = (q & 1) ? (w_ >> 16) : (w_ & 0xffffu); \
        rowv[q] = *(const u32x4*)(tab + (size_t)id_ * 128); } } while (0)
#define PERMB(s0, s1, sel) __builtin_amdgcn_perm((s0), (s1), (sel))
__device__ __forceinline__ void peer_v_token(const u32x4 (&row)[16], const u32x4 wq, float sw, const bf16_t* xp, float* op, int lane) {
    const unsigned xb = __builtin_nontemporal_load((const unsigned*)xp); const f32x2_t xo = {bf_lo(xb), bf_hi(xb)};
    int a[16];
#pragma unroll
    for (int k = 0; k < 16; ++k) a[k] = 0;
#pragma unroll
    for (int g4 = 0; g4 < 4; ++g4) {
        const int wd = (int)wq[g4];
#pragma unroll
        for (int dw = 0; dw < 4; ++dw) {
            const unsigned A = row[4 * g4][dw], B = row[4 * g4 + 1][dw], C = row[4 * g4 + 2][dw], D = row[4 * g4 + 3][dw];
            const unsigned ablo = PERMB(B, A, 0x05010400u), abhi = PERMB(B, A, 0x07030602u), cdlo = PERMB(D, C, 0x05010400u), cdhi = PERMB(D, C, 0x07030602u);
            a[4 * dw + 0] = __builtin_amdgcn_sdot4((int)PERMB(cdlo, ablo, 0x05040100u), wd, a[4 * dw + 0], false);
            a[4 * dw + 1] = __builtin_amdgcn_sdot4((int)PERMB(cdlo, ablo, 0x07060302u), wd, a[4 * dw + 1], false);
            a[4 * dw + 2] = __builtin_amdgcn_sdot4((int)PERMB(cdhi, abhi, 0x05040100u), wd, a[4 * dw + 2], false);
            a[4 * dw + 3] = __builtin_amdgcn_sdot4((int)PERMB(cdhi, abhi, 0x07060302u), wd, a[4 * dw + 3], false);
        }
    }
    int r4a[4], r4b[4], r2a[2], r2b[2], r1a, r1b;
#pragma unroll
    for (int j = 0; j < 4; ++j) { const bool up = (lane & 8) != 0;
        const int ka = up ? a[4 * j + 2] : a[4 * j], kb = up ? a[4 * j + 3] : a[4 * j + 1], sa = up ? a[4 * j] : a[4 * j + 2], sb = up ? a[4 * j + 1] : a[4 * j + 3];
        r4a[j] = ka + __shfl_xor(sa, 8); r4b[j] = kb + __shfl_xor(sb, 8); }
#pragma unroll
    for (int j = 0; j < 2; ++j) { const bool up = (lane & 16) != 0;
        const int ka = up ? r4a[2 * j + 1] : r4a[2 * j], kb = up ? r4b[2 * j + 1] : r4b[2 * j], sa = up ? r4a[2 * j] : r4a[2 * j + 1], sb = up ? r4b[2 * j] : r4b[2 * j + 1];
        r2a[j] = ka + __shfl_xor(sa, 16); r2b[j] = kb + __shfl_xor(sb, 16); }
    { const bool up = (lane & 32) != 0;
        const int ka = up ? r2a[1] : r2a[0], kb = up ? r2b[1] : r2b[0], sa = up ? r2a[0] : r2a[1], sb = up ? r2b[0] : r2b[1];
        r1a = ka + __shfl_xor(sa, 32); r1b = kb + __shfl_xor(sb, 32); }
    __builtin_nontemporal_store((f32x2_t){xo[0] + sw * (float)r1a, xo[1] + sw * (float)r1b}, (f32x2_t*)op);
}

__device__ __forceinline__ void peer_u_sum(const u32x4 (&row)[16], const u32x4 xq, int lane, int& s0, int& s1) {
    int part[16];
#pragma unroll
    for (int q = 0; q < 16; ++q) { int a = 0;
#pragma unroll
        for (int dw = 0; dw < 4; ++dw) a = __builtin_amdgcn_sdot4((int)xq[dw], (int)row[q][dw], a, false);
        part[q] = a; }
    int r8[8], r4[4];
#pragma unroll
    for (int j = 0; j < 8; ++j) { const int keep = (lane & 1) ? part[2 * j + 1] : part[2 * j], send = (lane & 1) ? part[2 * j] : part[2 * j + 1]; r8[j] = keep + __shfl_xor(send, 1); }
#pragma unroll
    for (int j = 0; j < 4; ++j) { const int keep = (lane & 2) ? r8[2 * j + 1] : r8[2 * j], send = (lane & 2) ? r8[2 * j] : r8[2 * j + 1]; r4[j] = keep + __shfl_xor(send, 2); }
    { const int keep = (lane & 4) ? r4[1] : r4[0], send = (lane & 4) ? r4[0] : r4[1]; s0 += keep + __shfl_xor(send, 4); }
    { const int keep = (lane & 4) ? r4[3] : r4[2], send = (lane & 4) ? r4[2] : r4[3]; s1 += keep + __shfl_xor(send, 4); }
}
__device__ __forceinline__ void peer_fused_rounds(LAS unsigned char* lds, unsigned char* ws, float* out, int unit) {
    int tid_ = threadIdx.x; asm volatile("" : "+v"(tid_));
    const int tid = tid_, lane = tid & 63, wid = __builtin_amdgcn_readfirstlane(tid >> 6), es = lane >> 3, cb = lane & 7;
    const unsigned short* SELT = (const unsigned short*)(ws + WS_SELT); const unsigned char* X8 = ws + WS_X8; const float* GATE = (const float*)(ws + WS_GATE);
    const float* R1G = (const float*)(ws + WS_R1G); const float* SX = (const float*)(ws + WS_SX); const float* SU = (const float*)(ws + WS_SU); const float* SV = (const float*)(ws + WS_SV);
    LAS unsigned char* W8L = lds + 70000 + wid * 1024;
    const size_t tw = (size_t)unit * 64 + (size_t)wid * 8;
    u32x4 idr[8][2];
#pragma unroll
    for (int i = 0; i < 8; ++i) { idr[i][0] = *(const u32x4*)(SELT + (tw + i) * 128 + es * 16); idr[i][1] = *(const u32x4*)(SELT + (tw + i) * 128 + es * 16 + 8); }
    int acc[8][2];
#pragma unroll
    for (int i = 0; i < 8; ++i) { acc[i][0] = 0; acc[i][1] = 0; }
#pragma unroll 1
    for (int sidx = 0; sidx < 16; ++sidx) {
        const unsigned char* tab = ws + WS_UB + (size_t)sidx * (2 * MiB) + cb * 16;
        u32x4 xq[8];
#pragma unroll
        for (int i = 0; i < 8; ++i) xq[i] = *(const u32x4*)(X8 + (tw + i) * 2048 + sidx * 128 + cb * 16);
#pragma unroll
        for (int i = 0; i < 8; ++i) { u32x4 row[16]; u32x4 ia = idr[i][0], ib = idr[i][1]; asm volatile("" : "+v"(ia), "+v"(ib));
            PEER_ROWS(row, ia, ib); peer_u_sum(row, xq[i], lane, acc[i][0], acc[i][1]); asm volatile("" ::: "memory"); }
    }
    float swv[8];
#pragma unroll
    for (int i = 0; i < 8; ++i) { const size_t t = tw + i; const float tsc = SX[t] * R1G[t]; float wv[2];
#pragma unroll
        for (int hf = 0; hf < 2; ++hf) { const size_t idx = t * 128 + es * 16 + 8 * hf + cb; const unsigned id = SELT[idx];
            const float act = (float)acc[i][hf] * tsc * SU[id];
            wv[hf] = GATE[idx] * 0.5f * act * (1.f + erff(act * 0.70710678118654752f)) * SV[id]; }
        const float aw = fmaxf(wave_max(fmaxf(fabsf(wv[0]), fabsf(wv[1]))), 1e-30f); const float iw = 127.f / aw;
        W8L[i * 128 + es * 16 + cb] = (unsigned char)((int)__builtin_rintf(wv[0] * iw) & 0xff); W8L[i * 128 + es * 16 + 8 + cb] = (unsigned char)((int)__builtin_rintf(wv[1] * iw) & 0xff);
        swv[i] = aw * (1.f / 127.f); }
    asm volatile("s_waitcnt lgkmcnt(0)" ::: "memory");
    u32x4 wq[8];
#pragma unroll
    for (int i = 0; i < 8; ++i) wq[i] = *(const LAS u32x4*)(W8L + i * 128 + es * 16);
#pragma unroll 1
    for (int sidx = 0; sidx < 16; ++sidx) {
        const unsigned char* tab = ws + WS_VB + (size_t)sidx * (2 * MiB) + cb * 16;
        float* ob = out + sidx * 128 + cb * 16 + 2 * es; const bf16_t* xb1 = (const bf16_t*)(ws + WS_X1B) + sidx * 128 + cb * 16 + 2 * es;
#pragma unroll
        for (int i = 0; i < 8; ++i) { u32x4 row[16]; u32x4 ia = idr[i][0], ib = idr[i][1]; asm volatile("" : "+v"(ia), "+v"(ib));
            PEER_ROWS(row, ia, ib); peer_v_token(row, wq[i], swv[i], xb1 + (tw + i) * 2048, ob + (tw + i) * 2048, lane); asm volatile("" ::: "memory"); }
    }
}

#define XB_TMO      128
#define XB_XCNT(j)  (256  + 64 * (j))
#define XB_XSUB(j)  (1280 + 64 * (j))
#define XB_XGEN(j)  (2304 + 64 * (j))
#define XB_TOP      3328
#define XB_TOPGEN   3392
#define XB_SPIN_CAP (1u << 22)
__device__ __forceinline__ unsigned xb_ld(unsigned* p)              { return __hip_atomic_load(p, __ATOMIC_RELAXED, __HIP_MEMORY_SCOPE_AGENT); }
__device__ __forceinline__ unsigned xb_add(unsigned* p, unsigned v) { return __hip_atomic_fetch_add(p, v, __ATOMIC_RELAXED, __HIP_MEMORY_SCOPE_AGENT); }
__device__ __forceinline__ unsigned xb_xcc_id() { return (unsigned)__builtin_amdgcn_s_getreg((3 << 11) | 20) & 0xFu; }
#define XB_SPIN(cond, bar) do { unsigned _sp = 0; while (cond) { __builtin_amdgcn_s_sleep(1); \
    if ((++_sp & 255u) == 0u) { if (xb_ld(&(bar)[XB_TMO])) break; if (_sp > XB_SPIN_CAP) { atomicAdd(&(bar)[XB_TMO], 1u); break; } } } } while (0)
struct XcdBarrier { unsigned* bar; unsigned x; volatile LAS unsigned* st; };
__device__ __forceinline__ XcdBarrier xcd_barrier_post(unsigned* bar, volatile LAS unsigned* st) {
    XcdBarrier b; b.bar = bar; b.x = xb_xcc_id(); b.st = st;
    if (threadIdx.x == 0) (void)xb_add(&bar[XB_XCNT(b.x)], 1u);
    return b;
}
__device__ __forceinline__ void xcd_barrier_complete(unsigned* bar, unsigned x, unsigned& nloc, unsigned& nx) {
    const unsigned G = gridDim.x * gridDim.y * gridDim.z;
    unsigned sum, cnt, mine, sp = 0u;
    for (;;) {
        sum = 0u; cnt = 0u; mine = 0u;
#pragma unroll
        for (unsigned j = 0; j < 16; ++j) { const unsigned c = xb_ld(&bar[XB_XCNT(j)]); sum += c; cnt += (c > 0u) ? 1u : 0u; mine = (j == x) ? c : mine; }
        if (sum == G) break;
        __builtin_amdgcn_s_sleep(1);
        if ((++sp & 255u) == 0u) { if (xb_ld(&bar[XB_TMO])) break; if (sp > XB_SPIN_CAP) { atomicAdd(&bar[XB_TMO], 1u); break; } }
    }
    nloc = mine > 0u ? mine : 1u; nx = cnt > 0u ? cnt : 1u;
}
__device__ __forceinline__ void xcd_barrier(const XcdBarrier& b) {
    asm volatile("s_waitcnt vmcnt(0)" ::: "memory");
    __syncthreads();
    if (threadIdx.x == 0) {
        unsigned* bar = b.bar;
        __builtin_amdgcn_s_waitcnt(0);
        unsigned nloc = b.st[0], nx = b.st[1];
        if (nloc == 0u) { xcd_barrier_complete(bar, b.x, nloc, nx); b.st[0] = nloc; b.st[1] = nx; }
        const unsigned old = xb_add(&bar[XB_XSUB(b.x)], 1u);
        const unsigned gen = old / nloc;
        if (old + 1u == (gen + 1u) * nloc) {
            __builtin_amdgcn_fence(__ATOMIC_RELEASE, "agent");
            asm volatile("s_waitcnt vmcnt(0)" ::: "memory");
            const unsigned og = xb_add(&bar[XB_TOP], 1u);
            const unsigned tg = og / nx;
            if (og + 1u == (tg + 1u) * nx) xb_add(&bar[XB_TOPGEN], 1u);
            else XB_SPIN(xb_ld(&bar[XB_TOPGEN]) == tg, bar);
            __builtin_amdgcn_fence(__ATOMIC_ACQUIRE, "agent");
            xb_add(&bar[XB_XGEN(b.x)], 1u);
            asm volatile("s_waitcnt vmcnt(0)" ::: "memory");
        } else {
            XB_SPIN(xb_ld(&bar[XB_XGEN(b.x)]) == gen, bar);
            __builtin_amdgcn_fence(__ATOMIC_ACQUIRE, "agent");
            asm volatile("s_waitcnt vmcnt(0)" ::: "memory");
        }
    }
    __syncthreads();
}

__global__ void __launch_bounds__(512, 2) mk_fwd(Args args) {
    extern __shared__ __attribute__((aligned(16))) unsigned char lds_raw[];
    LAS unsigned char* lds = (LAS unsigned char*)lds_raw;
    const int tid = threadIdx.x, lane = tid & 63, wave = __builtin_amdgcn_readfirstlane(tid >> 6);
    const int G = gridDim.x, bx = blockIdx.x;
    const int vcu = (G % 8 == 0) ? (bx % 8) * (G / 8) + bx / 8 : bx;
    unsigned char* ws = args.ws;
    const float* x = (const float*)args.in[0]; const int* positions = (const int*)args.in[1];
    const float* g_norm_mix = (const float*)args.in[2]; const float* w_in = (const float*)args.in[3]; const float* b_gate = (const float*)args.in[4];
    const float* g_cq = (const float*)args.in[5]; const float* w_uq = (const float*)args.in[6]; const float* g_ckv = (const float*)args.in[7]; const float* w_ukv = (const float*)args.in[8];
    const float* g_qn = (const float*)args.in[9]; const float* g_qr = (const float*)args.in[10]; const float* g_kn = (const float*)args.in[11]; const float* g_kr = (const float*)args.in[12];
    const float* w_a2 = (const float*)args.in[13]; const float* b_a = (const float*)args.in[14]; const float* g_on = (const float*)args.in[15];
    const float* w_out = (const float*)args.in[16]; const float* g_ffn = (const float*)args.in[17]; const float* w_pq = (const float*)args.in[18]; const float* sub_keys = (const float*)args.in[19];
    const float* u_emb = (const float*)args.in[20]; const float* v_emb = (const float*)args.in[21];
    float* out = args.out;
    const int lo = args.ph_lo, hi_ph = args.ph_hi;
#ifndef PH_MASK
#define PH_MASK 0xff
#endif
#define IN(k) (((PH_MASK >> (k)) & 1) && lo <= (k) && (k) < hi_ph)
#define SEAM(k) do { if (IN(k) && IN((k) + 1)) { if (args.ph_lo < 0) cg::this_grid().sync(); else xcd_barrier(xbar); } } while (0)
    volatile LAS unsigned* xst = (volatile LAS unsigned*)(lds + (LDS_BYTES - 64));
    if (tid < 2) xst[tid] = 0u;
    __syncthreads();
    XcdBarrier xbar = xcd_barrier_post((unsigned*)ws, xst);
    const int gw = vcu * 8 + wave, NGW = G * 8;

    if (IN(0)) {
#ifdef REP_P0
      for (int rep_ = 0; rep_ < 2; ++rep_) {
#else
      {
#endif
        LAS float* scr = (LAS float*)(lds + wave * 16896);
        constexpr int I_UQ = 8 * 96, I_UKV = 8 * 64, I_OUT = 32 * 32, I_PQ = 32 * 32, I_GM = 32 * 180;
        constexpr int NITEMS = I_UQ + I_UKV + I_OUT + I_PQ + I_GM;
        for (int it = gw; it < NITEMS; it += NGW) {
            int r = it;
            if (r < I_GM) { p0_gate_colmax_item<true>(w_in, 11344, 180, (float*)(ws + WS_PMAX), r, lane); continue; } r -= I_GM;
            if (r < I_UQ) { p0_transpose_item(w_uq, 3072, 512, 96, (bf16_t*)(ws + WS_WUQ), scr, r, lane, CmWuq(), g_cq); continue; } r -= I_UQ;
            if (r < I_UKV) { p0_transpose_item64(w_ukv, 4096, 512, 64, (bf16_t*)(ws + WS_WUKV), scr, r, lane, CmWukv(), g_ckv); continue; } r -= I_UKV;
            if (r < I_OUT) { p0_gate_colmax_item<false>(w_out, 2048, 32, (float*)(ws + WS_PMAXO), r, lane); continue; } r -= I_OUT;
            p0_gate_colmax_item<false>(w_pq, 2048, 32, (float*)(ws + WS_PMAXP), r, lane, g_ffn);
        }
        for (int m = gw; m < T; m += 2 * NGW) {
            const int m2 = m + NGW;
            const f32x4* xr = (const f32x4*)(x + (size_t)m * 2048) + lane; const f32x4* xr2 = (const f32x4*)(x + (size_t)(m2 < T ? m2 : m) * 2048) + lane;
            f32x4 v[8], v2[8]; float s = 0.f, s2 = 0.f;
#pragma unroll
            for (int j = 0; j < 8; ++j) { v[j] = __builtin_nontemporal_load(xr + 64 * j); v2[j] = __builtin_nontemporal_load(xr2 + 64 * j); }
#pragma unroll
            for (int j = 0; j < 8; ++j) { s += (v[j][0] * v[j][0] + v[j][1] * v[j][1]) + (v[j][2] * v[j][2] + v[j][3] * v[j][3]); s2 += (v2[j][0] * v2[j][0] + v2[j][1] * v2[j][1]) + (v2[j][2] * v2[j][2] + v2[j][3] * v2[j][3]); }
            const float rstd = 1.f / sqrtf(wave_sum(s) * (1.f / 2048.f) + EPS), rstd2 = 1.f / sqrtf(wave_sum(s2) * (1.f / 2048.f) + EPS);
            float am = 0.f, am2 = 0.f;
#pragma unroll
            for (int j = 0; j < 8; ++j) { const f32x4 gg = *((const f32x4*)g_norm_mix + lane + 64 * j);
                v[j] = v[j] * rstd * gg; v2[j] = v2[j] * rstd2 * gg;
                am = fmaxf(am, fmaxf(fmaxf(fabsf(v[j][0]), fabsf(v[j][1])), fmaxf(fabsf(v[j][2]), fabsf(v[j][3])))); am2 = fmaxf(am2, fmaxf(fmaxf(fabsf(v2[j][0]), fabsf(v2[j][1])), fmaxf(fabsf(v2[j][2]), fabsf(v2[j][3]))));
                }
            am = fmaxf(wave_max(am), 1e-30f); am2 = fmaxf(wave_max(am2), 1e-30f);
            const float ih = 127.f / am, ih2 = 127.f / am2;
            unsigned* h8 = (unsigned*)((unsigned char*)out + (size_t)m * 2048) + lane; unsigned* h82 = (unsigned*)((unsigned char*)out + (size_t)m2 * 2048) + lane;
#pragma unroll
            for (int j = 0; j < 8; ++j) { h8[64 * j] = q8pack(v[j][0], v[j][1], v[j][2], v[j][3], ih); if (m2 < T) h82[64 * j] = q8pack(v2[j][0], v2[j][1], v2[j][2], v2[j][3], ih2); }
            if (lane == 0) { float* SH = (float*)((unsigned char*)out + 32 * MiB); SH[m] = am * (1.f / 127.f); if (m2 < T) SH[m2] = am2 * (1.f / 127.f); }
        }
        { float* ROPE = (float*)(ws + WS_ROPE);
          for (int i = bx * 512 + tid; i < T * 32; i += G * 512) { const int t = i >> 5, f = i & 31; const float inv = powf(10000.f, -(float)(2 * f) / 64.f); const float ang = (float)positions[t] * inv;
              ROPE[(size_t)t * 64 + f] = cosf(ang); ROPE[(size_t)t * 64 + 32 + f] = sinf(ang); } }
        { bf16_t* KEYS = (bf16_t*)(ws + WS_KEYS);
          for (int i = bx * 512 + tid; i < 8 * 2 * 128 * 128 / 2; i += G * 512) { const f32x2_t v = *(const f32x2_t*)(sub_keys + 2 * (size_t)i); *(unsigned*)(KEYS + 2 * (size_t)i) = pkbf(v[0], v[1]); } }
      }
    }
    SEAM(0);
    if (IN(1)) {
        {   LAS float* scr = (LAS float*)(lds + wave * 16896);
            for (int it = gw; it < 32 * 180 + 2 * 32 * 32; it += NGW) {
                if (it < 32 * 180) p0_gate_quant_item<true>(w_in, 11344, 180, (const float*)(ws + WS_PMAX), ws + WS_WG8, (float*)(ws + WS_SWG), scr, it, lane);
                else if (it < 32 * 180 + 32 * 32) p0_gate_quant_item<false>(w_out, 2048, 32, (const float*)(ws + WS_PMAXO), ws + WS_WOUT, (float*)(ws + WS_SWO), scr, it - 32 * 180, lane);
                else p0_gate_quant_item<false>(w_pq, 2048, 32, (const float*)(ws + WS_PMAXP), ws + WS_WPQ, (float*)(ws + WS_SWP), scr, it - 32 * 180 - 32 * 32, lane, g_ffn); }
            __syncthreads(); }
        if (lo == 0 && hi_ph == NPH) xcd_barrier(xbar);
        {
            pg8::Gemm g{(const bf16_t*)out, (const bf16_t*)(ws + WS_WG8), T, N1, 1024, 1024, 1024}; pg8::StaticOrder S; S.init(T, N1, G, bx);
            EpiG1i E{ws, b_gate, (const float*)((const unsigned char*)out + 32 * MiB), (const float*)(ws + WS_SWG), (float*)(ws + WS_RSQ0)};
            pg8::gemm_phase<EpiG1i, true>(lds, g, S, E); }
    }
    SEAM(1);
    if (IN(2)) {
        {
            const bf16_t* MISC = (const bf16_t*)(ws + WS_MISC); const float* ROPE = (const float*)(ws + WS_ROPE); bf16_t* KPE = (bf16_t*)(ws + WS_KPE);
            for (int t = gw; t < T; t += NGW) {
                const float v = bf1(MISC[(size_t)t * 256 + lane]);
                const float ss = wave_sum(v * v);
                const float xn = v * __builtin_amdgcn_rsqf(ss * (1.f / 64.f) + EPS) * g_kr[lane];
                const float other = __shfl_xor(xn, 32);
                const int f = lane & 31; const float c = ROPE[(size_t)t * 64 + f], s = ROPE[(size_t)t * 64 + 32 + f];
                const float o = (lane < 32) ? (xn * c - other * s) : (xn * c + other * s);
                KPE[(size_t)t * 64 + 2 * f + (lane >> 5)] = f2bf(o);
            }
        }
#ifndef NO_PREP
        {
            bf16_t* QG = (bf16_t*)(ws + WS_QG); bf16_t* KG = (bf16_t*)(ws + WS_KG); const bf16_t* MISC = (const bf16_t*)(ws + WS_MISC); float* DECG = (float*)(ws + WS_DEC);
            LAS float* alr = (LAS float*)lds; LAS float* tot = (LAS float*)(lds + 4096); LAS float* cumL = (LAS float*)(lds + 8192);
            LAS unsigned char* qL = lds + 8192 + 65536; LAS unsigned char* kL = qL + 64 * 528;
            const int d = tid & 255, half = tid >> 8;
            for (int un = vcu; un < 1024; un += G) {
                const int c = un & 31, hh = (un >> 5) & 3, b = un >> 7; const size_t t0 = (size_t)b * SEQ + (size_t)c * 64;
                for (int i = tid; i < 1024; i += 512) alr[i] = bf1(MISC[(t0 + (i >> 4)) * 256 + 64 + (i & 15)]);
                const int dc = (tid & 31) * 8;
                u32x4 qv[4], kv[4];
#pragma unroll
                for (int i = 0; i < 4; ++i) { const size_t off = (t0 + (tid >> 5) + 16 * i) * 1024 + hh * 256 + dc; qv[i] = *(const u32x4*)(QG + off); kv[i] = *(const u32x4*)(KG + off); }
                float w[16];
#pragma unroll
                for (int r = 0; r < 16; ++r) w[r] = w_a2[r * 1024 + hh * 256 + d];
                const float ba = b_a[hh * 256 + d];
                __syncthreads();
                float la[32]; float sum = 0.f;
#pragma unroll
                for (int jj = 0; jj < 32; ++jj) { const int j = 32 * half + jj; float z = ba;
#pragma unroll
                    for (int r4 = 0; r4 < 4; ++r4) { const f32x4 a = *(const LAS f32x4*)(alr + j * 16 + 4 * r4); z += a[0] * w[4 * r4] + a[1] * w[4 * r4 + 1] + a[2] * w[4 * r4 + 2] + a[3] * w[4 * r4 + 3]; }
                    const float ls = fminf(z, 0.f) - __logf(1.f + __expf(-fabsf(z)));
                    la[jj] = ls * (1.f / 16.f); sum += la[jj]; }
                if (half == 0) tot[d] = sum;
                __syncthreads();
                float cum = half ? tot[d] : 0.f;
#pragma unroll
                for (int jj = 0; jj < 32; ++jj) { cum += la[jj]; cumL[(32 * half + jj) * 256 + d] = cum; }
                if (half == 1) DECG[((size_t)((b * 4 + hh) * 32 + c)) * 256 + d] = __expf(cum);
                __syncthreads();
#pragma unroll
                for (int i = 0; i < 4; ++i) { const int j = (tid >> 5) + 16 * i; const size_t off = (t0 + j) * 1024 + hh * 256 + dc;
                    const f32x4 c0 = *(const LAS f32x4*)(cumL + j * 256 + dc), c1 = *(const LAS f32x4*)(cumL + j * 256 + dc + 4);
                    float e[8];
#pragma unroll
                    for (int k = 0; k < 4; ++k) { e[k] = __expf(c0[k]); e[4 + k] = __expf(c1[k]); }
                    u32x4 qo, ko;
#pragma unroll
                    for (int k = 0; k < 4; ++k) { const float e0 = e[2 * k], e1 = e[2 * k + 1];
                        qo[k] = pkbf(bf_lo(qv[i][k]) * e0 * 0.0625f, bf_hi(qv[i][k]) * e1 * 0.0625f);
                        ko[k] = pkbf(bf_lo(kv[i][k]) * __builtin_amdgcn_rcpf(e0), bf_hi(kv[i][k]) * __builtin_amdgcn_rcpf(e1)); }
                    *(u32x4*)(QG + off) = qo; *(u32x4*)(KG + off) = ko;
                    *(LAS u32x4*)(qL + j * 528 + dc * 2) = qo; *(LAS u32x4*)(kL + j * 528 + dc * 2) = ko; }
                __syncthreads();
                {
                    bf16_t* ABUF = (bf16_t*)(ws + WS_ABUF) + ((size_t)((b * 4 + hh) * 32 + c)) * 4096;
                    const int l15 = lane & 15, g = lane >> 4, it = wave >> 1;
#pragma unroll
                    for (int jj = 0; jj < 2; ++jj) {
                        const int jt = 2 * (wave & 1) + jj;
                        f32x4 a = (f32x4){0.f, 0.f, 0.f, 0.f};
                        if (jt <= it) {
#pragma unroll
                            for (int ks = 0; ks < 8; ++ks) {
                                const bf16x8 fa = *(const LAS bf16x8*)(qL + (16 * it + l15) * 528 + (32 * ks + 8 * g) * 2);
                                const bf16x8 fb = *(const LAS bf16x8*)(kL + (16 * jt + l15) * 528 + (32 * ks + 8 * g) * 2);
                                a = __builtin_amdgcn_mfma_f32_16x16x32_bf16(fb, fa, a, 0, 0, 0);
                            }
                        }
                        const int i = 16 * it + l15, j0 = 16 * jt + 4 * g;
                        u32x2 w2; w2.x = pkbf((j0 <= i) ? a[0] : 0.f, (j0 + 1 <= i) ? a[1] : 0.f); w2.y = pkbf((j0 + 2 <= i) ? a[2] : 0.f, (j0 + 3 <= i) ? a[3] : 0.f);
                        *(u32x2*)(ABUF + i * 64 + j0) = w2;
                    }
                }
                __syncthreads();
            }
        }
#endif
#ifndef NO_G2
        {
            pg8::Gemm g{(const bf16_t*)(ws + WS_CQKV), (const bf16_t*)(ws + WS_WUQ), T, 3072, 512, 1024, 512}; pg8::StaticOrder S; S.init(T, 3072, G, bx);
            EpiUp<0> E{lds, (const float*)(ws + WS_RSQ0), 0, g_qn, g_qr, (const float*)(ws + WS_ROPE), (bf16_t*)(ws + WS_QH), nullptr};
            pg8::gemm_phase<EpiUp<0>, true>(lds, g, S, E);
#ifdef REP_G2
            pg8::gemm_phase<EpiUp<0>, true>(lds, g, S, E);
#endif
        }
#endif
#ifndef NO_G3
        {
            pg8::Gemm g{(const bf16_t*)(ws + WS_CQKV) + 512, (const bf16_t*)(ws + WS_WUKV), T, 4096, 512, 1024, 512}; pg8::StaticOrder S; S.init(T, 4096, G, bx);
            EpiUp<1> E{lds, (const float*)(ws + WS_RSQ0), 8, g_kn, nullptr, nullptr, (bf16_t*)out, (bf16_t*)out + (size_t)T * 2048};
            pg8::gemm_phase<EpiUp<1>, true>(lds, g, S, E);
#ifdef REP_G2
            pg8::gemm_phase<EpiUp<1>, true>(lds, g, S, E);
#endif
        }
#endif
    }
    SEAM(2);
    if (IN(3)) {
#ifndef NO_GLA
        for (int un = vcu; un < 256; un += G) gla_scan_unit(lds, ws, g_on, un >> 5, (un >> 3) & 3, un & 7, false);
#endif
#ifdef REP_GLA
        for (int un = vcu; un < 256; un += G) gla_scan_unit(lds, ws, g_on, un >> 5, (un >> 3) & 3, un & 7, true);
#endif
        const bf16_t* Qh = (const bf16_t*)(ws + WS_QH); const bf16_t* Kh = (const bf16_t*)out; const bf16_t* Vh = (const bf16_t*)out + (size_t)T * 2048;
        const bf16_t* KPE = (const bf16_t*)(ws + WS_KPE); bf16_t* GA = (bf16_t*)(ws + WS_GA);
#ifndef NO_ATTN
        for (int pr = vcu; pr < 512; pr += G) {
            const int bh = pr >> 2, s = pr & 3;
            attn_unit(lds, Qh, Kh, Vh, KPE, GA, GA, ~(size_t)0, bh >> 4, bh & 15, 7 - s);
            attn_unit(lds, Qh, Kh, Vh, KPE, GA, GA, ~(size_t)0, bh >> 4, bh & 15, s);
        }
#endif
#ifdef REP_ATTN
        for (int pr = vcu; pr < 512; pr += G) { const int bh = pr >> 2, s = pr & 3;
            attn_unit(lds, Qh, Kh, Vh, KPE, GA, (bf16_t*)(ws + WS_CQKV), (size_t)0xffffff, bh >> 4, bh & 15, 7 - s);
            attn_unit(lds, Qh, Kh, Vh, KPE, GA, (bf16_t*)(ws + WS_CQKV), (size_t)0xffffff, bh >> 4, bh & 15, s); }
#endif
    }
    SEAM(3);
    if (IN(4)) {
        const bf16_t* GA = (const bf16_t*)(ws + WS_GA); const bf16_t* GB = (const bf16_t*)(ws + WS_GB); const float* SSQ = (const float*)(ws + WS_SSQ);
        unsigned char* M8 = ws + WS_M8; float* SM = (float*)(ws + WS_SM);
        for (int t = gw; t < T; t += NGW) {
            float mv[4][8]; float am = 0.f;
#pragma unroll
            for (int q = 0; q < 4; ++q) {
                const f32x4 s0 = *(const f32x4*)(SSQ + ((size_t)t * 4 + q) * 8), s1 = *(const f32x4*)(SSQ + ((size_t)t * 4 + q) * 8 + 4);
                const float rs = __builtin_amdgcn_rsqf(((s0[0] + s0[1]) + (s0[2] + s0[3]) + (s1[0] + s1[1]) + (s1[2] + s1[3])) * (1.f / 512.f) + EPS);
                const size_t off = (size_t)t * 2048 + (size_t)(lane + 64 * q) * 8;
                const u32x4 a = __builtin_nontemporal_load((const u32x4*)(GA + off)), bb = __builtin_nontemporal_load((const u32x4*)(GB + off));
                mv[q][0] = bf_lo(a.x) + rs * bf_lo(bb.x); mv[q][1] = bf_hi(a.x) + rs * bf_hi(bb.x); mv[q][2] = bf_lo(a.y) + rs * bf_lo(bb.y); mv[q][3] = bf_hi(a.y) + rs * bf_hi(bb.y);
                mv[q][4] = bf_lo(a.z) + rs * bf_lo(bb.z); mv[q][5] = bf_hi(a.z) + rs * bf_hi(bb.z); mv[q][6] = bf_lo(a.w) + rs * bf_lo(bb.w); mv[q][7] = bf_hi(a.w) + rs * bf_hi(bb.w);
#pragma unroll
                for (int e = 0; e < 8; ++e) am = fmaxf(am, fabsf(mv[q][e]));
            }
            am = fmaxf(wave_max(am), 1e-30f); const float im = 127.f / am;
#pragma unroll
            for (int q = 0; q < 4; ++q) { u32x2 w; w.x = q8pack(mv[q][0], mv[q][1], mv[q][2], mv[q][3], im); w.y = q8pack(mv[q][4], mv[q][5], mv[q][6], mv[q][7], im);
                *(u32x2*)(M8 + (size_t)t * 2048 + (size_t)(lane + 64 * q) * 8) = w; }
            if (lane == 0) SM[t] = am * (1.f / 127.f);
        }
        unsigned char* U8 = ws + WS_UB; unsigned char* V8 = ws + WS_VB;
        float* SU = (float*)(ws + WS_SU); float* SV = (float*)(ws + WS_SV);
#ifdef REP_P4C
      for (int rep_ = 0; rep_ < 2; ++rep_)
#endif
        for (int e = gw; e < 16384; e += NGW) {
            f32x4 uv[8], vv[8]; float au = 0.f, av = 0.f;
#pragma unroll
            for (int q = 0; q < 2; ++q)
#pragma unroll
                for (int h4 = 0; h4 < 4; ++h4) { const int col = 16 * (lane + 64 * q) + 4 * h4;
                    uv[4 * q + h4] = *(const f32x4*)(u_emb + (size_t)e * 2048 + col) * *(const f32x4*)(g_ffn + col); vv[4 * q + h4] = *(const f32x4*)(v_emb + (size_t)e * 2048 + col); }
#pragma unroll
            for (int k = 0; k < 8; ++k) { au = fmaxf(au, fmaxf(fmaxf(fabsf(uv[k][0]), fabsf(uv[k][1])), fmaxf(fabsf(uv[k][2]), fabsf(uv[k][3]))));
                av = fmaxf(av, fmaxf(fmaxf(fabsf(vv[k][0]), fabsf(vv[k][1])), fmaxf(fabsf(vv[k][2]), fabsf(vv[k][3])))); }
            au = fmaxf(wave_max(au), 1e-30f); av = fmaxf(wave_max(av), 1e-30f);
            const float iu = 127.f / au, iv = 127.f / av;
#pragma unroll
            for (int q = 0; q < 2; ++q) { const int cc = lane + 64 * q; const size_t dst = (size_t)(cc >> 3) * (2 * MiB) + (size_t)e * 128 + (size_t)(cc & 7) * 16;
                u32x4 wu, wv;
#pragma unroll
                for (int h4 = 0; h4 < 4; ++h4) { wu[h4] = q8pack(uv[4 * q + h4][0], uv[4 * q + h4][1], uv[4 * q + h4][2], uv[4 * q + h4][3], iu); wv[h4] = q8pack(vv[4 * q + h4][0], vv[4 * q + h4][1], vv[4 * q + h4][2], vv[4 * q + h4][3], iv); }
                *(u32x4*)(U8 + dst) = wu; *(u32x4*)(V8 + dst) = wv; }
            if (lane == 0) { SU[e] = au * (1.f / 127.f); SV[e] = av * (1.f / 127.f); }
        }
    }
    SEAM(4);
    if (IN(5)) {
        pg8::Gemm g{(const bf16_t*)(ws + WS_M8), (const bf16_t*)(ws + WS_WOUT), T, 2048, 1024, 1024, 1024}; pg8::StaticOrder S; S.init(T, 2048, G, bx);
        EpiOutI E{x, (bf16_t*)(ws + WS_X1B), (float*)(ws + WS_RSQ1), (const float*)(ws + WS_SM), (const float*)(ws + WS_SWO)};
        pg8::gemm_phase<EpiOutI, true>(lds, g, S, E);
    }
    SEAM(5);
    if (IN(6)) {
        for (int un = vcu; un < 256; un += G) x1_quant_unit(ws, un);
        if (lo == 0 && hi_ph == NPH) xcd_barrier(xbar);
        pg8::Gemm g{(const bf16_t*)(ws + WS_X8), (const bf16_t*)(ws + WS_WPQ), T, 2048, 1024, 1024, 1024}; pg8::StaticOrder S; S.init(T, 2048, G, bx);
        EpiQPi E{(bf16_t*)(ws + WS_QP), (const float*)(ws + WS_SX), (const float*)(ws + WS_SWP)};
        pg8::gemm_phase<EpiQPi, true>(lds, g, S, E);
    }
    SEAM(6);
    if (IN(7)) {
        for (int un = vcu; un < 256; un += G) { peer_unit(lds, ws, out, un); peer_fused_rounds(lds, ws, out, un); __syncthreads(); }
    }
#undef IN
#undef SEAM
}

extern "C" void kernel_launch(void* const* d_in, const int* in_sizes, int n_in, void* d_out, int out_size, void* d_ws, size_t ws_size, hipStream_t stream) {
    static int grid = 0;
    if (grid == 0) {
        if (n_in != 22 || out_size != T * DM || ws_size < WS_END) { fprintf(stderr, "kernel_launch: unexpected problem (n_in %d out %d ws %zu)\n", n_in, out_size, ws_size); grid = -1; return; }
        int dev = 0, cus = 0, per_cu = 0;
        (void)hipGetDevice(&dev); (void)hipDeviceGetAttribute(&cus, hipDeviceAttributeMultiprocessorCount, dev);
        if (hipFuncSetAttribute((const void*)mk_fwd, hipFuncAttributeMaxDynamicSharedMemorySize, LDS_BYTES) != hipSuccess) { fprintf(stderr, "kernel_launch: hipFuncSetAttribute failed\n"); grid = -1; return; }
        if (hipOccupancyMaxActiveBlocksPerMultiprocessor(&per_cu, (const void*)mk_fwd, 512, LDS_BYTES) != hipSuccess || per_cu < 1) { fprintf(stderr, "kernel_launch: occupancy query says %d\n", per_cu); (void)hipGetLastError(); grid = -1; return; }
        grid = cus;
        fprintf(stderr, "kernel_launch: grid %d (per_cu %d)\n", grid, per_cu);
    }
    if (grid < 0) return;
    if (hipMemsetAsync(d_ws, 0, 16384, stream) != hipSuccess) { fprintf(stderr, "kernel_launch: memset failed\n"); return; }
    Args a{};
    for (int i = 0; i < 22; ++i) a.in[i] = d_in[i];
    a.out = (float*)d_out; a.ws = (unsigned char*)d_ws;
#if MK_N_LAUNCHES == 1
    a.ph_lo = 0; a.ph_hi = NPH;
    void* kargs[] = {&a};
    hipError_t e = hipLaunchCooperativeKernel((const void*)mk_fwd, dim3(grid), dim3(512), kargs, LDS_BYTES, stream);
    if (e != hipSuccess) fprintf(stderr, "kernel_launch: cooperative launch failed: %s\n", hipGetErrorString(e));
#else
    for (int p = 0; p < NPH; ++p) { a.ph_lo = p; a.ph_hi = p + 1; hipLaunchKernelGGL(mk_fwd, dim3(grid), dim3(512), LDS_BYTES, stream, a); }
#endif
}
```

```cpp
#include <hip/hip_runtime.h>
#include <hip/hip_cooperative_groups.h>
#include <cstdio>
#include <cstdint>
namespace cg = cooperative_groups;

#ifndef MK_N_LAUNCHES
#define MK_N_LAUNCHES 1
#endif

#define LAS __attribute__((address_space(3)))
typedef unsigned short bf16_t;
typedef short bf16x8 __attribute__((ext_vector_type(8)));
typedef short s16x4 __attribute__((ext_vector_type(4)));
typedef float f32x4 __attribute__((ext_vector_type(4)));
typedef int i32x4 __attribute__((ext_vector_type(4)));
typedef float f32x16 __attribute__((ext_vector_type(16)));
typedef unsigned u32x4 __attribute__((ext_vector_type(4)));
typedef unsigned u32x2 __attribute__((ext_vector_type(2)));
typedef float f32x2_t __attribute__((ext_vector_type(2)));
typedef __bf16 bf16x2_t __attribute__((ext_vector_type(2)));
typedef short v4i16_t __attribute__((ext_vector_type(4)));

constexpr int T = 16384, DM = 2048, NB = 8, SEQ = 2048;
constexpr float EPS = 1e-6f;
constexpr int N1 = 11520;
constexpr float QSCALE = 0.07216878364870322f * 1.4426950408889634f;

constexpr size_t MiB = 1u << 20;
constexpr size_t WS_WUQ = 1 * MiB, WS_WUKV = 4 * MiB, WS_WOUT = 8 * MiB, WS_WPQ = 16 * MiB, WS_KEYS = 24 * MiB, WS_ROPE = 25 * MiB;
constexpr size_t WS_RSQ0 = 29 * MiB, WS_RSQ1 = 30 * MiB, WS_DEC = 32 * MiB, WS_SSQ = 33 * MiB, WS_KPE = 35 * MiB;
constexpr size_t WS_WIN = 40 * MiB, WS_H = 85 * MiB;
constexpr size_t WS_QH = 40 * MiB;
constexpr size_t WS_X1B = 40 * MiB;
constexpr size_t WS_CQKV = 149 * MiB, WS_QG = 181 * MiB, WS_KG = 213 * MiB, WS_VG = 245 * MiB, WS_OG = 309 * MiB, WS_GA = 373 * MiB, WS_GB = 437 * MiB, WS_MISC = 501 * MiB;
constexpr size_t WS_UB = WS_OG, WS_VB = WS_OG + 32 * MiB, WS_QP = WS_VG;
constexpr size_t WS_ABUF = 138 * MiB;
constexpr size_t WS_WG8 = 40 * MiB;
constexpr size_t WS_PMAX = 37 * MiB, WS_SWG = 39 * MiB;
constexpr size_t WS_SM = 39 * MiB + 512 * 1024, WS_SWO = 39 * MiB + 768 * 1024, WS_PMAXO = 38 * MiB + 512 * 1024;
constexpr size_t WS_PMAXP = 38 * MiB + 768 * 1024, WS_SWP = 39 * MiB + 832 * 1024;
constexpr size_t WS_M8 = WS_QG;
constexpr size_t WS_END = 509 * MiB;
constexpr size_t WS_SELT = WS_CQKV, WS_GATE = WS_CQKV + 4 * MiB, WS_R1G = WS_CQKV + 20 * MiB, WS_ACTP = WS_GA;
constexpr size_t WS_SX = WS_CQKV + 21 * MiB, WS_SU = 39 * MiB + 896 * 1024, WS_SV = 39 * MiB + 960 * 1024, WS_SW = WS_CQKV + 24 * MiB, WS_W8 = WS_CQKV + 25 * MiB;
constexpr size_t WS_X8 = WS_KG;
constexpr int NPH = 8;

constexpr int LDS_BYTES = 163840;
constexpr int XCH_OFF = 132096;

__device__ __forceinline__ unsigned pkbf(float lo, float hi) { f32x2_t v = {lo, hi}; bf16x2_t b = __builtin_convertvector(v, bf16x2_t); return __builtin_bit_cast(unsigned, b); }
__device__ __forceinline__ float bf_lo(unsigned u) { return __uint_as_float(u << 16); }
__device__ __forceinline__ float bf_hi(unsigned u) { return __uint_as_float(u & 0xffff0000u); }
__device__ __forceinline__ float bf1(bf16_t u) { return __uint_as_float(((unsigned)u) << 16); }
__device__ __forceinline__ bf16_t f2bf(float f) { return (bf16_t)(pkbf(f, 0.f) & 0xffffu); }
__device__ __forceinline__ float wave_sum(float v) {
#pragma unroll
    for (int o = 1; o < 64; o <<= 1) v += __shfl_xor(v, o);
    return v;
}
__device__ __forceinline__ float wave_max(float v) {
#pragma unroll
    for (int o = 1; o < 64; o <<= 1) v = fmaxf(v, __shfl_xor(v, o));
    return v;
}
__device__ __forceinline__ unsigned q8pack(float a, float b, float c, float d, float inv) {
    const int ia = (int)__builtin_rintf(a * inv), ib = (int)__builtin_rintf(b * inv), ic = (int)__builtin_rintf(c * inv), id = (int)__builtin_rintf(d * inv);
    return ((unsigned)ia & 0xffu) | (((unsigned)ib & 0xffu) << 8) | (((unsigned)ic & 0xffu) << 16) | ((unsigned)id << 24);
}
__device__ __forceinline__ float fast_sigmoid(float v) { return __builtin_amdgcn_rcpf(1.f + __builtin_amdgcn_exp2f(-1.4426950408889634f * v)); }

namespace pg8 {
constexpr int BM = 256, BK = 64, HALF = 128, HTB = HALF * BK * 2, STAGE_BYTES = 8 * HTB, NXCD = 8, WGM = 8;
__host__ __device__ __forceinline__ int lds_byte(int r, int c) { const int st = (r >> 4) * 2 + (c >> 5), rr = r & 15, cc = c & 31, ob = rr * 64 + cc * 2; return st * 1024 + (ob ^ (((ob >> 9) & 1) << 5)); }
__host__ __device__ __forceinline__ void stage_rc(int b, int& R, int& C) { const int st = b / 1024, sb = b % 1024, swz = sb ^ (((sb >> 9) & 1) << 5); R = (st >> 1) * 16 + swz / 64; C = (st & 1) * 32 + (swz % 64) / 2; }
__host__ __device__ __forceinline__ int perm32(int rho) { const int n = rho >> 4, i = rho & 15; return 8 * (i >> 2) + 4 * n + (i & 3); }
struct Unit { int pm, pn; };
struct Gemm { const bf16_t* A; const bf16_t* Bt; int M, N, K, lda, ldb; };
struct StaticOrder {
    int nM, nN, nwg, G, c;
    __device__ void init(int M, int N, int G_, int c_) { nM = M / BM; nN = N / BM; nwg = nM * nN; G = G_; c = c_; }
    __device__ bool next(int i, Unit& u) const {
        const long L = (long)i * G + c; if (L >= nwg) return false;
        int wgid = (int)L; { const int q = nwg / NXCD, r = nwg % NXCD, xcd = wgid % NXCD, off = wgid / NXCD; wgid = (xcd < r ? xcd * (q + 1) : r * (q + 1) + (xcd - r) * q) + off; }
        const int nig = WGM * nN, gid = wgid / nig, fm = gid * WGM, gsz = (nM - fm) < WGM ? (nM - fm) : WGM;
        u.pm = fm + ((wgid % nig) % gsz); u.pn = (wgid % nig) / gsz; return true;
    }
};
__device__ __forceinline__ f32x4 mma16(bf16x8 a, bf16x8 b, f32x4 c) { return __builtin_amdgcn_mfma_f32_16x16x32_bf16(a, b, c, 0, 0, 0); }
__device__ __forceinline__ i32x4 mma16(bf16x8 a, bf16x8 b, i32x4 c) { return __builtin_amdgcn_mfma_i32_16x16x64_i8(__builtin_bit_cast(i32x4, a), __builtin_bit_cast(i32x4, b), c, 0, 0, 0); }
template <class Epi, bool ALIGN_EPI>
__device__ __forceinline__ void gemm_phase(LAS unsigned char* lds, const Gemm g, const StaticOrder& S, const Epi& E) {
    const int tid = threadIdx.x, wid = __builtin_amdgcn_readfirstlane(tid >> 6), lane = tid & 63, wr = wid >> 2, wc = wid & 3, fr = lane & 15, fq = lane >> 4;
    const int K = g.K, nt = K / BK;
    unsigned voffA[2], voffB[2];
#pragma unroll
    for (int i = 0; i < 2; ++i) { int R, C; stage_rc(tid * 16 + i * 8192, R, C); const int Rb = Epi::PERM ? ((R & ~31) + perm32(R & 31)) : R;
        voffA[i] = (unsigned)(R * g.lda + C) * 2u; voffB[i] = (unsigned)(Rb * g.ldb + C) * 2u; }
    const size_t kstep = (size_t)(BK * 2);
    const size_t hstepA = (size_t)HALF * g.lda * 2, hstepB = (size_t)HALF * g.ldb * 2;
    const size_t tstepA = 2 * hstepA, tstepB = 2 * hstepB;
    const unsigned ldsw = (unsigned)wid * 1024u;
    const int aoff = lds_byte(wr * 64 + fr, fq * 8), boff = lds_byte(wc * 32 + fr, fq * 8);
#define PG8_SA(b, h) (((b) * 2 + (h)) * HTB)
#define PG8_SB(b, h) ((4 + (b) * 2 + (h)) * HTB)
#define PG8_STAGE(bufoff, gbase, voff) do { _Pragma("unroll") for (int _i = 0; _i < 2; ++_i) \
        __builtin_amdgcn_global_load_lds((const unsigned*)((const char*)(gbase) + (voff)[_i]), (LAS unsigned*)(lds + (bufoff) + ldsw + _i * 8192), 16, 0, 0); } while (0)
#define PG8_LDA(dst, b, h) do { _Pragma("unroll") for (int m = 0; m < 4; ++m) _Pragma("unroll") for (int k = 0; k < 2; ++k) dst[m][k] = *(const LAS bf16x8*)(lds + PG8_SA(b, h) + aoff + m * 2048 + k * 1024); } while (0)
#define PG8_LDB(dst, b, h) do { _Pragma("unroll") for (int n = 0; n < 2; ++n) _Pragma("unroll") for (int k = 0; k < 2; ++k) dst[n][k] = *(const LAS bf16x8*)(lds + PG8_SB(b, h) + boff + n * 2048 + k * 1024); } while (0)
#define PG8_MMA(ai, bj, At, Bt) do { __builtin_amdgcn_s_setprio(1); _Pragma("unroll") for (int m = 0; m < 4; ++m) _Pragma("unroll") for (int n = 0; n < 2; ++n) _Pragma("unroll") for (int k = 0; k < 2; ++k) \
        acc[ai][bj][m][n] = mma16(Bt[n][k], At[m][k], acc[ai][bj][m][n]); __builtin_amdgcn_s_setprio(0); } while (0)
#define PG8_WAIT_V(n) asm volatile("s_waitcnt vmcnt(" #n ")" ::: "memory")
#define PG8_WAIT_L(n) asm volatile("s_waitcnt lgkmcnt(" #n ")" ::: "memory")
#define PG8_BAR __builtin_amdgcn_s_barrier()
#define PG8_SCHED __builtin_amdgcn_sched_barrier(0)
    Unit cur, nxt; int ui = 0;
    if (!S.next(0, cur)) return;
    typename Epi::acc_t acc[2][2][4][2];
    E.init(acc, cur, wr, wc, fr, fq);
    bf16x8 At[4][2], B0[2][2], B1[2][2];
    const char* cA = (const char*)g.A + (size_t)cur.pm * tstepA; const char* cB = (const char*)g.Bt + (size_t)cur.pn * tstepB;
    PG8_STAGE(PG8_SB(0, 0), cB, voffB); PG8_STAGE(PG8_SB(0, 1), cB + hstepB, voffB); PG8_STAGE(PG8_SA(0, 0), cA, voffA); PG8_STAGE(PG8_SA(0, 1), cA + hstepA, voffA);
    if (wr == 1) PG8_BAR;
    PG8_WAIT_V(2); PG8_BAR;
    PG8_STAGE(PG8_SB(1, 0), cB + kstep, voffB); PG8_STAGE(PG8_SA(1, 0), cA + kstep, voffA); PG8_STAGE(PG8_SB(1, 1), cB + hstepB + kstep, voffB);
    PG8_WAIT_V(6); PG8_BAR;
    for (;;) {
        const bool has_next = S.next(ui + 1, nxt);
        const char* nA = has_next ? (const char*)g.A + (size_t)nxt.pm * tstepA : cA; const char* nB = has_next ? (const char*)g.Bt + (size_t)nxt.pn * tstepB : cB;
        for (int t = 0; t < nt; t += 2) {
            const bool last = (t == nt - 2);
            const char* a1 = cA + (size_t)(t + 1) * kstep;
            const char* a2 = last ? nA : cA + (size_t)(t + 2) * kstep; const char* b2 = last ? nB : cB + (size_t)(t + 2) * kstep;
            const char* a3 = a2 + kstep; const char* b3 = b2 + kstep;
            PG8_LDB(B0, 0, 0); PG8_LDB(B1, 0, 1); PG8_SCHED; PG8_LDA(At, 0, 0); PG8_STAGE(PG8_SA(1, 1), a1 + hstepA, voffA);
            PG8_WAIT_V(8); PG8_WAIT_L(0); PG8_BAR; PG8_MMA(0, 0, At, B0); PG8_MMA(0, 1, At, B1); PG8_BAR; PG8_SCHED;
            PG8_LDA(At, 0, 1); PG8_STAGE(PG8_SB(0, 0), b2, voffB); PG8_STAGE(PG8_SB(0, 1), b2 + hstepB, voffB); PG8_STAGE(PG8_SA(0, 0), a2, voffA);
            PG8_WAIT_V(8); PG8_WAIT_L(0); PG8_BAR; PG8_MMA(1, 0, At, B0); PG8_MMA(1, 1, At, B1); PG8_BAR; PG8_SCHED;
            PG8_LDB(B0, 1, 0); PG8_LDB(B1, 1, 1); PG8_SCHED; PG8_LDA(At, 1, 0); PG8_STAGE(PG8_SA(0, 1), a2 + hstepA, voffA);
            PG8_WAIT_V(8); PG8_WAIT_L(0); PG8_BAR; PG8_MMA(0, 0, At, B0); PG8_MMA(0, 1, At, B1); PG8_BAR; PG8_SCHED;
            PG8_LDA(At, 1, 1); PG8_STAGE(PG8_SB(1, 0), b3, voffB); PG8_STAGE(PG8_SB(1, 1), b3 + hstepB, voffB); PG8_STAGE(PG8_SA(1, 0), a3, voffA);
            PG8_WAIT_V(8); PG8_WAIT_L(0); PG8_BAR; PG8_MMA(1, 0, At, B0); PG8_MMA(1, 1, At, B1); PG8_BAR; PG8_SCHED;
        }
        if constexpr (ALIGN_EPI) { if (wr == 0) PG8_BAR; }
        E(acc, cur, wr, wc, fr, fq);
        if (!has_next) break;
        E.init(acc, nxt, wr, wc, fr, fq);
        cur = nxt; cA = nA; cB = nB; ++ui;
        if constexpr (ALIGN_EPI) { if (wr == 1) PG8_BAR; }
    }
    PG8_WAIT_V(0);
    if constexpr (!ALIGN_EPI) { if (wr == 0) PG8_BAR; }
    PG8_BAR;
#undef PG8_SA
#undef PG8_SB
#undef PG8_STAGE
#undef PG8_LDA
#undef PG8_LDB
#undef PG8_MMA
#undef PG8_WAIT_V
#undef PG8_WAIT_L
#undef PG8_BAR
#undef PG8_SCHED
}
}
using pg8::Unit;

#define RAW_BAR() asm volatile("s_waitcnt lgkmcnt(0)\n\ts_barrier" ::: "memory")

struct EpiG1 {
    static constexpr bool PERM = true;
    typedef f32x4 acc_t;
    __device__ __forceinline__ void init(f32x4 (&acc)[2][2][4][2], const Unit&, int, int, int, int) const {
#pragma unroll
        for (int a = 0; a < 2; ++a)
#pragma unroll
            for (int b = 0; b < 2; ++b)
#pragma unroll
                for (int m = 0; m < 4; ++m)
#pragma unroll
                    for (int n = 0; n < 2; ++n) acc[a][b][m][n] = (f32x4){0.f, 0.f, 0.f, 0.f};
    }
    unsigned char* ws; const float* bgate; float* rsq0;
    __device__ __forceinline__ void operator()(const f32x4 (&acc)[2][2][4][2], const Unit& u, int wr, int wc, int fr, int fq) const {
        asm volatile("" : "+v"(fr), "+v"(fq));
        const int pn = u.pn; bf16_t* base; int ld, ct, act = 0; const float* bias = nullptr;
        if (pn < 4)       { base = (bf16_t*)(ws + WS_CQKV); ld = 1024; ct = pn; }
        else if (pn < 8)  { base = (bf16_t*)(ws + WS_QG);   ld = 1024; ct = pn - 4; }
        else if (pn < 12) { base = (bf16_t*)(ws + WS_KG);   ld = 1024; ct = pn - 8; }
        else if (pn < 20) { base = (bf16_t*)(ws + WS_VG);   ld = 2048; ct = pn - 12; }
        else              { base = (bf16_t*)(ws + WS_MISC); ld = 256;  ct = 0; }
        const int col0 = ct * 256 + wc * 32 + 8 * fq;
        f32x4 bv[2][2];
#pragma unroll
        for (int bj = 0; bj < 2; ++bj)
#pragma unroll
            for (int n = 0; n < 2; ++n) bv[bj][n] = bias ? *(const f32x4*)(bias + col0 + bj * 128 + 4 * n) : (f32x4){0.f, 0.f, 0.f, 0.f};
#pragma unroll
        for (int ai = 0; ai < 2; ++ai)
#pragma unroll
            for (int m = 0; m < 4; ++m) {
                const int row = u.pm * 256 + ai * 128 + wr * 64 + m * 16 + fr;
                bf16_t* rowp = base + (size_t)row * ld + col0;
                float ss = 0.f;
#pragma unroll
                for (int bj = 0; bj < 2; ++bj) {
                    f32x4 v0 = acc[ai][bj][m][0] + bv[bj][0], v1 = acc[ai][bj][m][1] + bv[bj][1];
                    if (act == 1) {
#pragma unroll
                        for (int j = 0; j < 4; ++j) { v0[j] = v0[j] * fast_sigmoid(v0[j]); v1[j] = v1[j] * fast_sigmoid(v1[j]); }
                    } else if (act == 2) {
#pragma unroll
                        for (int j = 0; j < 4; ++j) { v0[j] = fast_sigmoid(v0[j]); v1[j] = fast_sigmoid(v1[j]); }
                    }
#pragma unroll
                    for (int j = 0; j < 4; ++j) ss += v0[j] * v0[j] + v1[j] * v1[j];
                    u32x4 w; w.x = pkbf(v0[0], v0[1]); w.y = pkbf(v0[2], v0[3]); w.z = pkbf(v1[0], v1[1]); w.w = pkbf(v1[2], v1[3]);
                    *(u32x4*)(rowp + bj * 128) = w;
                }
                if (pn < 4) {
                    ss += __shfl_xor(ss, 16); ss += __shfl_xor(ss, 32);
                    if (fq == 0) rsq0[((size_t)row * 4 + pn) * 4 + wc] = ss;
                }
            }
    }
};

struct EpiG1i {
    static constexpr bool PERM = true;
    typedef i32x4 acc_t;
    __device__ __forceinline__ void init(i32x4 (&acc)[2][2][4][2], const Unit&, int, int, int, int) const {
#pragma unroll
        for (int a = 0; a < 2; ++a)
#pragma unroll
            for (int b = 0; b < 2; ++b)
#pragma unroll
                for (int m = 0; m < 4; ++m)
#pragma unroll
                    for (int n = 0; n < 2; ++n) acc[a][b][m][n] = (i32x4){0, 0, 0, 0};
    }
    unsigned char* ws; const float* bgate; const float* sh; const float* swg; float* rsq0;
    __device__ __forceinline__ void operator()(const i32x4 (&acc)[2][2][4][2], const Unit& u, int wr, int wc, int fr, int fq) const {
        asm volatile("" : "+v"(fr), "+v"(fq));
        const int pn = u.pn; bf16_t* base; int ld, ct, act = 0; const float* bias = nullptr;
        if (pn < 4)       { base = (bf16_t*)(ws + WS_CQKV); ld = 1024; ct = pn; }
        else if (pn < 8)  { base = (bf16_t*)(ws + WS_QG);   ld = 1024; ct = pn - 4; }
        else if (pn < 12) { base = (bf16_t*)(ws + WS_KG);   ld = 1024; ct = pn - 8; }
        else if (pn < 20) { base = (bf16_t*)(ws + WS_VG);   ld = 2048; ct = pn - 12; }
        else if (pn < 28) { base = (bf16_t*)(ws + WS_GA);   ld = 2048; ct = pn - 20; act = 2; bias = bgate; }
        else if (pn < 44) { base = (bf16_t*)(ws + WS_GB);   ld = 2048; ct = 0; act = 3; bias = bgate + 2048; }
        else              { base = (bf16_t*)(ws + WS_MISC); ld = 256;  ct = 0; }
        const int col0 = (act == 3) ? (pn - 28) * 128 + wc * 32 + 8 * fq : ct * 256 + wc * 32 + 8 * fq, colg = pn * 256 + wc * 32 + 8 * fq;
        f32x4 bv[2][2], sw[2][2];
#pragma unroll
        for (int bj = 0; bj < 2; ++bj)
#pragma unroll
            for (int n = 0; n < 2; ++n) { bv[bj][n] = (bias && !(act == 3 && bj == 0)) ? *(const f32x4*)(bias + col0 + (act == 3 ? 0 : bj * 128) + 4 * n) : (f32x4){0.f, 0.f, 0.f, 0.f}; sw[bj][n] = *(const f32x4*)(swg + colg + bj * 128 + 4 * n);
                if (act == 2 || (act == 3 && bj == 1)) { bv[bj][n] = bv[bj][n] * -1.4426950408889634f; sw[bj][n] = sw[bj][n] * -1.4426950408889634f; } }
        float shv[2][4];
#pragma unroll
        for (int ai = 0; ai < 2; ++ai)
#pragma unroll
            for (int m = 0; m < 4; ++m) shv[ai][m] = sh[u.pm * 256 + ai * 128 + wr * 64 + m * 16 + fr];
#pragma unroll
        for (int ai = 0; ai < 2; ++ai)
#pragma unroll
            for (int m = 0; m < 4; ++m) {
                const int row = u.pm * 256 + ai * 128 + wr * 64 + m * 16 + fr;
                const float shr = shv[ai][m];
                bf16_t* rowp = base + (size_t)row * ld + col0;
                float ss = 0.f;
                if (act == 3) {
                    f32x4 a0, a1, g0, g1;
#pragma unroll
                    for (int j = 0; j < 4; ++j) { a0[j] = (float)acc[ai][0][m][0][j] * shr * sw[0][0][j]; a1[j] = (float)acc[ai][0][m][1][j] * shr * sw[0][1][j];
                        g0[j] = (float)acc[ai][1][m][0][j] * shr * sw[1][0][j] + bv[1][0][j]; g1[j] = (float)acc[ai][1][m][1][j] * shr * sw[1][1][j] + bv[1][1][j]; }
#pragma unroll
                    for (int j = 0; j < 4; ++j) {
                        a0[j] = a0[j] * __builtin_amdgcn_rcpf((1.f + __builtin_amdgcn_exp2f(-1.4426950408889634f * a0[j])) * (1.f + __builtin_amdgcn_exp2f(g0[j])));
                        a1[j] = a1[j] * __builtin_amdgcn_rcpf((1.f + __builtin_amdgcn_exp2f(-1.4426950408889634f * a1[j])) * (1.f + __builtin_amdgcn_exp2f(g1[j]))); }
                    u32x4 w; w.x = pkbf(a0[0], a0[1]); w.y = pkbf(a0[2], a0[3]); w.z = pkbf(a1[0], a1[1]); w.w = pkbf(a1[2], a1[3]);
                    __builtin_nontemporal_store(w, (u32x4*)rowp);
                } else
#pragma unroll
                for (int bj = 0; bj < 2; ++bj) {
                    f32x4 v0, v1;
#pragma unroll
                    for (int j = 0; j < 4; ++j) { v0[j] = (float)acc[ai][bj][m][0][j] * shr * sw[bj][0][j] + bv[bj][0][j]; v1[j] = (float)acc[ai][bj][m][1][j] * shr * sw[bj][1][j] + bv[bj][1][j]; }
                    if (act == 2) {
#pragma unroll
                        for (int j = 0; j < 4; ++j) { v0[j] = __builtin_amdgcn_rcpf(1.f + __builtin_amdgcn_exp2f(v0[j])); v1[j] = __builtin_amdgcn_rcpf(1.f + __builtin_amdgcn_exp2f(v1[j])); }
                    } else if (pn < 4) {
#pragma unroll
                        for (int j = 0; j < 4; ++j) ss += v0[j] * v0[j] + v1[j] * v1[j];
                    }
                    u32x4 w; w.x = pkbf(v0[0], v0[1]); w.y = pkbf(v0[2], v0[3]); w.z = pkbf(v1[0], v1[1]); w.w = pkbf(v1[2], v1[3]);
                    __builtin_nontemporal_store(w, (u32x4*)(rowp + bj * 128));
                }
                if (pn < 4) {
                    ss += __shfl_xor(ss, 16); ss += __shfl_xor(ss, 32);
                    if (fq == 0) rsq0[((size_t)row * 4 + pn) * 4 + wc] = ss;
                }
            }
    }
};

template <int MODE> struct EpiUp {
    static constexpr bool PERM = true;
    typedef f32x4 acc_t;
    __device__ __forceinline__ void init(f32x4 (&acc)[2][2][4][2], const Unit&, int, int, int, int) const {
#pragma unroll
        for (int a = 0; a < 2; ++a)
#pragma unroll
            for (int b = 0; b < 2; ++b)
#pragma unroll
                for (int m = 0; m < 4; ++m)
#pragma unroll
                    for (int n = 0; n < 2; ++n) acc[a][b][m][n] = (f32x4){0.f, 0.f, 0.f, 0.f};
    }
    LAS unsigned char* lds; const float* rsq0; int rsq_off; const float* gn; const float* gr; const float* rope; bf16_t* out0; bf16_t* out1;
    __device__ __forceinline__ void operator()(const f32x4 (&acc)[2][2][4][2], const Unit& u, int wr, int wc, int fr, int fq) const {
        asm volatile("" : "+v"(fr), "+v"(fq));
        auto rcf = [&](int ai, int m) -> float {
            const int row = u.pm * 256 + ai * 128 + wr * 64 + m * 16 + fr;
            const f32x4 a = *(const f32x4*)(rsq0 + (size_t)row * 16 + rsq_off), b = *(const f32x4*)(rsq0 + (size_t)row * 16 + rsq_off + 4);
            const float s = (a[0] + a[1]) + (a[2] + a[3]) + (b[0] + b[1]) + (b[2] + b[3]);
            return __builtin_amdgcn_rsqf(s * (1.f / 512.f) + EPS);
        };
        const int pn = u.pn;
        if (pn < 8) {
            LAS float* X = (LAS float*)(lds + XCH_OFF);
#pragma unroll
            for (int ai = 0; ai < 2; ++ai)
#pragma unroll
                for (int m = 0; m < 4; ++m) {
                    const float rcv = rcf(ai, m);
#pragma unroll
                    for (int bj = 0; bj < 2; ++bj) {
                        float s = 0.f;
#pragma unroll
                        for (int n = 0; n < 2; ++n)
#pragma unroll
                            for (int j = 0; j < 4; ++j) { const float v = acc[ai][bj][m][n][j]; s += v * v; }
                        s *= rcv * rcv;
                        s += __shfl_xor(s, 16); s += __shfl_xor(s, 32);
                        if (fq == 0) X[((ai * 128 + wr * 64 + m * 16 + fr) * 2 + bj) * 4 + wc] = s;
                    }
                    asm volatile("" ::: "memory");
                }
            RAW_BAR();
            const int d0 = wc * 32 + 8 * fq;
            const f32x4 g0 = *(const f32x4*)(gn + d0), g1 = *(const f32x4*)(gn + d0 + 4);
#pragma unroll
            for (int ai = 0; ai < 2; ++ai)
#pragma unroll
                for (int m = 0; m < 4; ++m) {
                    const int rl = ai * 128 + wr * 64 + m * 16 + fr; const size_t row = (size_t)u.pm * 256 + rl;
                    const float rcv = rcf(ai, m);
#pragma unroll
                    for (int bj = 0; bj < 2; ++bj) {
                        const f32x4 t = *(const LAS f32x4*)(X + (rl * 2 + bj) * 4);
                        const float tot = (t[0] + t[1]) + (t[2] + t[3]);
                        float rs = __builtin_amdgcn_rsqf(tot * (1.f / 128.f) + EPS) * rcv;
                        if (MODE == 0) rs *= QSCALE;
                        const f32x4 v0 = acc[ai][bj][m][0] * rs * g0, v1 = acc[ai][bj][m][1] * rs * g1;
                        u32x4 w; w.x = pkbf(v0[0], v0[1]); w.y = pkbf(v0[2], v0[3]); w.z = pkbf(v1[0], v1[1]); w.w = pkbf(v1[2], v1[3]);
                        const int head = 2 * pn + bj;
                        if (MODE == 0) __builtin_nontemporal_store(w, (u32x4*)(out0 + row * 3072 + head * 192 + d0));
                        else           __builtin_nontemporal_store(w, (u32x4*)(out0 + row * 2048 + head * 128 + d0));
                    }
                    asm volatile("" ::: "memory");
                }
        } else if (MODE == 1) {
            const int d0 = wc * 32 + 8 * fq;
#pragma unroll
            for (int ai = 0; ai < 2; ++ai)
#pragma unroll
                for (int m = 0; m < 4; ++m) {
                    const size_t row = (size_t)u.pm * 256 + ai * 128 + wr * 64 + m * 16 + fr;
                    const float rcv = rcf(ai, m);
#pragma unroll
                    for (int bj = 0; bj < 2; ++bj) {
                        const f32x4 v0 = acc[ai][bj][m][0] * rcv, v1 = acc[ai][bj][m][1] * rcv;
                        u32x4 w; w.x = pkbf(v0[0], v0[1]); w.y = pkbf(v0[2], v0[3]); w.z = pkbf(v1[0], v1[1]); w.w = pkbf(v1[2], v1[3]);
                        const int head = 2 * (pn - 8) + bj;
                        __builtin_nontemporal_store(w, (u32x4*)(out1 + row * 2048 + head * 128 + d0));
                    }
                    asm volatile("" ::: "memory");
                }
        } else {
            const int head = 4 * (pn - 8) + wc;
#pragma unroll
            for (int ai = 0; ai < 2; ++ai)
#pragma unroll
                for (int m = 0; m < 4; ++m) {
                    const size_t row = (size_t)u.pm * 256 + ai * 128 + wr * 64 + m * 16 + fr;
                    const float rcv = rcf(ai, m);
                    float s = 0.f;
#pragma unroll
                    for (int bj = 0; bj < 2; ++bj)
#pragma unroll
                        for (int n = 0; n < 2; ++n)
#pragma unroll
                            for (int j = 0; j < 4; ++j) { const float v = acc[ai][bj][m][n][j]; s += v * v; }
                    s *= rcv * rcv;
                    s += __shfl_xor(s, 16); s += __shfl_xor(s, 32);
                    const float rs = __builtin_amdgcn_rsqf(s * (1.f / 64.f) + EPS) * rcv;
#pragma unroll
                    for (int bj = 0; bj < 2; ++bj) {
                        unsigned wv[4];
#pragma unroll
                        for (int n = 0; n < 2; ++n) {
                            const int i0 = 16 * bj + 4 * fq + 2 * n;
                            const f32x2_t cs = *(const f32x2_t*)(rope + row * 64 + i0), sn = *(const f32x2_t*)(rope + row * 64 + 32 + i0);
                            const f32x2_t ga = *(const f32x2_t*)(gr + i0), gb = *(const f32x2_t*)(gr + 32 + i0);
                            const f32x4 a = acc[ai][bj][m][n];
                            const float x1a = a[0] * rs * ga[0], x2a = a[1] * rs * gb[0], x1b = a[2] * rs * ga[1], x2b = a[3] * rs * gb[1];
                            const float o0 = (x1a * cs[0] - x2a * sn[0]) * QSCALE, o1 = (x2a * cs[0] + x1a * sn[0]) * QSCALE;
                            const float o2 = (x1b * cs[1] - x2b * sn[1]) * QSCALE, o3 = (x2b * cs[1] + x1b * sn[1]) * QSCALE;
                            wv[2 * n] = pkbf(o0, o1); wv[2 * n + 1] = pkbf(o2, o3);
                        }
                        u32x4 w; w.x = wv[0]; w.y = wv[1]; w.z = wv[2]; w.w = wv[3];
                        __builtin_nontemporal_store(w, (u32x4*)(out0 + row * 3072 + head * 192 + 128 + 32 * bj + 8 * fq));
                    }
                    asm volatile("" ::: "memory");
                }
        }
    }
};

struct EpiOut {
    static constexpr bool PERM = false;
    typedef f32x4 acc_t;
    const float* x; float* out; bf16_t* x1b; float* rsq1;
    __device__ __forceinline__ void init(f32x4 (&acc)[2][2][4][2], const Unit& u, int wr, int wc, int fr, int fq) const {
        asm volatile("" : "+v"(fr), "+v"(fq));
        const int col0 = u.pn * 256 + wc * 32 + 4 * fq;
#pragma unroll
        for (int ai = 0; ai < 2; ++ai)
#pragma unroll
            for (int m = 0; m < 4; ++m) { const size_t off = ((size_t)u.pm * 256 + ai * 128 + wr * 64 + m * 16 + fr) * 2048 + col0;
#pragma unroll
                for (int bj = 0; bj < 2; ++bj)
#pragma unroll
                    for (int n = 0; n < 2; ++n) acc[ai][bj][m][n] = *(const f32x4*)(x + off + bj * 128 + n * 16); }
    }
    __device__ __forceinline__ void operator()(const f32x4 (&acc)[2][2][4][2], const Unit& u, int wr, int wc, int fr, int fq) const {
        asm volatile("" : "+v"(fr), "+v"(fq));
        const int col0 = u.pn * 256 + wc * 32 + 4 * fq;
#pragma unroll
        for (int ai = 0; ai < 2; ++ai)
#pragma unroll
            for (int m = 0; m < 4; ++m) {
                const size_t row = (size_t)u.pm * 256 + ai * 128 + wr * 64 + m * 16 + fr; const size_t off = row * 2048 + col0;
                float ss = 0.f;
#pragma unroll
                for (int bj = 0; bj < 2; ++bj)
#pragma unroll
                    for (int n = 0; n < 2; ++n) {
                        const f32x4 v = acc[ai][bj][m][n];
                        *(f32x4*)(out + off + bj * 128 + n * 16) = v;
                        u32x2 w; w.x = pkbf(v[0], v[1]); w.y = pkbf(v[2], v[3]);
                        *(u32x2*)(x1b + off + bj * 128 + n * 16) = w;
                        ss += (v[0] * v[0] + v[1] * v[1]) + (v[2] * v[2] + v[3] * v[3]);
                    }
                ss += __shfl_xor(ss, 16); ss += __shfl_xor(ss, 32);
                if (fq == 0) rsq1[row * 32 + u.pn * 4 + wc] = ss;
            }
    }
};
struct EpiOutI {
    static constexpr bool PERM = true;
    typedef i32x4 acc_t;
    __device__ __forceinline__ void init(i32x4 (&acc)[2][2][4][2], const Unit&, int, int, int, int) const {
#pragma unroll
        for (int a = 0; a < 2; ++a)
#pragma unroll
            for (int b = 0; b < 2; ++b)
#pragma unroll
                for (int m = 0; m < 4; ++m)
#pragma unroll
                    for (int n = 0; n < 2; ++n) acc[a][b][m][n] = (i32x4){0, 0, 0, 0};
    }
    const float* x; bf16_t* x1b; float* rsq1; const float* sm; const float* swo;
    __device__ __forceinline__ void operator()(const i32x4 (&acc)[2][2][4][2], const Unit& u, int wr, int wc, int fr, int fq) const {
        asm volatile("" : "+v"(fr), "+v"(fq));
        const int col0 = u.pn * 256 + wc * 32 + 8 * fq;
        f32x4 sw[2][2];
#pragma unroll
        for (int bj = 0; bj < 2; ++bj)
#pragma unroll
            for (int n = 0; n < 2; ++n) sw[bj][n] = *(const f32x4*)(swo + col0 + bj * 128 + 4 * n);
#pragma unroll
        for (int ai = 0; ai < 2; ++ai)
#pragma unroll
            for (int m = 0; m < 4; ++m) {
                const size_t row = (size_t)u.pm * 256 + ai * 128 + wr * 64 + m * 16 + fr; const size_t off = row * 2048 + col0;
                const float smr = sm[row];
                f32x4 xv[2][2];
#pragma unroll
                for (int bj = 0; bj < 2; ++bj)
#pragma unroll
                    for (int n = 0; n < 2; ++n) xv[bj][n] = __builtin_nontemporal_load((const f32x4*)(x + off + bj * 128 + 4 * n));
                float ss = 0.f;
#pragma unroll
                for (int bj = 0; bj < 2; ++bj) {
                    f32x4 v0, v1;
#pragma unroll
                    for (int j = 0; j < 4; ++j) { v0[j] = xv[bj][0][j] + (float)acc[ai][bj][m][0][j] * smr * sw[bj][0][j]; v1[j] = xv[bj][1][j] + (float)acc[ai][bj][m][1][j] * smr * sw[bj][1][j]; }
                    u32x4 w; w.x = pkbf(v0[0], v0[1]); w.y = pkbf(v0[2], v0[3]); w.z = pkbf(v1[0], v1[1]); w.w = pkbf(v1[2], v1[3]);
                    *(u32x4*)(x1b + off + bj * 128) = w;
                    ss += ((v0[0] * v0[0] + v0[1] * v0[1]) + (v0[2] * v0[2] + v0[3] * v0[3])) + ((v1[0] * v1[0] + v1[1] * v1[1]) + (v1[2] * v1[2] + v1[3] * v1[3]));
                }
                ss += __shfl_xor(ss, 16); ss += __shfl_xor(ss, 32);
                if (fq == 0) rsq1[row * 32 + u.pn * 4 + wc] = ss;
                if (m & 1) asm volatile("" ::: "memory");
            }
    }
};
struct EpiQP {
    static constexpr bool PERM = true;
    typedef f32x4 acc_t;
    __device__ __forceinline__ void init(f32x4 (&acc)[2][2][4][2], const Unit&, int, int, int, int) const {
#pragma unroll
        for (int a = 0; a < 2; ++a)
#pragma unroll
            for (int b = 0; b < 2; ++b)
#pragma unroll
                for (int m = 0; m < 4; ++m)
#pragma unroll
                    for (int n = 0; n < 2; ++n) acc[a][b][m][n] = (f32x4){0.f, 0.f, 0.f, 0.f};
    }
    bf16_t* qp;
    __device__ __forceinline__ void operator()(const f32x4 (&acc)[2][2][4][2], const Unit& u, int wr, int wc, int fr, int fq) const {
        asm volatile("" : "+v"(fr), "+v"(fq));
        const int col0 = u.pn * 256 + wc * 32 + 8 * fq;
#pragma unroll
        for (int ai = 0; ai < 2; ++ai)
#pragma unroll
            for (int m = 0; m < 4; ++m) {
                const size_t row = (size_t)u.pm * 256 + ai * 128 + wr * 64 + m * 16 + fr;
#pragma unroll
                for (int bj = 0; bj < 2; ++bj) {
                    const f32x4 v0 = acc[ai][bj][m][0], v1 = acc[ai][bj][m][1];
                    u32x4 w; w.x = pkbf(v0[0], v0[1]); w.y = pkbf(v0[2], v0[3]); w.z = pkbf(v1[0], v1[1]); w.w = pkbf(v1[2], v1[3]);
                    *(u32x4*)(qp + row * 2048 + col0 + bj * 128) = w;
                }
            }
    }
};

struct EpiQPi {
    static constexpr bool PERM = true;
    typedef i32x4 acc_t;
    __device__ __forceinline__ void init(i32x4 (&acc)[2][2][4][2], const Unit&, int, int, int, int) const {
#pragma unroll
        for (int a = 0; a < 2; ++a)
#pragma unroll
            for (int b = 0; b < 2; ++b)
#pragma unroll
                for (int m = 0; m < 4; ++m)
#pragma unroll
                    for (int n = 0; n < 2; ++n) acc[a][b][m][n] = (i32x4){0, 0, 0, 0};
    }
    bf16_t* qp; const float* sx; const float* swp;
    __device__ __forceinline__ void operator()(const i32x4 (&acc)[2][2][4][2], const Unit& u, int wr, int wc, int fr, int fq) const {
        asm volatile("" : "+v"(fr), "+v"(fq));
        const int col0 = u.pn * 256 + wc * 32 + 8 * fq;
        f32x4 sw[2][2];
#pragma unroll
        for (int bj = 0; bj < 2; ++bj)
#pragma unroll
            for (int n = 0; n < 2; ++n) sw[bj][n] = *(const f32x4*)(swp + col0 + bj * 128 + 4 * n);
#pragma unroll
        for (int ai = 0; ai < 2; ++ai)
#pragma unroll
            for (int m = 0; m < 4; ++m) {
                const size_t row = (size_t)u.pm * 256 + ai * 128 + wr * 64 + m * 16 + fr; const float sxr = sx[row];
#pragma unroll
                for (int bj = 0; bj < 2; ++bj) {
                    f32x4 v0, v1;
#pragma unroll
                    for (int j = 0; j < 4; ++j) { v0[j] = (float)acc[ai][bj][m][0][j] * sxr * sw[bj][0][j]; v1[j] = (float)acc[ai][bj][m][1][j] * sxr * sw[bj][1][j]; }
                    u32x4 w; w.x = pkbf(v0[0], v0[1]); w.y = pkbf(v0[2], v0[3]); w.z = pkbf(v1[0], v1[1]); w.w = pkbf(v1[2], v1[3]);
                    __builtin_nontemporal_store(w, (u32x4*)(qp + row * 2048 + col0 + bj * 128));
                }
            }
    }
};

template <class CM>
__device__ __forceinline__ void p0_transpose_item(const float* W, int ldw, int K, int nblk, bf16_t* WT, LAS float* scr, int item, int lane, const CM& colmap, const float* kscale) {
    const int kb = item / nblk, nb = item % nblk, k0 = 64 * kb, n0 = 32 * nb;
    const int src = colmap(n0 + (lane & 31));
    float vv[32];
#pragma unroll
    for (int i = 0; i < 32; ++i) { const int kk = 2 * i + (lane >> 5); vv[i] = (src >= 0) ? W[(size_t)(k0 + kk) * ldw + src] : 0.f; }
    if (kscale) {
#pragma unroll
        for (int i = 0; i < 32; ++i) vv[i] *= kscale[k0 + 2 * i + (lane >> 5)];
    }
#pragma unroll
    for (int i = 0; i < 32; ++i) scr[(2 * i + (lane >> 5)) * 33 + (lane & 31)] = vv[i];
    asm volatile("s_waitcnt lgkmcnt(0)" ::: "memory");
    const int c = lane & 7;
#pragma unroll
    for (int j = 0; j < 4; ++j) { const int n = (lane >> 3) + 8 * j; const LAS float* s = scr + (8 * c) * 33 + n;
        u32x4 o; o.x = pkbf(s[0 * 33], s[1 * 33]); o.y = pkbf(s[2 * 33], s[3 * 33]); o.z = pkbf(s[4 * 33], s[5 * 33]); o.w = pkbf(s[6 * 33], s[7 * 33]);
        *(u32x4*)(WT + (size_t)(n0 + n) * K + k0 + 8 * c) = o; }
    asm volatile("s_waitcnt lgkmcnt(0)" ::: "memory");
}
template <class CM>
__device__ __forceinline__ void p0_transpose_item64(const float* W, int ldw, int K, int nblk, bf16_t* WT, LAS float* scr, int item, int lane, const CM& colmap, const float* kscale) {
    const int kb = item / nblk, nb = item % nblk, k0 = 64 * kb, n0 = 64 * nb;
    const int c4 = lane & 15, rr = lane >> 4;
    const int src = colmap(n0 + 4 * c4);
    f32x4 vv[16];
#pragma unroll
    for (int i = 0; i < 16; ++i) { const int kk = 4 * i + rr; vv[i] = (src >= 0) ? *(const f32x4*)(W + (size_t)(k0 + kk) * ldw + src) : (f32x4){0.f, 0.f, 0.f, 0.f}; }
    if (kscale) {
#pragma unroll
        for (int i = 0; i < 16; ++i) vv[i] = vv[i] * kscale[k0 + 4 * i + rr];
    }
#pragma unroll
    for (int i = 0; i < 16; ++i) { LAS float* d = scr + (4 * i + rr) * 65 + 4 * c4; d[0] = vv[i][0]; d[1] = vv[i][1]; d[2] = vv[i][2]; d[3] = vv[i][3]; }
    asm volatile("s_waitcnt lgkmcnt(0)" ::: "memory");
    const int c = lane & 7;
#pragma unroll
    for (int j = 0; j < 8; ++j) { const int n = (lane >> 3) + 8 * j; const LAS float* sp = scr + (8 * c) * 65 + n;
        u32x4 o; o.x = pkbf(sp[0 * 65], sp[1 * 65]); o.y = pkbf(sp[2 * 65], sp[3 * 65]); o.z = pkbf(sp[4 * 65], sp[5 * 65]); o.w = pkbf(sp[6 * 65], sp[7 * 65]);
        *(u32x4*)(WT + (size_t)(n0 + n) * K + k0 + 8 * c) = o; }
    asm volatile("s_waitcnt lgkmcnt(0)" ::: "memory");
}
__device__ __forceinline__ int cm_win(int n) { if (n < 1024) return n; if (n < 5120) return n + 64; if (n < 7168) return n + 2048 + 80;
    if (n < 11264) { const int q = n - 7168, t = q >> 8, r = q & 255; return ((r < 128) ? 5120 + 128 * t + r : 9216 + 128 * t + (r - 128)) + 80; }
    if (n < 11328) return 1024 + (n - 11264); if (n < 11344) return 5184 + (n - 11328); return -1; }
template <bool WIN> __device__ __forceinline__ void p0_gate_colmax_item(const float* W, int ldw, int nblk, float* PMAX, int item, int lane, const float* kscale = nullptr) {
    const int kb = item / nblk, nb = item % nblk, k0 = 64 * kb, n0 = 64 * nb, c4 = lane & 15, rr = lane >> 4, ncol = 64 * nblk;
    const int src = WIN ? cm_win(n0 + 4 * c4) : n0 + 4 * c4;
    f32x4 mx = (f32x4){0.f, 0.f, 0.f, 0.f};
#pragma unroll
    for (int i = 0; i < 16; ++i) { const f32x4 v = ((src >= 0) ? *(const f32x4*)(W + (size_t)(k0 + 4 * i + rr) * ldw + src) : (f32x4){0.f, 0.f, 0.f, 0.f}) * (kscale ? kscale[k0 + 4 * i + rr] : 1.f);
        mx[0] = fmaxf(mx[0], fabsf(v[0])); mx[1] = fmaxf(mx[1], fabsf(v[1])); mx[2] = fmaxf(mx[2], fabsf(v[2])); mx[3] = fmaxf(mx[3], fabsf(v[3])); }
#pragma unroll
    for (int j = 0; j < 4; ++j) { mx[j] = fmaxf(mx[j], __shfl_xor(mx[j], 16)); mx[j] = fmaxf(mx[j], __shfl_xor(mx[j], 32)); }
    if (rr == 0) *(f32x4*)(PMAX + (size_t)kb * ncol + n0 + 4 * c4) = mx;
}
template <bool WIN> __device__ __forceinline__ void p0_gate_quant_item(const float* W, int ldw, int nblk, const float* PMAX, unsigned char* WG8, float* SWG, LAS float* scr, int item, int lane, const float* kscale = nullptr) {
    const int kb = item / nblk, nb = item % nblk, k0 = 64 * kb, n0 = 64 * nb, c4 = lane & 15, rr = lane >> 4, ncol = 64 * nblk;
    const int src = WIN ? cm_win(n0 + 4 * c4) : n0 + 4 * c4;
    float cm = 0.f;
#pragma unroll 8
    for (int b = 0; b < 32; ++b) cm = fmaxf(cm, PMAX[(size_t)b * ncol + n0 + lane]);
    cm = fmaxf(cm, 1e-30f);
    if (kb == 0) SWG[n0 + lane] = cm * (1.f / 127.f);
    f32x4 vv[16];
#pragma unroll
    for (int i = 0; i < 16; ++i) vv[i] = ((src >= 0) ? __builtin_nontemporal_load((const f32x4*)(W + (size_t)(k0 + 4 * i + rr) * ldw + src)) : (f32x4){0.f, 0.f, 0.f, 0.f}) * (kscale ? kscale[k0 + 4 * i + rr] : 1.f);
#pragma unroll
    for (int i = 0; i < 16; ++i) { LAS float* d = scr + (4 * i + rr) * 65 + 4 * c4; d[0] = vv[i][0]; d[1] = vv[i][1]; d[2] = vv[i][2]; d[3] = vv[i][3]; }
    asm volatile("s_waitcnt lgkmcnt(0)" ::: "memory");
    const int c = lane & 3;
#pragma unroll
    for (int j = 0; j < 4; ++j) { const int n = (lane >> 2) + 16 * j; const LAS float* sp = scr + (16 * c) * 65 + n;
        const float inv = 127.f / __shfl(cm, n);
        u32x4 o;
        o.x = q8pack(sp[0 * 65], sp[1 * 65], sp[2 * 65], sp[3 * 65], inv); o.y = q8pack(sp[4 * 65], sp[5 * 65], sp[6 * 65], sp[7 * 65], inv);
        o.z = q8pack(sp[8 * 65], sp[9 * 65], sp[10 * 65], sp[11 * 65], inv); o.w = q8pack(sp[12 * 65], sp[13 * 65], sp[14 * 65], sp[15 * 65], inv);
        *(u32x4*)(WG8 + (size_t)(n0 + n) * 2048 + k0 + 16 * c) = o; }
    asm volatile("s_waitcnt lgkmcnt(0)" ::: "memory");
}
struct CmWin { __device__ int operator()(int n) const { if (n < 1024) return n; if (n < 5120) return n + 64; if (n < 11264) return n + 80; if (n < 11328) return 1024 + (n - 11264); if (n < 11344) return 5184 + (n - 11328); return -1; } };
struct CmWuq { __device__ int operator()(int n) const { if (n < 2048) return (n >> 7) * 192 + (n & 127);
    const int m = n - 2048, tile = m >> 8, cl = m & 255, hl = (cl >> 5) & 3, pos = 32 * (cl >> 7) + (cl & 31), head = 4 * tile + hl; return head * 192 + 128 + (pos >> 1) + 32 * (pos & 1); } };
struct CmWukv { __device__ int operator()(int n) const { if (n < 2048) return (n >> 7) * 256 + (n & 127); const int m = n - 2048; return (m >> 7) * 256 + 128 + (m & 127); } };
struct CmId { __device__ int operator()(int n) const { return n; } };

struct Args { const void* in[22]; float* out; unsigned char* ws; int ph_lo, ph_hi; };

__device__ __forceinline__ s16x4 tr_read(const LAS unsigned char* p) { return __builtin_bit_cast(s16x4, __builtin_amdgcn_ds_read_tr16_b64_v4i16((LAS v4i16_t*)p)); }
__device__ __forceinline__ bf16x8 cat8(s16x4 lo, s16x4 hi) { return (bf16x8){lo[0], lo[1], lo[2], lo[3], hi[0], hi[1], hi[2], hi[3]}; }
__device__ __forceinline__ int crow(int r, int hi) { return (r & 3) + 8 * (r >> 2) + 4 * hi; }
__device__ __forceinline__ unsigned f2key(float f) { const unsigned u = __float_as_uint(f); return (u & 0x80000000u) ? ~u : (u | 0x80000000u); }
__device__ __forceinline__ float key2f(unsigned k) { const unsigned u = (k & 0x80000000u) ? (k & 0x7fffffffu) : ~k; return __uint_as_float(u); }
__device__ __forceinline__ unsigned umed3(unsigned a, unsigned b, unsigned c) { const unsigned mx = a > b ? a : b, mn = a > b ? b : a; const unsigned t = mx < c ? mx : c; return mn > t ? mn : t; }

constexpr int GL_QS = 0, GL_KS = 33792, GL_VS = 67584, GL_ST = 76800, GL_AB = 110592, GL_OB = 119808, GL_DEC = 137216;
__device__ __forceinline__ void gla_scan_unit(LAS unsigned char* lds, unsigned char* ws, const float* g_on, int b, int hh, int sl, bool dummy) {
    int tid_ = threadIdx.x; asm volatile("" : "+v"(tid_));
    const int tid = tid_, lane = tid & 63, wid = __builtin_amdgcn_readfirstlane(tid >> 6), l15 = lane & 15, g = lane >> 4;
    const bf16_t* QG = (const bf16_t*)(ws + WS_QG); const bf16_t* KG = (const bf16_t*)(ws + WS_KG); const bf16_t* VG = (const bf16_t*)(ws + WS_VG);
    const bf16_t* OG = (const bf16_t*)(ws + WS_OG); bf16_t* GB = (bf16_t*)(ws + WS_GB); const float* DECG = (const float*)(ws + WS_DEC); float* SSQ = (float*)(ws + WS_SSQ);
    const bf16_t* ABUF = (const bf16_t*)(ws + WS_ABUF);
    bf16_t* GBo = dummy ? (bf16_t*)(ws + WS_CQKV) : GB; float* SSQo = dummy ? (float*)(ws + WS_WIN + 100 * MiB) : SSQ; const size_t omask = dummy ? (size_t)0xffffff : ~(size_t)0;
    f32x4 S[2][4];
#pragma unroll
    for (int a = 0; a < 2; ++a)
#pragma unroll
        for (int v = 0; v < 4; ++v) S[a][v] = (f32x4){0.f, 0.f, 0.f, 0.f};
    u32x4 pq[4], pk[4], pv, pab, pgb; f32x4 pd = (f32x4){0.f, 0.f, 0.f, 0.f};
    const size_t tb = (size_t)b * SEQ;
    const int oi = tid >> 3, opart = tid & 7, oe0 = sl * 64 + 8 * opart;
    const f32x4 gn0 = *(const f32x4*)(g_on + oe0), gn1 = *(const f32x4*)(g_on + oe0 + 4);
    auto issue = [&](int c) {
        const size_t t0 = tb + (size_t)c * 64;
#pragma unroll
        for (int q = 0; q < 4; ++q) { const int ci = tid + 512 * q, row = ci >> 5, cc = ci & 31;
            pq[q] = *(const u32x4*)(QG + (t0 + row) * 1024 + hh * 256 + cc * 8); pk[q] = *(const u32x4*)(KG + (t0 + row) * 1024 + hh * 256 + cc * 8); }
        { const int row = tid >> 3, cc = tid & 7; pv = *(const u32x4*)(VG + (t0 + row) * 2048 + hh * 512 + sl * 64 + cc * 8);
          pab = *(const u32x4*)(ABUF + ((size_t)((b * 4 + hh) * 32 + c)) * 4096 + row * 64 + cc * 8); }
        if (tid < 64) pd = *(const f32x4*)(DECG + ((size_t)((b * 4 + hh) * 32 + c)) * 256 + 4 * tid);
        { const size_t off = (t0 + oi) * 2048 + hh * 512 + oe0; pgb = *(const u32x4*)(GB + off); }
    };
    issue(0);
    for (int c = 0; c < 32; ++c) {
#ifdef REP_GA
        for (int rep_ = 0; rep_ < 2; ++rep_) {
#else
        {
#endif
#pragma unroll
        for (int q = 0; q < 4; ++q) { const int ci = tid + 512 * q, row = ci >> 5, cc = ci & 31;
            *(LAS u32x4*)(lds + GL_QS + row * 528 + cc * 16) = pq[q]; *(LAS u32x4*)(lds + GL_KS + row * 528 + cc * 16) = pk[q]; }
        { const int row = tid >> 3, cc = tid & 7; *(LAS u32x4*)(lds + GL_VS + row * 144 + cc * 16) = pv; *(LAS u32x4*)(lds + GL_AB + row * 144 + cc * 16) = pab; }
        if (tid < 64) *(LAS f32x4*)(lds + GL_DEC + 16 * tid) = pd;
#pragma unroll
        for (int a = 0; a < 2; ++a)
#pragma unroll
            for (int vt = 0; vt < 4; ++vt) { const int dt = 2 * wid + a; u32x2 w; w.x = pkbf(S[a][vt][0], S[a][vt][1]); w.y = pkbf(S[a][vt][2], S[a][vt][3]);
                *(LAS u32x2*)(lds + GL_ST + (16 * vt + l15) * 528 + (16 * dt + 4 * g) * 2) = w; }
        RAW_BAR();
        }
        const u32x4 cgb = pgb;
        if (c + 1 < 32) issue(c + 1);
#ifdef REP_GF1
        for (int rep_ = 0; rep_ < 2; ++rep_)
#endif
        {
            const int it = wid >> 1;
#pragma unroll
            for (int vv = 0; vv < 2; ++vv) {
                const int vt = 2 * (wid & 1) + vv;
                f32x4 o = (f32x4){0.f, 0.f, 0.f, 0.f};
#pragma unroll
                for (int ks = 0; ks < 8; ++ks) {
                    const bf16x8 fa = *(const LAS bf16x8*)(lds + GL_QS + (16 * it + l15) * 528 + (32 * ks + 8 * g) * 2);
                    const bf16x8 fb = *(const LAS bf16x8*)(lds + GL_ST + (16 * vt + l15) * 528 + (32 * ks + 8 * g) * 2);
                    o = __builtin_amdgcn_mfma_f32_16x16x32_bf16(fa, fb, o, 0, 0, 0);
                }
#pragma unroll
                for (int ks = 0; ks < 2; ++ks) {
                    const bf16x8 fa = *(const LAS bf16x8*)(lds + GL_AB + (16 * it + l15) * 144 + (32 * ks + 8 * g) * 2);
                    const LAS unsigned char* vp = lds + GL_VS + (32 * ks + 8 * g + (l15 >> 2)) * 144 + (16 * vt + 4 * (l15 & 3)) * 2;
                    const bf16x8 fb = cat8(tr_read(vp), tr_read(vp + 4 * 144));
                    o = __builtin_amdgcn_mfma_f32_16x16x32_bf16(fa, fb, o, 0, 0, 0);
                }
#pragma unroll
                for (int r = 0; r < 4; ++r) *(LAS float*)(lds + GL_OB + ((16 * it + 4 * g + r) * 68 + 16 * vt + l15) * 4) = o[r];
            }
        }
        {
            bf16x8 fv[4][2];
#pragma unroll
            for (int vt = 0; vt < 4; ++vt)
#pragma unroll
                for (int ks = 0; ks < 2; ++ks) { const LAS unsigned char* vp = lds + GL_VS + (32 * ks + 8 * g + (l15 >> 2)) * 144 + (16 * vt + 4 * (l15 & 3)) * 2;
                    fv[vt][ks] = cat8(tr_read(vp), tr_read(vp + 4 * 144)); }
#pragma unroll
            for (int a = 0; a < 2; ++a) {
                const int dt = 2 * wid + a;
#pragma unroll
                for (int ks = 0; ks < 2; ++ks) {
                    const LAS unsigned char* kp = lds + GL_KS + (32 * ks + 8 * g + (l15 >> 2)) * 528 + (16 * dt + 4 * (l15 & 3)) * 2;
                    const bf16x8 fk = cat8(tr_read(kp), tr_read(kp + 4 * 528));
#pragma unroll
                    for (int vt = 0; vt < 4; ++vt) S[a][vt] = __builtin_amdgcn_mfma_f32_16x16x32_bf16(fk, fv[vt][ks], S[a][vt], 0, 0, 0);
                }
                const f32x4 dc = *(const LAS f32x4*)(lds + GL_DEC + (16 * dt + 4 * g) * 4);
#pragma unroll
                for (int vt = 0; vt < 4; ++vt) S[a][vt] = S[a][vt] * dc;
            }
        }
        RAW_BAR();
        {
            const int i = oi, part = opart; const size_t t = tb + (size_t)c * 64 + i;
            const f32x4 o0 = *(const LAS f32x4*)(lds + GL_OB + (i * 68 + 8 * part) * 4), o1 = *(const LAS f32x4*)(lds + GL_OB + (i * 68 + 8 * part + 4) * 4);
            float ss = (o0[0] * o0[0] + o0[1] * o0[1]) + (o0[2] * o0[2] + o0[3] * o0[3]) + (o1[0] * o1[0] + o1[1] * o1[1]) + (o1[2] * o1[2] + o1[3] * o1[3]);
            ss += __shfl_xor(ss, 1); ss += __shfl_xor(ss, 2); ss += __shfl_xor(ss, 4);
            if (part == 0) SSQo[(t * 4 + hh) * 8 + sl] = ss;
            const size_t off = t * 2048 + hh * 512 + oe0;
            const u32x4 gb = cgb;
            u32x4 w;
            w.x = pkbf(o0[0] * bf_lo(gb.x) * gn0[0], o0[1] * bf_hi(gb.x) * gn0[1]);
            w.y = pkbf(o0[2] * bf_lo(gb.y) * gn0[2], o0[3] * bf_hi(gb.y) * gn0[3]);
            w.z = pkbf(o1[0] * bf_lo(gb.z) * gn1[0], o1[1] * bf_hi(gb.z) * gn1[1]);
            w.w = pkbf(o1[2] * bf_lo(gb.w) * gn1[2], o1[3] * bf_hi(gb.w) * gn1[3]);
            *(u32x4*)(GBo + (off & omask)) = w;
        }
    }
    __syncthreads();
}

constexpr int AT_KSTR = 400, AT_VSTR = 320, AT_VOFF = 64 * AT_KSTR, AT_BUF = 64 * AT_KSTR + 64 * AT_VSTR;
__device__ __forceinline__ void attn_unit(LAS unsigned char* lds, const bf16_t* Qh, const bf16_t* Kh, const bf16_t* Vh, const bf16_t* KPE, const bf16_t* GAin, bf16_t* GAout, size_t omask, int b, int hh, int qb) {
    int tid_ = threadIdx.x; asm volatile("" : "+v"(tid_));
    const int tid = tid_, lane = tid & 63, wid = __builtin_amdgcn_readfirstlane(tid >> 6), r32 = lane & 31, hi = lane >> 5;
    const size_t tb = (size_t)b * SEQ; const int q0 = qb * 256;
    const int NT = (q0 + 256) / 64;
    u32x4 sk[2], sr, sv[2];
    auto issue = [&](int jt) {
        const size_t t0 = tb + (size_t)jt * 64;
#pragma unroll
        for (int q = 0; q < 2; ++q) { const int ci = tid + 512 * q, row = ci >> 4, cc = ci & 15;
            sk[q] = *(const u32x4*)(Kh + (t0 + row) * 2048 + hh * 128 + cc * 8); sv[q] = *(const u32x4*)(Vh + (t0 + row) * 2048 + hh * 128 + cc * 8); }
        { const int row = tid >> 3, cc = tid & 7; sr = *(const u32x4*)(KPE + (t0 + row) * 64 + cc * 8); }
    };
    auto stash = [&](int buf) {
        LAS unsigned char* kb = lds + buf * AT_BUF; LAS unsigned char* vb = kb + AT_VOFF;
#pragma unroll
        for (int q = 0; q < 2; ++q) { const int ci = tid + 512 * q, row = ci >> 4, cc = ci & 15;
            *(LAS u32x4*)(kb + row * AT_KSTR + cc * 16) = sk[q]; *(LAS u32x4*)(vb + row * AT_VSTR + cc * 16) = sv[q]; }
        { const int row = tid >> 3, cc = tid & 7; *(LAS u32x4*)(kb + row * AT_KSTR + 256 + cc * 16) = sr; }
    };
    issue(0);
    bf16x8 qf[12];
    { const bf16_t* qp = Qh + (tb + q0 + wid * 32 + r32) * 3072 + hh * 192 + hi * 8;
#pragma unroll
      for (int d0 = 0; d0 < 12; ++d0) qf[d0] = *(const bf16x8*)(qp + d0 * 16); }
    f32x16 o[4];
#pragma unroll
    for (int d = 0; d < 4; ++d)
#pragma unroll
        for (int r = 0; r < 16; ++r) o[d][r] = 0.f;
    float mrun = -1e30f, lrun = 0.f;
    stash(0);
    if (NT > 1) issue(1);
    RAW_BAR();
    const int qidx = q0 + wid * 32 + r32;
    for (int jt = 0; jt < NT; ++jt) {
        const int buf = jt & 1;
        const LAS unsigned char* kb = lds + buf * AT_BUF; const LAS unsigned char* vb = kb + AT_VOFF;
        f32x16 p0, p1;
#pragma unroll
        for (int r = 0; r < 16; ++r) { p0[r] = 0.f; p1[r] = 0.f; }
        __builtin_amdgcn_s_setprio(1);
#pragma unroll
        for (int d0 = 0; d0 < 12; ++d0) {
            const bf16x8 k0 = *(const LAS bf16x8*)(kb + r32 * AT_KSTR + (16 * d0 + 8 * hi) * 2);
            const bf16x8 k1 = *(const LAS bf16x8*)(kb + (32 + r32) * AT_KSTR + (16 * d0 + 8 * hi) * 2);
            p0 = __builtin_amdgcn_mfma_f32_32x32x16_bf16(k0, qf[d0], p0, 0, 0, 0);
            p1 = __builtin_amdgcn_mfma_f32_32x32x16_bf16(k1, qf[d0], p1, 0, 0, 0);
        }
        __builtin_amdgcn_s_setprio(0);
        if (jt >= NT - 4) {
            const int kbase = jt * 64 + 4 * hi;
#pragma unroll
            for (int r = 0; r < 16; ++r) { const int kv = kbase + (r & 3) + 8 * (r >> 2); if (kv > qidx) p0[r] = -1e30f; if (kv + 32 > qidx) p1[r] = -1e30f; }
        }
        float mxa = fmaxf(fmaxf(p0[0], p0[1]), p0[2]), mxb = fmaxf(fmaxf(p1[0], p1[1]), p1[2]);
#pragma unroll
        for (int r = 3; r < 15; r += 2) { mxa = fmaxf(fmaxf(mxa, p0[r]), p0[r + 1]); mxb = fmaxf(fmaxf(mxb, p1[r]), p1[r + 1]); }
        float mx = fmaxf(fmaxf(mxa, p0[15]), fmaxf(mxb, p1[15]));
        mx = fmaxf(mx, __shfl_xor(mx, 32));
        const bool grow = mx > mrun + 6.0f;
        if (__builtin_amdgcn_ballot_w64(grow) != 0ull) {
            const float mnew = fmaxf(mrun, mx);
            const float alpha = __builtin_amdgcn_exp2f(mrun - mnew);
            mrun = mnew; lrun *= alpha;
#pragma unroll
            for (int d = 0; d < 4; ++d)
#pragma unroll
                for (int r = 0; r < 16; ++r) o[d][r] *= alpha;
        }
        float ls = 0.f;
#pragma unroll
        for (int r = 0; r < 16; ++r) { p0[r] = __builtin_amdgcn_exp2f(p0[r] - mrun); p1[r] = __builtin_amdgcn_exp2f(p1[r] - mrun); ls += p0[r] + p1[r]; }
        lrun += ls;
        bf16x8 pf[4];
        { u32x4 w;
          w.x = pkbf(p0[0], p0[1]); w.y = pkbf(p0[2], p0[3]); w.z = pkbf(p0[4], p0[5]); w.w = pkbf(p0[6], p0[7]); pf[0] = __builtin_bit_cast(bf16x8, w);
          w.x = pkbf(p0[8], p0[9]); w.y = pkbf(p0[10], p0[11]); w.z = pkbf(p0[12], p0[13]); w.w = pkbf(p0[14], p0[15]); pf[1] = __builtin_bit_cast(bf16x8, w);
          w.x = pkbf(p1[0], p1[1]); w.y = pkbf(p1[2], p1[3]); w.z = pkbf(p1[4], p1[5]); w.w = pkbf(p1[6], p1[7]); pf[2] = __builtin_bit_cast(bf16x8, w);
          w.x = pkbf(p1[8], p1[9]); w.y = pkbf(p1[10], p1[11]); w.z = pkbf(p1[12], p1[13]); w.w = pkbf(p1[14], p1[15]); pf[3] = __builtin_bit_cast(bf16x8, w); }
        const int i16 = lane & 15;
        const LAS unsigned char* vbase = vb + ((4 * hi) + (i16 >> 2)) * AT_VSTR + (16 * ((lane >> 4) & 1) + 4 * (i16 & 3)) * 2;
        __builtin_amdgcn_s_setprio(1);
#pragma unroll
        for (int ks = 0; ks < 4; ++ks) {
#pragma unroll
            for (int d = 0; d < 4; ++d) {
                const LAS unsigned char* vp = vbase + (16 * ks) * AT_VSTR + (32 * d) * 2;
                const bf16x8 fv = cat8(tr_read(vp), tr_read(vp + 8 * AT_VSTR));
                o[d] = __builtin_amdgcn_mfma_f32_32x32x16_bf16(fv, pf[ks], o[d], 0, 0, 0);
            }
        }
        __builtin_amdgcn_s_setprio(0);
        if (jt + 1 < NT) stash(buf ^ 1);
        if (jt + 2 < NT) issue(jt + 2);
        RAW_BAR();
    }
    lrun += __shfl_xor(lrun, 32);
    const float inv = __builtin_amdgcn_rcpf(lrun);
    bf16_t* op = GAout + (((tb + qidx) * 2048 + hh * 128) & omask); const bf16_t* ip = GAin + (tb + qidx) * 2048 + hh * 128;
#pragma unroll
    for (int d = 0; d < 4; ++d)
#pragma unroll
        for (int g4 = 0; g4 < 4; ++g4) {
            const int dv = 32 * d + 8 * g4 + 4 * hi;
            const u32x2 ga = *(const u32x2*)(ip + dv);
            u32x2 w;
            w.x = pkbf(o[d][4 * g4 + 0] * inv * bf_lo(ga.x), o[d][4 * g4 + 1] * inv * bf_hi(ga.x));
            w.y = pkbf(o[d][4 * g4 + 2] * inv * bf_lo(ga.y), o[d][4 * g4 + 3] * inv * bf_hi(ga.y));
            *(u32x2*)(op + dv) = w;
        }
}

__device__ __forceinline__ void x1_quant_unit(unsigned char* ws, int unit) {
    int tid_ = threadIdx.x; asm volatile("" : "+v"(tid_));
    const int tid = tid_, lane = tid & 63, wid = __builtin_amdgcn_readfirstlane(tid >> 6);
    const bf16_t* X1B = (const bf16_t*)(ws + WS_X1B); const size_t t0 = (size_t)unit * 64;
    {
        unsigned char* X8 = ws + WS_X8; float* SX = (float*)(ws + WS_SX);
        u32x4 xv[8][4];
#pragma unroll
        for (int it = 0; it < 8; ++it)
#pragma unroll
            for (int k = 0; k < 4; ++k) xv[it][k] = *(const u32x4*)(X1B + (t0 + wid + 8 * it) * 2048 + (size_t)(lane + 64 * k) * 8);
#pragma unroll
        for (int it = 0; it < 8; ++it) { const size_t t = t0 + wid + 8 * it; float ax = 0.f;
#pragma unroll
            for (int k = 0; k < 4; ++k)
#pragma unroll
                for (int d = 0; d < 4; ++d) ax = fmaxf(ax, fmaxf(fabsf(bf_lo(xv[it][k][d])), fabsf(bf_hi(xv[it][k][d]))));
            ax = fmaxf(wave_max(ax), 1e-30f); const float ix = 127.f / ax;
#pragma unroll
            for (int k = 0; k < 4; ++k) { u32x2 w;
                w.x = q8pack(bf_lo(xv[it][k].x), bf_hi(xv[it][k].x), bf_lo(xv[it][k].y), bf_hi(xv[it][k].y), ix); w.y = q8pack(bf_lo(xv[it][k].z), bf_hi(xv[it][k].z), bf_lo(xv[it][k].w), bf_hi(xv[it][k].w), ix);
                *(u32x2*)(X8 + t * 2048 + (size_t)(lane + 64 * k) * 8) = w; }
            if (lane == 0) SX[t] = ax * (1.f / 127.f); }
    }
}

constexpr int PE_KEYS = 0, PE_R1 = 135168;
__device__ __forceinline__ void sort16_insert(unsigned (&L)[16], unsigned x) {
#pragma unroll
    for (int i = 15; i >= 1; --i) L[i] = umed3(L[i - 1], L[i], x);
    L[0] = L[0] > x ? L[0] : x;
}
__device__ __forceinline__ void cex(unsigned& a, unsigned& b) { const unsigned hi = a > b ? a : b, lo = a > b ? b : a; a = hi; b = lo; }
__device__ __forceinline__ unsigned sel4(unsigned p0, unsigned p1, unsigned p2, unsigned p3, int i) {
    const unsigned w = (i & 8) ? ((i & 4) ? p3 : p2) : ((i & 4) ? p1 : p0);
    return (w >> (8 * (i & 3))) & 0xffu;
}
__device__ __forceinline__ void peer_unit(LAS unsigned char* lds, unsigned char* ws, float* out, int unit) {
    unsigned short* SELT = (unsigned short*)(ws + WS_SELT); float* GATE = (float*)(ws + WS_GATE); float* R1G = (float*)(ws + WS_R1G);
    int tid_ = threadIdx.x; asm volatile("" : "+v"(tid_));
    const int tid = tid_, lane = tid & 63, wid = __builtin_amdgcn_readfirstlane(tid >> 6), r32 = lane & 31, hi = lane >> 5;
    const bf16_t* QP = (const bf16_t*)(ws + WS_QP); const bf16_t* KEYS = (const bf16_t*)(ws + WS_KEYS); const bf16_t* X1B = (const bf16_t*)(ws + WS_X1B);
    const unsigned char* U8 = ws + WS_UB; const unsigned char* V8 = ws + WS_VB; const float* RSQ1 = (const float*)(ws + WS_RSQ1);
    LAS float* R1 = (LAS float*)(lds + PE_R1);
    const size_t t0 = (size_t)unit * 64;
    if (tid < 64) { const float* p = RSQ1 + (t0 + tid) * 32; float s = 0.f;
#pragma unroll
        for (int i = 0; i < 8; ++i) { const f32x4 v = *(const f32x4*)(p + 4 * i); s += (v[0] + v[1]) + (v[2] + v[3]); }
        const float r1v = __builtin_amdgcn_rsqf(s * (1.f / 2048.f) + EPS); R1[tid] = r1v; R1G[t0 + tid] = r1v; }
    __syncthreads();
#ifndef NO_PEER1
    {
        const int tg = wid & 1; const int tl = 32 * tg + r32; const size_t t = t0 + tl;
        const float rstd = R1[tl];
#define PEER_STAGE_KEYS(step) do { const int hx_ = (step) >> 1, p_ = (step) & 1; \
            _Pragma("unroll") for (int i_ = 0; i_ < 16; ++i_) { const int r_ = (wid & 1) * 64 + 4 * i_ + (lane >> 4); \
                __builtin_amdgcn_global_load_lds((const unsigned*)(KEYS + ((size_t)(((4 * hx_ + (wid >> 1)) * 2 + p_) * 128 + r_)) * 128 + (((lane & 15) ^ (r_ & 15)) * 8)), \
                                                 (LAS unsigned*)(lds + PE_KEYS + (wid * 16 + i_) * 1024), 16, 0, 0); } } while (0)
        PEER_STAGE_KEYS(0);
        const unsigned kbase = (unsigned)(PE_KEYS + (wid >> 1) * 32768 + r32 * 256); const int kx = r32 & 15;
        bf16x8 qf[8];
        { const bf16_t* qn = QP + t * 2048 + (wid >> 1) * 256 + 8 * hi;
#pragma unroll
          for (int d0 = 0; d0 < 8; ++d0) qf[d0] = *(const bf16x8*)(qn + 16 * d0); }
        asm volatile("s_waitcnt vmcnt(0)" ::: "memory"); __syncthreads();
#pragma unroll 1
        for (int hx = 0; hx < 2; ++hx) {
            const int h = (wid >> 1) + 4 * hx;
            unsigned LA[16], LB[16];
#pragma unroll 1
            for (int p = 0; p < 2; ++p) {
                f32x16 acc[4];
#pragma unroll
                for (int kb = 0; kb < 4; ++kb)
#pragma unroll
                    for (int r = 0; r < 16; ++r) acc[kb][r] = 0.f;
#pragma unroll
                for (int d0 = 0; d0 < 8; ++d0) {
                    const unsigned ko = kbase + (unsigned)(((2 * d0 + hi) ^ kx) << 4);
#pragma unroll
                    for (int kb = 0; kb < 4; ++kb) { const bf16x8 kf = *(const LAS bf16x8*)(lds + ko + kb * 8192);
                        acc[kb] = __builtin_amdgcn_mfma_f32_32x32x16_bf16(kf, qf[d0], acc[kb], 0, 0, 0); }
                }
                if (hx * 2 + p < 3) { __syncthreads(); PEER_STAGE_KEYS(hx * 2 + p + 1);
                    const int sn = hx * 2 + p + 1; const bf16_t* qn = QP + t * 2048 + ((wid >> 1) + 4 * (sn >> 1)) * 256 + (sn & 1) * 128 + 8 * hi;
#pragma unroll
                    for (int d0 = 0; d0 < 8; ++d0) qf[d0] = *(const bf16x8*)(qn + 16 * d0); }
                unsigned L[16];
#pragma unroll
                for (int i = 0; i < 16; ++i) L[i] = 0u;
#pragma unroll
                for (int kb = 0; kb < 4; ++kb)
#pragma unroll
                    for (int r = 0; r < 16; ++r) { const int key = 32 * kb + (r & 3) + 8 * (r >> 2);
                        const unsigned x = (f2key(acc[kb][r]) & ~127u) | (unsigned)(127 - key - 4 * hi); sort16_insert(L, x); }
                unsigned M[16];
#pragma unroll
                for (int i = 0; i < 16; ++i) { const unsigned o = (unsigned)__shfl_xor((int)L[15 - i], 32); M[i] = L[i] > o ? L[i] : o; }
#pragma unroll
                for (int dd = 8; dd >= 1; dd >>= 1)
#pragma unroll
                    for (int i = 0; i < 16; ++i) if ((i & dd) == 0) cex(M[i], M[i + dd]);
                if (p == 0) {
#pragma unroll
                    for (int i = 0; i < 16; ++i) LA[i] = M[i];
                } else {
#pragma unroll
                    for (int i = 0; i < 16; ++i) LB[i] = M[i];
                }
                if (hx * 2 + p < 3) { asm volatile("s_waitcnt vmcnt(0)" ::: "memory"); __syncthreads(); }
            }
            float fa[16], fb[16]; unsigned ia0 = 0u, ia1 = 0u, ia2 = 0u, ia3 = 0u, ib0 = 0u, ib1 = 0u, ib2 = 0u, ib3 = 0u;
#pragma unroll
            for (int i = 0; i < 16; ++i) { fa[i] = key2f(LA[i] & ~127u); fb[i] = key2f(LB[i] & ~127u);
                const unsigned va = (127u - (LA[i] & 127u)) << (8 * (i & 3)), vb = (127u - (LB[i] & 127u)) << (8 * (i & 3));
                if ((i >> 2) == 0) { ia0 |= va; ib0 |= vb; } else if ((i >> 2) == 1) { ia1 |= va; ib1 |= vb; } else if ((i >> 2) == 2) { ia2 |= va; ib2 |= vb; } else { ia3 |= va; ib3 |= vb; } }
            unsigned C[16];
#pragma unroll
            for (int i = 0; i < 16; ++i) C[i] = 0u;
#pragma unroll
            for (int i = 0; i < 16; ++i)
#pragma unroll
                for (int j = 0; j < 16; ++j) if ((i + 1) * (j + 1) <= 16) { const unsigned x = (f2key(fa[i] + fb[j]) & ~255u) | (unsigned)(i * 16 + j); sort16_insert(C, x); }
            const float smax = key2f(C[0] & ~255u);
            float e[16], den = 0.f;
#pragma unroll
            for (int k = 0; k < 16; ++k) { e[k] = __builtin_amdgcn_exp2f((key2f(C[k] & ~255u) - smax) * rstd * 1.4426950408889634f); den += e[k]; }
            const float rden = 1.f / den;
            if (hi == 0) {
#pragma unroll
                for (int k = 0; k < 16; ++k) { const int ij = (int)(C[k] & 255u); const unsigned id = sel4(ia0, ia1, ia2, ia3, ij >> 4) * 128u + sel4(ib0, ib1, ib2, ib3, ij & 15);
                    const int pos = (k & 7) * 16 + 2 * h + (k >> 3);
                    SELT[t * 128 + pos] = (unsigned short)id; GATE[t * 128 + pos] = e[k] * rden; }
            }
        }
    }
#endif
    __syncthreads();
    __syncthreads();
}


#define PEER_IDS(dst0, dst1, tt) do { dst0 = __builtin_nontemporal_load((const u32x4*)(SELT + (tt) * 128 + es * 16)); dst1 = __builtin_nontemporal_load((const u32x4*)(SELT + (tt) * 128 + es * 16 + 8)); } while (0)
#define PEER_ROWS(rowv, i0v, i1v) do { _Pragma("unroll") for (int q = 0; q < 16; ++q) { const unsigned w_ = (q < 8) ? i0v[q >> 1] : i1v[(q - 8) >> 1]; const unsigned id_ = (q & 1) ? (w_ >> 16) : (w_ & 0xffffu); \
        rowv[q] = *(const u32x4*)(tab + (size_t)id_ * 128); } } while (0)
#define PERMB(s0, s1, sel) __builtin_amdgcn_perm((s0), (s1), (sel))
#define PEER_ROWS4(rowv, i0v, i1v, g4_, tabp) do { _Pragma("unroll") for (int q_ = 4 * (g4_); q_ < 4 * (g4_) + 4; ++q_) { const unsigned w_ = (q_ < 8) ? i0v[q_ >> 1] : i1v[(q_ - 8) >> 1]; \
        const unsigned id_ = (q_ & 1) ? (w_ >> 16) : (w_ & 0xffffu); rowv[q_] = *(const u32x4*)((tabp) + (size_t)id_ * 128); } } while (0)
__device__ __forceinline__ void peer_v_group(const u32x4 (&row)[16], const u32x4 wq, const int g4, int (&a)[16]) {
    const int wd = (int)wq[g4];
#pragma unroll
    for (int dw = 0; dw < 4; ++dw) {
        const unsigned A = row[4 * g4][dw], B = row[4 * g4 + 1][dw], C = row[4 * g4 + 2][dw], D = row[4 * g4 + 3][dw];
        const unsigned ablo = PERMB(B, A, 0x05010400u), abhi = PERMB(B, A, 0x07030602u), cdlo = PERMB(D, C, 0x05010400u), cdhi = PERMB(D, C, 0x07030602u);
        a[4 * dw + 0] = __builtin_amdgcn_sdot4((int)PERMB(cdlo, ablo, 0x05040100u), wd, a[4 * dw + 0], false);
        a[4 * dw + 1] = __builtin_amdgcn_sdot4((int)PERMB(cdlo, ablo, 0x07060302u), wd, a[4 * dw + 1], false);
        a[4 * dw + 2] = __builtin_amdgcn_sdot4((int)PERMB(cdhi, abhi, 0x05040100u), wd, a[4 * dw + 2], false);
        a[4 * dw + 3] = __builtin_amdgcn_sdot4((int)PERMB(cdhi, abhi, 0x07060302u), wd, a[4 * dw + 3], false);
    }
}
__device__ __forceinline__ void peer_v_finish(const int (&a)[16], float sw, const f32x2_t xo, float* op, int lane) {
    int r4a[4], r4b[4], r2a[2], r2b[2], r1a, r1b;
#pragma unroll
    for (int j = 0; j < 4; ++j) { const bool up = (lane & 8) != 0;
        const int ka = up ? a[4 * j + 2] : a[4 * j], kb = up ? a[4 * j + 3] : a[4 * j + 1], sa = up ? a[4 * j] : a[4 * j + 2], sb = up ? a[4 * j + 1] : a[4 * j + 3];
        r4a[j] = ka + __shfl_xor(sa, 8); r4b[j] = kb + __shfl_xor(sb, 8); }
#pragma unroll
    for (int j = 0; j < 2; ++j) { const bool up = (lane & 16) != 0;
        const int ka = up ? r4a[2 * j + 1] : r4a[2 * j], kb = up ? r4b[2 * j + 1] : r4b[2 * j], sa = up ? r4a[2 * j] : r4a[2 * j + 1], sb = up ? r4b[2 * j] : r4b[2 * j + 1];
        r2a[j] = ka + __shfl_xor(sa, 16); r2b[j] = kb + __shfl_xor(sb, 16); }
    { const bool up = (lane & 32) != 0;
        const int ka = up ? r2a[1] : r2a[0], kb = up ? r2b[1] : r2b[0], sa = up ? r2a[0] : r2a[1], sb = up ? r2b[0] : r2b[1];
        r1a = ka + __shfl_xor(sa, 32); r1b = kb + __shfl_xor(sb, 32); }
    __builtin_nontemporal_store((f32x2_t){xo[0] + sw * (float)r1a, xo[1] + sw * (float)r1b}, (f32x2_t*)op);
}

__device__ __forceinline__ void peer_u_sum(const u32x4 (&row)[16], const u32x4 xq, int lane, int& s0, int& s1) {
    int part[16];
#pragma unroll
    for (int q = 0; q < 16; ++q) { int a = 0;
#pragma unroll
        for (int dw = 0; dw < 4; ++dw) a = __builtin_amdgcn_sdot4((int)xq[dw], (int)row[q][dw], a, false);
        part[q] = a; }
    int r8[8], r4[4];
#pragma unroll
    for (int j = 0; j < 8; ++j) { const int keep = (lane & 1) ? part[2 * j + 1] : part[2 * j], send = (lane & 1) ? part[2 * j] : part[2 * j + 1]; r8[j] = keep + __shfl_xor(send, 1); }
#pragma unroll
    for (int j = 0; j < 4; ++j) { const int keep = (lane & 2) ? r8[2 * j + 1] : r8[2 * j], send = (lane & 2) ? r8[2 * j] : r8[2 * j + 1]; r4[j] = keep + __shfl_xor(send, 2); }
    { const int keep = (lane & 4) ? r4[1] : r4[0], send = (lane & 4) ? r4[0] : r4[1]; s0 += keep + __shfl_xor(send, 4); }
    { const int keep = (lane & 4) ? r4[3] : r4[2], send = (lane & 4) ? r4[2] : r4[3]; s1 += keep + __shfl_xor(send, 4); }
}
__device__ __forceinline__ void peer_fused_rounds(LAS unsigned char* lds, unsigned char* ws, float* out, int unit) {
    int tid_ = threadIdx.x; asm volatile("" : "+v"(tid_));
    const int tid = tid_, lane = tid & 63, wid = __builtin_amdgcn_readfirstlane(tid >> 6), es = lane >> 3, cb = lane & 7;
    const unsigned short* SELT = (const unsigned short*)(ws + WS_SELT); const unsigned char* X8 = ws + WS_X8; const float* GATE = (const float*)(ws + WS_GATE);
    const float* R1G = (const float*)(ws + WS_R1G); const float* SX = (const float*)(ws + WS_SX); const float* SU = (const float*)(ws + WS_SU); const float* SV = (const float*)(ws + WS_SV);
    LAS unsigned char* W8L = lds + 131072 + wid * 1024;
    LAS unsigned char* X8L = lds + wid * 16384;
    const size_t tw = (size_t)unit * 64 + (size_t)wid * 8;
    u32x4 idr[8][2];
#pragma unroll
    for (int i = 0; i < 8; ++i) { idr[i][0] = *(const u32x4*)(SELT + (tw + i) * 128 + es * 16); idr[i][1] = *(const u32x4*)(SELT + (tw + i) * 128 + es * 16 + 8); }
    int acc[8][2];
#pragma unroll
    for (int i = 0; i < 8; ++i) { acc[i][0] = 0; acc[i][1] = 0; }
    {
#pragma unroll
        for (int j = 0; j < 16; ++j) { const u32x4 v = *(const u32x4*)(X8 + tw * 2048 + (size_t)j * 1024 + lane * 16); *(LAS u32x4*)(X8L + j * 1024 + lane * 16) = v; }
        asm volatile("s_waitcnt lgkmcnt(0)" ::: "memory");
    }
#pragma unroll 1
    for (int sidx = 0; sidx < 16; ++sidx) {
        const unsigned char* tab = ws + WS_UB + (size_t)sidx * (2 * MiB) + cb * 16;
        u32x4 xq[8];
#pragma unroll
        for (int i = 0; i < 8; ++i) xq[i] = *(const LAS u32x4*)(X8L + i * 2048 + sidx * 128 + cb * 16);
#pragma unroll
        for (int i = 0; i < 8; ++i) { u32x4 row[16]; u32x4 ia = idr[i][0], ib = idr[i][1]; asm volatile("" : "+v"(ia), "+v"(ib));
            PEER_ROWS(row, ia, ib); peer_u_sum(row, xq[i], lane, acc[i][0], acc[i][1]); asm volatile("" ::: "memory"); }
    }
    float swv[8];
#pragma unroll
    for (int i = 0; i < 8; ++i) { const size_t t = tw + i; const float tsc = SX[t] * R1G[t]; float wv[2];
#pragma unroll
        for (int hf = 0; hf < 2; ++hf) { const size_t idx = t * 128 + es * 16 + 8 * hf + cb; const unsigned id = SELT[idx];
            const float act = (float)acc[i][hf] * tsc * SU[id];
            wv[hf] = GATE[idx] * 0.5f * act * (1.f + erff(act * 0.70710678118654752f)) * SV[id]; }
        const float aw = fmaxf(wave_max(fmaxf(fabsf(wv[0]), fabsf(wv[1]))), 1e-30f); const float iw = 127.f / aw;
        W8L[i * 128 + es * 16 + cb] = (unsigned char)((int)__builtin_rintf(wv[0] * iw) & 0xff); W8L[i * 128 + es * 16 + 8 + cb] = (unsigned char)((int)__builtin_rintf(wv[1] * iw) & 0xff);
        swv[i] = aw * (1.f / 127.f); }
    asm volatile("s_waitcnt lgkmcnt(0)" ::: "memory");
    {
        u32x4 row[16];
        { u32x4 ia = idr[0][0], ib = idr[0][1]; asm volatile("" : "+v"(ia), "+v"(ib)); const unsigned char* tab = ws + WS_VB + cb * 16; PEER_ROWS(row, ia, ib); }
#pragma unroll 1
        for (int sidx = 0; sidx < 16; ++sidx) {
            const unsigned char* tab = ws + WS_VB + (size_t)sidx * (2 * MiB) + cb * 16; const unsigned char* tabn = (sidx < 15) ? tab + 2 * MiB : tab;
            float* ob = out + sidx * 128 + cb * 16 + 2 * es;
            if ((sidx & 3) == 0) {
                u32x4 t8[8];
#pragma unroll
                for (int i = 0; i < 8; ++i) t8[i] = __builtin_nontemporal_load((const u32x4*)((const bf16_t*)(ws + WS_X1B) + (tw + i) * 2048 + sidx * 128 + lane * 8));
#pragma unroll
                for (int i = 0; i < 8; ++i) *(LAS u32x4*)(X8L + i * 1024 + lane * 16) = t8[i];
                asm volatile("s_waitcnt lgkmcnt(0)" ::: "memory");
            }
#pragma unroll
            for (int i = 0; i < 8; ++i) {
                u32x4 ia = idr[(i + 1) & 7][0], ib = idr[(i + 1) & 7][1]; asm volatile("" : "+v"(ia), "+v"(ib));
                const unsigned char* tn = (i < 7) ? tab : tabn;
                const unsigned xb = *(const LAS unsigned*)(X8L + i * 1024 + (sidx & 3) * 256 + (cb * 16 + 2 * es) * 2); const f32x2_t xo = {bf_lo(xb), bf_hi(xb)};
                const u32x4 wqi = *(const LAS u32x4*)(W8L + i * 128 + es * 16);
                int a[16];
#pragma unroll
                for (int k = 0; k < 16; ++k) a[k] = 0;
#pragma unroll
                for (int g4 = 0; g4 < 4; ++g4) { peer_v_group(row, wqi, g4, a); asm volatile("" ::: "memory"); PEER_ROWS4(row, ia, ib, g4, tn); asm volatile("" ::: "memory"); }
                peer_v_finish(a, swv[i], xo, ob + (tw + i) * 2048, lane); asm volatile("" ::: "memory");
            }
        }
    }
}

__device__ __forceinline__ void table_quant(unsigned char* ws, const float* u_emb, const float* v_emb, const float* g_ffn, int gw, int NGW, int lane) {
    unsigned char* U8 = ws + WS_UB; unsigned char* V8 = ws + WS_VB;
    float* SU = (float*)(ws + WS_SU); float* SV = (float*)(ws + WS_SV);
    for (int e = gw; e < 16384; e += NGW) {
        f32x4 uv[8], vv[8]; float au = 0.f, av = 0.f;
#pragma unroll
        for (int j = 0; j < 8; ++j) { const int col = 256 * j + 4 * lane;
            uv[j] = __builtin_nontemporal_load((const f32x4*)(u_emb + (size_t)e * 2048 + col)) * *(const f32x4*)(g_ffn + col); vv[j] = __builtin_nontemporal_load((const f32x4*)(v_emb + (size_t)e * 2048 + col)); }
#pragma unroll
        for (int k = 0; k < 8; ++k) { au = fmaxf(au, fmaxf(fmaxf(fabsf(uv[k][0]), fabsf(uv[k][1])), fmaxf(fabsf(uv[k][2]), fabsf(uv[k][3]))));
            av = fmaxf(av, fmaxf(fmaxf(fabsf(vv[k][0]), fabsf(vv[k][1])), fmaxf(fabsf(vv[k][2]), fabsf(vv[k][3])))); }
        au = fmaxf(wave_max(au), 1e-30f); av = fmaxf(wave_max(av), 1e-30f);
        const float iu = 127.f / au, iv = 127.f / av;
#pragma unroll
        for (int j = 0; j < 8; ++j) { const size_t dst = (size_t)(2 * j + (lane >> 5)) * (2 * MiB) + (size_t)e * 128 + (size_t)(lane & 31) * 4;
            __builtin_nontemporal_store(q8pack(uv[j][0], uv[j][1], uv[j][2], uv[j][3], iu), (unsigned*)(U8 + dst)); __builtin_nontemporal_store(q8pack(vv[j][0], vv[j][1], vv[j][2], vv[j][3], iv), (unsigned*)(V8 + dst)); }
        if (lane == 0) { SU[e] = au * (1.f / 127.f); SV[e] = av * (1.f / 127.f); }
    }
}

#define XB_TMO      128
#define XB_XCNT(j)  (256  + 64 * (j))
#define XB_XSUB(j)  (1280 + 64 * (j))
#define XB_XGEN(j)  (2304 + 64 * (j))
#define XB_TOP      3328
#define XB_TOPGEN   3392
#define XB_SPIN_CAP (1u << 22)
__device__ __forceinline__ unsigned xb_ld(unsigned* p)              { return __hip_atomic_load(p, __ATOMIC_RELAXED, __HIP_MEMORY_SCOPE_AGENT); }
__device__ __forceinline__ unsigned xb_add(unsigned* p, unsigned v) { return __hip_atomic_fetch_add(p, v, __ATOMIC_RELAXED, __HIP_MEMORY_SCOPE_AGENT); }
__device__ __forceinline__ unsigned xb_xcc_id() { return (unsigned)__builtin_amdgcn_s_getreg((3 << 11) | 20) & 0xFu; }
#define XB_SPIN(cond, bar) do { unsigned _sp = 0; while (cond) { __builtin_amdgcn_s_sleep(1); \
    if ((++_sp & 255u) == 0u) { if (xb_ld(&(bar)[XB_TMO])) break; if (_sp > XB_SPIN_CAP) { atomicAdd(&(bar)[XB_TMO], 1u); break; } } } } while (0)
struct XcdBarrier { unsigned* bar; unsigned x; volatile LAS unsigned* st; };
__device__ __forceinline__ XcdBarrier xcd_barrier_post(unsigned* bar, volatile LAS unsigned* st) {
    XcdBarrier b; b.bar = bar; b.x = xb_xcc_id(); b.st = st;
    if (threadIdx.x == 0) (void)xb_add(&bar[XB_XCNT(b.x)], 1u);
    return b;
}
__device__ __forceinline__ void xcd_barrier_complete(unsigned* bar, unsigned x, unsigned& nloc, unsigned& nx) {
    const unsigned G = gridDim.x * gridDim.y * gridDim.z;
    unsigned sum, cnt, mine, sp = 0u;
    for (;;) {
        sum = 0u; cnt = 0u; mine = 0u;
#pragma unroll
        for (unsigned j = 0; j < 16; ++j) { const unsigned c = xb_ld(&bar[XB_XCNT(j)]); sum += c; cnt += (c > 0u) ? 1u : 0u; mine = (j == x) ? c : mine; }
        if (sum == G) break;
        __builtin_amdgcn_s_sleep(1);
        if ((++sp & 255u) == 0u) { if (xb_ld(&bar[XB_TMO])) break; if (sp > XB_SPIN_CAP) { atomicAdd(&bar[XB_TMO], 1u); break; } }
    }
    nloc = mine > 0u ? mine : 1u; nx = cnt > 0u ? cnt : 1u;
}
__device__ __forceinline__ void xcd_barrier(const XcdBarrier& b) {
    asm volatile("s_waitcnt vmcnt(0)" ::: "memory");
    __syncthreads();
    if (threadIdx.x == 0) {
        unsigned* bar = b.bar;
        __builtin_amdgcn_s_waitcnt(0);
        unsigned nloc = b.st[0], nx = b.st[1];
        if (nloc == 0u) { xcd_barrier_complete(bar, b.x, nloc, nx); b.st[0] = nloc; b.st[1] = nx; }
        const unsigned old = xb_add(&bar[XB_XSUB(b.x)], 1u);
        const unsigned gen = old / nloc;
        if (old + 1u == (gen + 1u) * nloc) {
            __builtin_amdgcn_fence(__ATOMIC_RELEASE, "agent");
            asm volatile("s_waitcnt vmcnt(0)" ::: "memory");
            const unsigned og = xb_add(&bar[XB_TOP], 1u);
            const unsigned tg = og / nx;
            if (og + 1u == (tg + 1u) * nx) xb_add(&bar[XB_TOPGEN], 1u);
            else XB_SPIN(xb_ld(&bar[XB_TOPGEN]) == tg, bar);
            __builtin_amdgcn_fence(__ATOMIC_ACQUIRE, "agent");
            xb_add(&bar[XB_XGEN(b.x)], 1u);
            asm volatile("s_waitcnt vmcnt(0)" ::: "memory");
        } else {
            XB_SPIN(xb_ld(&bar[XB_XGEN(b.x)]) == gen, bar);
            __builtin_amdgcn_fence(__ATOMIC_ACQUIRE, "agent");
            asm volatile("s_waitcnt vmcnt(0)" ::: "memory");
        }
    }
    __syncthreads();
}

__global__ void __launch_bounds__(512, 2) mk_fwd(Args args) {
    extern __shared__ __attribute__((aligned(16))) unsigned char lds_raw[];
    LAS unsigned char* lds = (LAS unsigned char*)lds_raw;
    const int tid = threadIdx.x, lane = tid & 63, wave = __builtin_amdgcn_readfirstlane(tid >> 6);
    const int G = gridDim.x, bx = blockIdx.x;
    const int vcu = (G % 8 == 0) ? (bx % 8) * (G / 8) + bx / 8 : bx;
    unsigned char* ws = args.ws;
    const float* x = (const float*)args.in[0]; const int* positions = (const int*)args.in[1];
    const float* g_norm_mix = (const float*)args.in[2]; const float* w_in = (const float*)args.in[3]; const float* b_gate = (const float*)args.in[4];
    const float* g_cq = (const float*)args.in[5]; const float* w_uq = (const float*)args.in[6]; const float* g_ckv = (const float*)args.in[7]; const float* w_ukv = (const float*)args.in[8];
    const float* g_qn = (const float*)args.in[9]; const float* g_qr = (const float*)args.in[10]; const float* g_kn = (const float*)args.in[11]; const float* g_kr = (const float*)args.in[12];
    const float* w_a2 = (const float*)args.in[13]; const float* b_a = (const float*)args.in[14]; const float* g_on = (const float*)args.in[15];
    const float* w_out = (const float*)args.in[16]; const float* g_ffn = (const float*)args.in[17]; const float* w_pq = (const float*)args.in[18]; const float* sub_keys = (const float*)args.in[19];
    const float* u_emb = (const float*)args.in[20]; const float* v_emb = (const float*)args.in[21];
    float* out = args.out;
    const int lo = args.ph_lo, hi_ph = args.ph_hi;
#ifndef PH_MASK
#define PH_MASK 0xff
#endif
#define IN(k) (((PH_MASK >> (k)) & 1) && lo <= (k) && (k) < hi_ph)
#define SEAM(k) do { if (IN(k) && IN((k) + 1)) { if (args.ph_lo < 0) cg::this_grid().sync(); else xcd_barrier(xbar); } } while (0)
    volatile LAS unsigned* xst = (volatile LAS unsigned*)(lds + (LDS_BYTES - 64));
    if (tid < 2) xst[tid] = 0u;
    __syncthreads();
    XcdBarrier xbar = xcd_barrier_post((unsigned*)ws, xst);
    const int gw = vcu * 8 + wave, NGW = G * 8;

    auto aux_items = [&]() {
        LAS float* scr = (LAS float*)(lds + wave * 16896);
        constexpr int I_UQ = 8 * 96, I_UKV = 8 * 64, I_OUT = 32 * 32, I_PQ = 32 * 32;
        for (int it = gw; it < I_UQ + I_UKV + I_OUT + I_PQ; it += NGW) {
            int r = it;
            if (r < I_UQ) { p0_transpose_item(w_uq, 3072, 512, 96, (bf16_t*)(ws + WS_WUQ), scr, r, lane, CmWuq(), g_cq); continue; } r -= I_UQ;
            if (r < I_UKV) { p0_transpose_item64(w_ukv, 4096, 512, 64, (bf16_t*)(ws + WS_WUKV), scr, r, lane, CmWukv(), g_ckv); continue; } r -= I_UKV;
            if (r < I_OUT) { p0_gate_colmax_item<false>(w_out, 2048, 32, (float*)(ws + WS_PMAXO), r, lane); continue; } r -= I_OUT;
            p0_gate_colmax_item<false>(w_pq, 2048, 32, (float*)(ws + WS_PMAXP), r, lane, g_ffn);
        }
        { float* ROPE = (float*)(ws + WS_ROPE);
          for (int i = bx * 512 + tid; i < T * 32; i += G * 512) { const int t = i >> 5, f = i & 31; const float inv = powf(10000.f, -(float)(2 * f) / 64.f); const float ang = (float)positions[t] * inv;
              ROPE[(size_t)t * 64 + f] = cosf(ang); ROPE[(size_t)t * 64 + 32 + f] = sinf(ang); } }
        { bf16_t* KEYS = (bf16_t*)(ws + WS_KEYS);
          for (int i = bx * 512 + tid; i < 8 * 2 * 128 * 128 / 2; i += G * 512) { const f32x2_t v = *(const f32x2_t*)(sub_keys + 2 * (size_t)i); *(unsigned*)(KEYS + 2 * (size_t)i) = pkbf(v[0], v[1]); } }
        __syncthreads();
    };
    auto x_to_h8 = [&]() {
        for (int m = gw; m < T; m += 2 * NGW) {
            const int m2 = m + NGW;
            const f32x4* xr = (const f32x4*)(x + (size_t)m * 2048) + lane; const f32x4* xr2 = (const f32x4*)(x + (size_t)(m2 < T ? m2 : m) * 2048) + lane;
            f32x4 v[8], v2[8]; float s = 0.f, s2 = 0.f;
#pragma unroll
            for (int j = 0; j < 8; ++j) { v[j] = __builtin_nontemporal_load(xr + 64 * j); v2[j] = __builtin_nontemporal_load(xr2 + 64 * j); }
#pragma unroll
            for (int j = 0; j < 8; ++j) { s += (v[j][0] * v[j][0] + v[j][1] * v[j][1]) + (v[j][2] * v[j][2] + v[j][3] * v[j][3]); s2 += (v2[j][0] * v2[j][0] + v2[j][1] * v2[j][1]) + (v2[j][2] * v2[j][2] + v2[j][3] * v2[j][3]); }
            const float rstd = 1.f / sqrtf(wave_sum(s) * (1.f / 2048.f) + EPS), rstd2 = 1.f / sqrtf(wave_sum(s2) * (1.f / 2048.f) + EPS);
            float am = 0.f, am2 = 0.f;
#pragma unroll
            for (int j = 0; j < 8; ++j) { const f32x4 gg = *((const f32x4*)g_norm_mix + lane + 64 * j);
                v[j] = v[j] * rstd * gg; v2[j] = v2[j] * rstd2 * gg;
                am = fmaxf(am, fmaxf(fmaxf(fabsf(v[j][0]), fabsf(v[j][1])), fmaxf(fabsf(v[j][2]), fabsf(v[j][3])))); am2 = fmaxf(am2, fmaxf(fmaxf(fabsf(v2[j][0]), fabsf(v2[j][1])), fmaxf(fabsf(v2[j][2]), fabsf(v2[j][3]))));
                }
            am = fmaxf(wave_max(am), 1e-30f); am2 = fmaxf(wave_max(am2), 1e-30f);
            const float ih = 127.f / am, ih2 = 127.f / am2;
            unsigned* h8 = (unsigned*)((unsigned char*)out + (size_t)m * 2048) + lane; unsigned* h82 = (unsigned*)((unsigned char*)out + (size_t)m2 * 2048) + lane;
#pragma unroll
            for (int j = 0; j < 8; ++j) { h8[64 * j] = q8pack(v[j][0], v[j][1], v[j][2], v[j][3], ih); if (m2 < T) h82[64 * j] = q8pack(v2[j][0], v2[j][1], v2[j][2], v2[j][3], ih2); }
            if (lane == 0) { float* SH = (float*)((unsigned char*)out + 32 * MiB); SH[m] = am * (1.f / 127.f); if (m2 < T) SH[m2] = am2 * (1.f / 127.f); }
        }
    };
    if (IN(0)) {
#ifdef REP_P0
      for (int rep_ = 0; rep_ < 2; ++rep_) {
#else
      {
#endif
        LAS float* scr = (LAS float*)(lds + wave * 16896);
        for (int it = gw; it < 32 * 180; it += NGW) p0_gate_colmax_item<true>(w_in, 11344, 180, (float*)(ws + WS_PMAX), it, lane);
      }
    }
    SEAM(0);
    if (IN(1)) {
        {   LAS float* scr = (LAS float*)(lds + wave * 16896);
            const bool quant_first = ((bx >> 6) & 1) == 0;
            if (!quant_first) x_to_h8();
            for (int it = gw; it < 32 * 180; it += NGW) p0_gate_quant_item<true>(w_in, 11344, 180, (const float*)(ws + WS_PMAX), ws + WS_WG8, (float*)(ws + WS_SWG), scr, it, lane);
            if (quant_first) x_to_h8();
            __syncthreads(); }
        if (lo == 0 && hi_ph == NPH) xcd_barrier(xbar);
        {
            pg8::Gemm g{(const bf16_t*)out, (const bf16_t*)(ws + WS_WG8), T, N1, 1024, 1024, 1024}; pg8::StaticOrder S; S.init(T, N1, G, bx);
            EpiG1i E{ws, b_gate, (const float*)((const unsigned char*)out + 32 * MiB), (const float*)(ws + WS_SWG), (float*)(ws + WS_RSQ0)};
            const bool tables_first = ((bx >> 6) & 1) == 0;
            if (tables_first) { table_quant(ws, u_emb, v_emb, g_ffn, gw, NGW, lane); aux_items(); }
            pg8::gemm_phase<EpiG1i, true>(lds, g, S, E);
            if (!tables_first) { table_quant(ws, u_emb, v_emb, g_ffn, gw, NGW, lane); aux_items(); } }
    }
    SEAM(1);
    if (IN(2)) {
        auto prep_part = [&]() {
        {
            LAS float* scr = (LAS float*)(lds + wave * 16896);
            for (int it = gw; it < 2 * 32 * 32; it += NGW) {
                if (it < 32 * 32) p0_gate_quant_item<false>(w_out, 2048, 32, (const float*)(ws + WS_PMAXO), ws + WS_WOUT, (float*)(ws + WS_SWO), scr, it, lane);
                else p0_gate_quant_item<false>(w_pq, 2048, 32, (const float*)(ws + WS_PMAXP), ws + WS_WPQ, (float*)(ws + WS_SWP), scr, it - 32 * 32, lane, g_ffn); }
            __syncthreads(); }
        {
            const bf16_t* MISC = (const bf16_t*)(ws + WS_MISC); const float* ROPE = (const float*)(ws + WS_ROPE); bf16_t* KPE = (bf16_t*)(ws + WS_KPE);
            for (int t0 = gw; t0 < T; t0 += 4 * NGW) {
                float v[4], c[4], sn[4]; const int f = lane & 31;
#pragma unroll
                for (int k = 0; k < 4; ++k) { const int t = t0 + k * NGW; const int tc = t < T ? t : t0;
                    v[k] = bf1(MISC[(size_t)tc * 256 + lane]); c[k] = ROPE[(size_t)tc * 64 + f]; sn[k] = ROPE[(size_t)tc * 64 + 32 + f]; }
#pragma unroll
                for (int k = 0; k < 4; ++k) { const int t = t0 + k * NGW;
                    const float ss = wave_sum(v[k] * v[k]);
                    const float xn = v[k] * __builtin_amdgcn_rsqf(ss * (1.f / 64.f) + EPS) * g_kr[lane];
                    const float other = __shfl_xor(xn, 32);
                    const float o = (lane < 32) ? (xn * c[k] - other * sn[k]) : (xn * c[k] + other * sn[k]);
                    if (t < T) KPE[(size_t)t * 64 + 2 * f + (lane >> 5)] = f2bf(o); }
            }
        }
        {
            bf16_t* QG = (bf16_t*)(ws + WS_QG); bf16_t* KG = (bf16_t*)(ws + WS_KG); const bf16_t* MISC = (const bf16_t*)(ws + WS_MISC); float* DECG = (float*)(ws + WS_DEC);
            LAS float* alr = (LAS float*)lds; LAS float* tot = (LAS float*)(lds + 4096); LAS float* cumL = (LAS float*)(lds + 8192);
            LAS unsigned char* qL = lds + 8192 + 65536; LAS unsigned char* kL = qL + 64 * 528;
            const int d = tid & 255, half = tid >> 8;
            for (int un = vcu; un < 1024; un += G) {
                const int c = un & 31, hh = (un >> 5) & 3, b = un >> 7; const size_t t0 = (size_t)b * SEQ + (size_t)c * 64;
                for (int i = tid; i < 1024; i += 512) alr[i] = bf1(MISC[(t0 + (i >> 4)) * 256 + 64 + (i & 15)]);
                const int dc = (tid & 31) * 8;
                u32x4 qv[4], kv[4];
#pragma unroll
                for (int i = 0; i < 4; ++i) { const size_t off = (t0 + (tid >> 5) + 16 * i) * 1024 + hh * 256 + dc; qv[i] = *(const u32x4*)(QG + off); kv[i] = *(const u32x4*)(KG + off); }
                float w[16];
#pragma unroll
                for (int r = 0; r < 16; ++r) w[r] = w_a2[r * 1024 + hh * 256 + d];
                const float ba = b_a[hh * 256 + d];
                __syncthreads();
                float la[32]; float sum = 0.f;
#pragma unroll
                for (int jj = 0; jj < 32; ++jj) { const int j = 32 * half + jj; float z = ba;
#pragma unroll
                    for (int r4 = 0; r4 < 4; ++r4) { const f32x4 a = *(const LAS f32x4*)(alr + j * 16 + 4 * r4); z += a[0] * w[4 * r4] + a[1] * w[4 * r4 + 1] + a[2] * w[4 * r4 + 2] + a[3] * w[4 * r4 + 3]; }
                    const float ls = fminf(z, 0.f) - __logf(1.f + __expf(-fabsf(z)));
                    la[jj] = ls * (1.f / 16.f); sum += la[jj]; }
                if (half == 0) tot[d] = sum;
                __syncthreads();
                float cum = half ? tot[d] : 0.f;
#pragma unroll
                for (int jj = 0; jj < 32; ++jj) { cum += la[jj]; cumL[(32 * half + jj) * 256 + d] = cum; }
                if (half == 1) DECG[((size_t)((b * 4 + hh) * 32 + c)) * 256 + d] = __expf(cum);
                __syncthreads();
#pragma unroll
                for (int i = 0; i < 4; ++i) { const int j = (tid >> 5) + 16 * i; const size_t off = (t0 + j) * 1024 + hh * 256 + dc;
                    const f32x4 c0 = *(const LAS f32x4*)(cumL + j * 256 + dc), c1 = *(const LAS f32x4*)(cumL + j * 256 + dc + 4);
                    float e[8];
#pragma unroll
                    for (int k = 0; k < 4; ++k) { e[k] = __expf(c0[k]); e[4 + k] = __expf(c1[k]); }
                    u32x4 qo, ko;
#pragma unroll
                    for (int k = 0; k < 4; ++k) { const float e0 = e[2 * k], e1 = e[2 * k + 1];
                        qo[k] = pkbf(bf_lo(qv[i][k]) * e0 * 0.0625f, bf_hi(qv[i][k]) * e1 * 0.0625f);
                        ko[k] = pkbf(bf_lo(kv[i][k]) * __builtin_amdgcn_rcpf(e0), bf_hi(kv[i][k]) * __builtin_amdgcn_rcpf(e1)); }
                    *(u32x4*)(QG + off) = qo; *(u32x4*)(KG + off) = ko;
                    *(LAS u32x4*)(qL + j * 528 + dc * 2) = qo; *(LAS u32x4*)(kL + j * 528 + dc * 2) = ko; }
                __syncthreads();
                {
                    bf16_t* ABUF = (bf16_t*)(ws + WS_ABUF) + ((size_t)((b * 4 + hh) * 32 + c)) * 4096;
                    const int l15 = lane & 15, g = lane >> 4, it = wave >> 1;
#pragma unroll
                    for (int jj = 0; jj < 2; ++jj) {
                        const int jt = 2 * (wave & 1) + jj;
                        f32x4 a = (f32x4){0.f, 0.f, 0.f, 0.f};
                        if (jt <= it) {
#pragma unroll
                            for (int ks = 0; ks < 8; ++ks) {
                                const bf16x8 fa = *(const LAS bf16x8*)(qL + (16 * it + l15) * 528 + (32 * ks + 8 * g) * 2);
                                const bf16x8 fb = *(const LAS bf16x8*)(kL + (16 * jt + l15) * 528 + (32 * ks + 8 * g) * 2);
                                a = __builtin_amdgcn_mfma_f32_16x16x32_bf16(fb, fa, a, 0, 0, 0);
                            }
                        }
                        const int i = 16 * it + l15, j0 = 16 * jt + 4 * g;
                        u32x2 w2; w2.x = pkbf((j0 <= i) ? a[0] : 0.f, (j0 + 1 <= i) ? a[1] : 0.f); w2.y = pkbf((j0 + 2 <= i) ? a[2] : 0.f, (j0 + 3 <= i) ? a[3] : 0.f);
                        *(u32x2*)(ABUF + i * 64 + j0) = w2;
                    }
                }
                __syncthreads();
            }
        }
        };
        auto gemm_part = [&]() {
        {
            pg8::Gemm g{(const bf16_t*)(ws + WS_CQKV), (const bf16_t*)(ws + WS_WUQ), T, 3072, 512, 1024, 512}; pg8::StaticOrder S; S.init(T, 3072, G, bx);
            EpiUp<0> E{lds, (const float*)(ws + WS_RSQ0), 0, g_qn, g_qr, (const float*)(ws + WS_ROPE), (bf16_t*)(ws + WS_QH), nullptr};
            pg8::gemm_phase<EpiUp<0>, true>(lds, g, S, E);
        }
        {
            pg8::Gemm g{(const bf16_t*)(ws + WS_CQKV) + 512, (const bf16_t*)(ws + WS_WUKV), T, 4096, 512, 1024, 512}; pg8::StaticOrder S; S.init(T, 4096, G, bx);
            EpiUp<1> E{lds, (const float*)(ws + WS_RSQ0), 8, g_kn, nullptr, nullptr, (bf16_t*)out, (bf16_t*)out + (size_t)T * 2048};
            pg8::gemm_phase<EpiUp<1>, true>(lds, g, S, E);
        }
        };
        if (((bx >> 6) & 1) == 0) { prep_part(); gemm_part(); } else { gemm_part(); prep_part(); }
    }
    SEAM(2);
    if (IN(3)) {
#ifndef NO_GLA
        for (int un = vcu; un < 256; un += G) gla_scan_unit(lds, ws, g_on, un >> 5, (un >> 3) & 3, un & 7, false);
#endif
#ifdef REP_GLA
        for (int un = vcu; un < 256; un += G) gla_scan_unit(lds, ws, g_on, un >> 5, (un >> 3) & 3, un & 7, true);
#endif
        const bf16_t* Qh = (const bf16_t*)(ws + WS_QH); const bf16_t* Kh = (const bf16_t*)out; const bf16_t* Vh = (const bf16_t*)out + (size_t)T * 2048;
        const bf16_t* KPE = (const bf16_t*)(ws + WS_KPE); bf16_t* GA = (bf16_t*)(ws + WS_GA);
#ifndef NO_ATTN
        for (int pr = vcu; pr < 512; pr += G) {
            const int bh = pr >> 2, s = pr & 3;
            attn_unit(lds, Qh, Kh, Vh, KPE, GA, GA, ~(size_t)0, bh >> 4, bh & 15, 7 - s);
            attn_unit(lds, Qh, Kh, Vh, KPE, GA, GA, ~(size_t)0, bh >> 4, bh & 15, s);
        }
#endif
#ifdef REP_ATTN
        for (int pr = vcu; pr < 512; pr += G) { const int bh = pr >> 2, s = pr & 3;
            attn_unit(lds, Qh, Kh, Vh, KPE, GA, (bf16_t*)(ws + WS_CQKV), (size_t)0xffffff, bh >> 4, bh & 15, 7 - s);
            attn_unit(lds, Qh, Kh, Vh, KPE, GA, (bf16_t*)(ws + WS_CQKV), (size_t)0xffffff, bh >> 4, bh & 15, s); }
#endif
    }
    SEAM(3);
    if (IN(4)) {
        const bf16_t* GA = (const bf16_t*)(ws + WS_GA); const bf16_t* GB = (const bf16_t*)(ws + WS_GB); const float* SSQ = (const float*)(ws + WS_SSQ);
        unsigned char* M8 = ws + WS_M8; float* SM = (float*)(ws + WS_SM);
        for (int t0 = gw; t0 < T; t0 += 2 * NGW) {
            u32x4 av[2][4], bv[2][4]; f32x4 sq[2][4][2];
#pragma unroll
            for (int k = 0; k < 2; ++k) { const int t = t0 + k * NGW < T ? t0 + k * NGW : t0;
#pragma unroll
                for (int q = 0; q < 4; ++q) { const size_t off = (size_t)t * 2048 + (size_t)(lane + 64 * q) * 8;
                    av[k][q] = __builtin_nontemporal_load((const u32x4*)(GA + off)); bv[k][q] = __builtin_nontemporal_load((const u32x4*)(GB + off));
                    sq[k][q][0] = *(const f32x4*)(SSQ + ((size_t)t * 4 + q) * 8); sq[k][q][1] = *(const f32x4*)(SSQ + ((size_t)t * 4 + q) * 8 + 4); } }
#pragma unroll
            for (int k = 0; k < 2; ++k) { const int t = t0 + k * NGW; if (t >= T) break;
                float mv[4][8]; float am = 0.f;
#pragma unroll
                for (int q = 0; q < 4; ++q) {
                    const f32x4 s0 = sq[k][q][0], s1 = sq[k][q][1];
                    const float rs = __builtin_amdgcn_rsqf(((s0[0] + s0[1]) + (s0[2] + s0[3]) + (s1[0] + s1[1]) + (s1[2] + s1[3])) * (1.f / 512.f) + EPS);
                    const u32x4 a = av[k][q], bb = bv[k][q];
                    mv[q][0] = bf_lo(a.x) + rs * bf_lo(bb.x); mv[q][1] = bf_hi(a.x) + rs * bf_hi(bb.x); mv[q][2] = bf_lo(a.y) + rs * bf_lo(bb.y); mv[q][3] = bf_hi(a.y) + rs * bf_hi(bb.y);
                    mv[q][4] = bf_lo(a.z) + rs * bf_lo(bb.z); mv[q][5] = bf_hi(a.z) + rs * bf_hi(bb.z); mv[q][6] = bf_lo(a.w) + rs * bf_lo(bb.w); mv[q][7] = bf_hi(a.w) + rs * bf_hi(bb.w);
#pragma unroll
                    for (int e = 0; e < 8; ++e) am = fmaxf(am, fabsf(mv[q][e]));
                }
                am = fmaxf(wave_max(am), 1e-30f); const float im = 127.f / am;
#pragma unroll
                for (int q = 0; q < 4; ++q) { u32x2 w; w.x = q8pack(mv[q][0], mv[q][1], mv[q][2], mv[q][3], im); w.y = q8pack(mv[q][4], mv[q][5], mv[q][6], mv[q][7], im);
                    *(u32x2*)(M8 + (size_t)t * 2048 + (size_t)(lane + 64 * q) * 8) = w; }
                if (lane == 0) SM[t] = am * (1.f / 127.f);
            }
        }
    }
    SEAM(4);
    if (IN(5)) {
        pg8::Gemm g{(const bf16_t*)(ws + WS_M8), (const bf16_t*)(ws + WS_WOUT), T, 2048, 1024, 1024, 1024}; pg8::StaticOrder S; S.init(T, 2048, G, bx);
        EpiOutI E{x, (bf16_t*)(ws + WS_X1B), (float*)(ws + WS_RSQ1), (const float*)(ws + WS_SM), (const float*)(ws + WS_SWO)};
        pg8::gemm_phase<EpiOutI, true>(lds, g, S, E);
    }
    SEAM(5);
    if (IN(6)) {
        for (int un = vcu; un < 256; un += G) x1_quant_unit(ws, un);
        if (lo == 0 && hi_ph == NPH) xcd_barrier(xbar);
        pg8::Gemm g{(const bf16_t*)(ws + WS_X8), (const bf16_t*)(ws + WS_WPQ), T, 2048, 1024, 1024, 1024}; pg8::StaticOrder S; S.init(T, 2048, G, bx);
        EpiQPi E{(bf16_t*)(ws + WS_QP), (const float*)(ws + WS_SX), (const float*)(ws + WS_SWP)};
        pg8::gemm_phase<EpiQPi, true>(lds, g, S, E);
    }
    SEAM(6);
    if (IN(7)) {
        for (int un = vcu; un < 256; un += G) { peer_unit(lds, ws, out, un); peer_fused_rounds(lds, ws, out, un); __syncthreads(); }
    }
#undef IN
#undef SEAM
}

extern "C" void kernel_launch(void* const* d_in, const int* in_sizes, int n_in, void* d_out, int out_size, void* d_ws, size_t ws_size, hipStream_t stream) {
    static int grid = 0;
    if (grid == 0) {
        if (n_in != 22 || out_size != T * DM || ws_size < WS_END) { fprintf(stderr, "kernel_launch: unexpected problem (n_in %d out %d ws %zu)\n", n_in, out_size, ws_size); grid = -1; return; }
        int dev = 0, cus = 0, per_cu = 0;
        (void)hipGetDevice(&dev); (void)hipDeviceGetAttribute(&cus, hipDeviceAttributeMultiprocessorCount, dev);
        if (hipFuncSetAttribute((const void*)mk_fwd, hipFuncAttributeMaxDynamicSharedMemorySize, LDS_BYTES) != hipSuccess) { fprintf(stderr, "kernel_launch: hipFuncSetAttribute failed\n"); grid = -1; return; }
        if (hipOccupancyMaxActiveBlocksPerMultiprocessor(&per_cu, (const void*)mk_fwd, 512, LDS_BYTES) != hipSuccess || per_cu < 1) { fprintf(stderr, "kernel_launch: occupancy query says %d\n", per_cu); (void)hipGetLastError(); grid = -1; return; }
        grid = cus;
        fprintf(stderr, "kernel_launch: grid %d (per_cu %d)\n", grid, per_cu);
    }
    if (grid < 0) return;
    if (hipMemsetAsync(d_ws, 0, 16384, stream) != hipSuccess) { fprintf(stderr, "kernel_launch: memset failed\n"); return; }
    Args a{};
    for (int i = 0; i < 22; ++i) a.in[i] = d_in[i];
    a.out = (float*)d_out; a.ws = (unsigned char*)d_ws;
#if MK_N_LAUNCHES == 1
    a.ph_lo = 0; a.ph_hi = NPH;
    void* kargs[] = {&a};
    hipError_t e = hipLaunchCooperativeKernel((const void*)mk_fwd, dim3(grid), dim3(512), kargs, LDS_BYTES, stream);
    if (e != hipSuccess) fprintf(stderr, "kernel_launch: cooperative launch failed: %s\n", hipGetErrorString(e));
#else
    for (int p = 0; p < NPH; ++p) { a.ph_lo = p; a.ph_hi = p + 1; hipLaunchKernelGGL(mk_fwd, dim3(grid), dim3(512), LDS_BYTES, stream, a); }
#endif
}
```
